# Optimizing an MI355X kernel written in HIP

```python
import jax, jax.numpy as jnp
from jax import lax
import numpy as np

D_MODEL = 1024
BATCH = 32
SEQ = 2048
DEPTH = 2
DEC_BATCH = 32
DEC_SEQ = 64
PAST_LEN = 1024

CHUNK = 64
Q_BLOCK = 128
EPS = 1e-6

SSD_HEADS = 8
SSD_HEAD_DIM = 64
SSD_WIDTH = SSD_HEADS * SSD_HEAD_DIM
SSD_GROUPS = 2
D_STATE = 128
CONV_W = 4
CONV_DIM = SSD_WIDTH + 2 * SSD_GROUPS * D_STATE

MLA_HEADS = 8
QK_NOPE = 64
QK_ROPE = 32
V_HEAD = 64
Q_LORA = 256
KV_LORA = 128
MLA_WIDTH = MLA_HEADS * V_HEAD
ROPE_BASE = 10000.0

MIX_WIDTH = SSD_WIDTH + MLA_WIDTH
S_Z = SSD_WIDTH
S_XBC = S_Z + CONV_DIM
S_DT = S_XBC + SSD_HEADS
S_Q = S_DT + Q_LORA
IN_PROJ = S_Q + KV_LORA + QK_ROPE

D_FF = -(-(8 * D_MODEL) // (3 * 256)) * 256

kernel_name = "hybrid_ssd_mla_streaming_step"


def rmsnorm(x, w):
    xf = x.astype(jnp.float32)
    y = xf * lax.rsqrt(jnp.mean(xf * xf, axis=-1, keepdims=True) + EPS)
    return (y * w.astype(jnp.float32)).astype(x.dtype)


def rope_tables(pos):
    inv = 1.0 / (ROPE_BASE ** (jnp.arange(0, QK_ROPE, 2, dtype=jnp.float32) / QK_ROPE))
    ang = pos.astype(jnp.float32)[:, None] * inv[None, :]
    return jnp.cos(ang), jnp.sin(ang)


def apply_rope(x, cos, sin):
    x1, x2 = jnp.split(x.astype(jnp.float32), 2, axis=-1)
    return jnp.concatenate([x1 * cos - x2 * sin, x1 * sin + x2 * cos], axis=-1).astype(x.dtype)


def causal_conv(u, buf, w, b):
    T = u.shape[1]
    up = jnp.concatenate([buf.astype(u.dtype), u], axis=1)
    y = b
    for k in range(CONV_W):
        y = y + up[:, k:k + T] * w[k]
    return jax.nn.silu(y), up[:, -(CONV_W - 1):]


def ssd_scan(xh, dt, A, Bm, Cm, h0):
    b, T = xh.shape[:2]
    L = min(CHUNK, T)
    nc = T // L
    hg = SSD_HEADS // SSD_GROUPS
    f32 = jnp.float32

    def to_chunks(a):
        return jnp.moveaxis(a.reshape((b, nc, L) + a.shape[2:]), 1, 0)

    xc = to_chunks(xh.astype(f32).reshape(b, T, SSD_GROUPS, hg, SSD_HEAD_DIM))
    dtc = to_chunks(dt.reshape(b, T, SSD_GROUPS, hg))
    Bc = to_chunks(Bm.astype(f32))
    Cc = to_chunks(Cm.astype(f32))
    causal = jnp.tril(jnp.ones((L, L), dtype=bool))[None, :, :, None, None]
    A_g = A.reshape(SSD_GROUPS, hg)

    def step(h, inp):
        x, d, Bk, Ck = inp
        cum = jnp.cumsum(d * A_g, axis=1)
        seg = cum[:, :, None] - cum[:, None, :]
        decay = jnp.where(causal, jnp.exp(jnp.where(causal, seg, 0.0)), 0.0)
        cb = jnp.einsum('blgn,bsgn->blsg', Ck, Bk)
        wts = decay * cb[..., None] * d[:, None]
        y = jnp.einsum('blsgh,bsghp->blghp', wts, x)
        y = y + jnp.einsum('blgn,bghpn,blgh->blghp', Ck, h, jnp.exp(cum))
        last = cum[:, -1]
        w_end = jnp.exp(last[:, None] - cum) * d
        h_new = jnp.exp(last)[..., None, None] * h + jnp.einsum('blgh,blghp,blgn->bghpn', w_end, x, Bk)
        return h_new, y

    h_init = h0.astype(f32).reshape(b, SSD_GROUPS, hg, SSD_HEAD_DIM, D_STATE)
    hT, ys = lax.scan(step, h_init, (xc, dtc, Bc, Cc))
    y = jnp.moveaxis(ys, 0, 1).reshape(b, T, SSD_HEADS, SSD_HEAD_DIM)
    return y, hT.reshape(b, SSD_HEADS, SSD_HEAD_DIM, D_STATE).astype(h0.dtype)


def mla_attend(q_lat, q_rope, q_pos, keys_c, keys_r, k_pos):
    b, T = q_lat.shape[:2]
    qb = min(Q_BLOCK, T)
    nb = T // qb
    scale = (QK_NOPE + QK_ROPE) ** -0.5
    k_chunk = k_pos // CHUNK

    def block(args):
        ql, qr, qp = args
        s = (jnp.einsum('bqhl,bkl->bhqk', ql, keys_c, preferred_element_type=jnp.float32)
             + jnp.einsum('bqhr,bkr->bhqk', qr, keys_r, preferred_element_type=jnp.float32))
        mask = k_chunk[None, :] <= (qp // CHUNK)[:, None]
        s = jnp.where(mask, s * scale, -jnp.inf)
        pr = jax.nn.softmax(s, axis=-1).astype(keys_c.dtype)
        return jnp.einsum('bhqk,bkl->bqhl', pr, keys_c)

    def split(a):
        return jnp.moveaxis(a.reshape((b, nb, qb) + a.shape[2:]), 1, 0)

    out = lax.map(block, (split(q_lat), split(q_rope), q_pos.reshape(nb, qb)))
    return jnp.moveaxis(out, 0, 1).reshape(b, T, MLA_HEADS, KV_LORA)


def hybrid_layer(x, ckv_past, krope_past, ssm_h0, conv_buf, p):
    b, T, _ = x.shape
    P = ckv_past.shape[1]
    h = rmsnorm(x, p['norm_mix'])
    proj = h @ p['w_in']
    z = proj[..., :S_Z]
    xbc = proj[..., S_Z:S_XBC]
    dt_raw = proj[..., S_XBC:S_DT]
    cq = proj[..., S_DT:S_Q]
    ckv_raw = proj[..., S_Q:]

    xbc, conv_new = causal_conv(xbc, conv_buf, p['conv_w'], p['conv_b'])
    xs = xbc[..., :SSD_WIDTH]
    Bm = xbc[..., SSD_WIDTH:SSD_WIDTH + SSD_GROUPS * D_STATE].reshape(b, T, SSD_GROUPS, D_STATE)
    Cm = xbc[..., SSD_WIDTH + SSD_GROUPS * D_STATE:].reshape(b, T, SSD_GROUPS, D_STATE)
    dt = jax.nn.softplus(dt_raw.astype(jnp.float32) + p['dt_bias'].astype(jnp.float32))
    A = -jnp.exp(p['a_log'].astype(jnp.float32))
    xh = xs.reshape(b, T, SSD_HEADS, SSD_HEAD_DIM)
    y, h_new = ssd_scan(xh, dt, A, Bm, Cm, ssm_h0)
    y = y + p['d_skip'].astype(jnp.float32)[:, None] * xh.astype(jnp.float32)
    y = y.reshape(b, T, SSD_WIDTH) * jax.nn.silu(z.astype(jnp.float32))
    y_ssd = rmsnorm(y, p['ssd_norm']).astype(x.dtype)

    q_pos = P + jnp.arange(T)
    cos, sin = rope_tables(q_pos)
    q = (rmsnorm(cq, p['q_norm']) @ p['w_uq']).reshape(b, T, MLA_HEADS, QK_NOPE + QK_ROPE)
    q_nope = q[..., :QK_NOPE]
    q_rope = apply_rope(q[..., QK_NOPE:], cos[:, None], sin[:, None])
    c_kv = rmsnorm(ckv_raw[..., :KV_LORA], p['kv_norm'])
    k_rope = apply_rope(ckv_raw[..., KV_LORA:], cos, sin)
    q_lat = jnp.einsum('bthd,lhd->bthl', q_nope, p['w_uk'])
    keys_c = jnp.concatenate([ckv_past.astype(c_kv.dtype), c_kv], axis=1)
    keys_r = jnp.concatenate([krope_past.astype(k_rope.dtype), k_rope], axis=1)
    o_lat = mla_attend(q_lat, q_rope, q_pos, keys_c, keys_r, jnp.arange(P + T))
    o = jnp.einsum('bthl,lhd->bthd', o_lat, p['w_uv']).reshape(b, T, MLA_WIDTH)

    x = x + jnp.concatenate([y_ssd, o], axis=-1) @ p['w_out']
    hf = rmsnorm(x, p['norm_ffn'])
    x = x + (jax.nn.silu(hf @ p['w_gate']) * (hf @ p['w_up'])) @ p['w_down']
    return x, c_kv, k_rope, h_new, conv_new


def setup_inputs(seed: int = 0) -> dict:
    key = jax.random.key(seed)
    ks = jax.random.split(key, 32)
    f32 = jnp.float32
    nrm = lambda k, shape, s: jax.random.normal(k, shape, f32) * s
    gain = lambda k, shape: 1.0 + 0.02 * jax.random.normal(k, shape, f32)
    dt0 = jnp.exp(jax.random.uniform(ks[20], (DEPTH, SSD_HEADS), f32, np.log(1e-3), np.log(1e-1)))
    return {
        "x_prompt": jax.random.normal(ks[0], (BATCH, SEQ, D_MODEL), f32),
        "x_sample": jax.random.normal(ks[1], (DEC_BATCH, DEC_SEQ, D_MODEL), f32),
        "cache_mla_ckv": jax.random.normal(ks[2], (DEPTH, DEC_BATCH, PAST_LEN, KV_LORA), f32),
        "cache_mla_krope": jax.random.normal(ks[3], (DEPTH, DEC_BATCH, PAST_LEN, QK_ROPE), f32),
        "state_ssm": nrm(ks[4], (DEPTH, DEC_BATCH, SSD_HEADS, SSD_HEAD_DIM, D_STATE), 0.1),
        "state_conv": jax.random.normal(ks[5], (DEPTH, DEC_BATCH, CONV_W - 1, CONV_DIM), f32),
        "w_in": nrm(ks[6], (DEPTH, D_MODEL, IN_PROJ), D_MODEL ** -0.5),
        "w_uq": nrm(ks[7], (DEPTH, Q_LORA, MLA_HEADS * (QK_NOPE + QK_ROPE)), Q_LORA ** -0.5),
        "w_uk": nrm(ks[8], (DEPTH, KV_LORA, MLA_HEADS, QK_NOPE), KV_LORA ** -0.5),
        "w_uv": nrm(ks[9], (DEPTH, KV_LORA, MLA_HEADS, V_HEAD), KV_LORA ** -0.5),
        "w_out": nrm(ks[10], (DEPTH, MIX_WIDTH, D_MODEL), MIX_WIDTH ** -0.5),
        "norm_mix": gain(ks[11], (DEPTH, D_MODEL)),
        "q_norm": gain(ks[12], (DEPTH, Q_LORA)),
        "kv_norm": gain(ks[13], (DEPTH, KV_LORA)),
        "ssd_norm": gain(ks[14], (DEPTH, SSD_WIDTH)),
        "conv_w": nrm(ks[15], (DEPTH, CONV_W, CONV_DIM), CONV_W ** -0.5),
        "conv_b": nrm(ks[16], (DEPTH, CONV_DIM), 0.01),
        "dt_bias": dt0 + jnp.log(-jnp.expm1(-dt0)),
        "a_log": jnp.log(jax.random.uniform(ks[17], (DEPTH, SSD_HEADS), f32, 1.0, 16.0)),
        "d_skip": 1.0 + 0.1 * jax.random.normal(ks[18], (DEPTH, SSD_HEADS), f32),
        "norm_ffn": gain(ks[19], (DEPTH, D_MODEL)),
        "w_gate": nrm(ks[21], (DEPTH, D_MODEL, D_FF), D_MODEL ** -0.5),
        "w_up": nrm(ks[22], (DEPTH, D_MODEL, D_FF), D_MODEL ** -0.5),
        "w_down": nrm(ks[23], (DEPTH, D_FF, D_MODEL), D_FF ** -0.5),
        "norm_final": gain(ks[24], (D_MODEL,)),
    }


def reference(x_prompt, x_sample, cache_mla_ckv, cache_mla_krope, state_ssm, state_conv,
              w_in, w_uq, w_uk, w_uv, w_out, norm_mix, q_norm, kv_norm, ssd_norm,
              conv_w, conv_b, dt_bias, a_log, d_skip, norm_ffn, w_gate, w_up, w_down, norm_final):
    xp, xs = x_prompt, x_sample
    bp = xp.shape[0]
    p_ckv, p_kr, p_ssm, p_conv = [], [], [], []
    s_ckv, s_kr, s_ssm, s_conv = [], [], [], []
    for l in range(DEPTH):
        p = {"w_in": w_in[l], "w_uq": w_uq[l], "w_uk": w_uk[l], "w_uv": w_uv[l], "w_out": w_out[l],
             "norm_mix": norm_mix[l], "q_norm": q_norm[l], "kv_norm": kv_norm[l], "ssd_norm": ssd_norm[l],
             "conv_w": conv_w[l], "conv_b": conv_b[l], "dt_bias": dt_bias[l], "a_log": a_log[l],
             "d_skip": d_skip[l], "norm_ffn": norm_ffn[l], "w_gate": w_gate[l], "w_up": w_up[l],
             "w_down": w_down[l]}
        xp, ckv, kr, hs, cb = hybrid_layer(
            xp,
            jnp.zeros((bp, 0, KV_LORA), xp.dtype),
            jnp.zeros((bp, 0, QK_ROPE), xp.dtype),
            jnp.zeros((bp, SSD_HEADS, SSD_HEAD_DIM, D_STATE), state_ssm.dtype),
            jnp.zeros((bp, CONV_W - 1, CONV_DIM), xp.dtype),
            p)
        p_ckv.append(ckv); p_kr.append(kr); p_ssm.append(hs); p_conv.append(cb)
        xs, ckv, kr, hs, cb = hybrid_layer(xs, cache_mla_ckv[l], cache_mla_krope[l], state_ssm[l], state_conv[l], p)
        s_ckv.append(ckv); s_kr.append(kr); s_ssm.append(hs); s_conv.append(cb)
    y_prompt = rmsnorm(xp, norm_final)
    y_sample = rmsnorm(xs, norm_final)
    return (y_prompt, y_sample,
            jnp.stack(p_ckv), jnp.stack(p_kr), jnp.stack(p_ssm), jnp.stack(p_conv),
            jnp.stack(s_ckv), jnp.stack(s_kr), jnp.stack(s_ssm), jnp.stack(s_conv))
```

```cpp
#include <hip/hip_runtime.h>
#include <hip/hip_cooperative_groups.h>
#include <cstdio>
#include <cstdint>
namespace cg = cooperative_groups;

#ifndef MK_N_LAUNCHES
#define MK_N_LAUNCHES 1
#endif

#define DI __device__ __forceinline__
#define LAS __attribute__((address_space(3)))
typedef unsigned short bf16_t;
typedef short bf16x8 __attribute__((ext_vector_type(8)));
typedef float f32x4 __attribute__((ext_vector_type(4)));
typedef float f32x16 __attribute__((ext_vector_type(16)));
typedef unsigned u32x4 __attribute__((ext_vector_type(4)));
typedef unsigned u32x2 __attribute__((ext_vector_type(2)));
typedef float f32x2_t __attribute__((ext_vector_type(2)));
typedef __bf16 bf16x2_t __attribute__((ext_vector_type(2)));
typedef LAS unsigned char* ldsp;

constexpr int MP = 65536, MS = 2048, MT = MP + MS;
constexpr int DM = 1024, NPROJ = 2048, QW = 1280, AOW = 1024, FF = 2816, GUW = 2 * FF;
constexpr int C_Z = 0, C_XBC = 512, C_CQ = 1536, C_CKV = 1792, C_KR = 1920, C_DT = 1952;
constexpr float EPS = 1e-6f;
constexpr float QSCALE = 0.10206207261596577f * 1.4426950408889634f;
constexpr int TKP = 2048, TKS = 1088;

constexpr size_t O_YP = 0, O_YS = O_YP + (size_t)MP * DM, O_CKVP = O_YS + (size_t)MS * DM, O_KRP = O_CKVP + (size_t)2 * 32 * 2048 * 128,
                 O_SSMP = O_KRP + (size_t)2 * 32 * 2048 * 32, O_CONVP = O_SSMP + (size_t)2 * 32 * 8 * 64 * 128, O_CKVS = O_CONVP + (size_t)2 * 32 * 3 * 1024,
                 O_KRS = O_CKVS + (size_t)2 * 32 * 64 * 128, O_SSMS = O_KRS + (size_t)2 * 32 * 64 * 32, O_CONVS = O_SSMS + (size_t)2 * 32 * 8 * 64 * 128,
                 O_END = O_CONVS + (size_t)2 * 32 * 3 * 1024;
constexpr size_t MiB = 1u << 20;
constexpr size_t WS_SSQ = 1 * MiB, WS_ROPE = 4 * MiB, WS_W = 8 * MiB, W_LAYER = 25 * MiB;
constexpr size_t WO_IN = 0, WO_Q = 4 * MiB, WO_UV = 4 * MiB + 640 * 1024, WO_OUT = 5 * MiB, WO_GU = 8 * MiB, WO_DN = 19 * MiB;
constexpr size_t WS_KP = 64 * MiB, WS_VTP = 84 * MiB, WS_KS = 100 * MiB, KS_LAYER = 11 * MiB, WS_VTS = 122 * MiB, VTS_LAYER = 9 * MiB;
constexpr size_t WS_XB = 144 * MiB, WS_AO = 276 * MiB, WS_PROJ = 474 * MiB, WS_Q = 738 * MiB, WS_H = WS_PROJ, WS_HALO = 903 * MiB, WS_END = 910 * MiB;
static_assert((size_t)MT * DM * 2 <= WS_AO - WS_XB && (size_t)MT * AOW * 2 <= WS_PROJ - WS_AO && (size_t)MT * NPROJ * 2 <= WS_Q - WS_PROJ && (size_t)MT * QW * 2 <= WS_HALO - WS_Q && (size_t)MT * FF * 2 <= WS_HALO - WS_H && (size_t)1056 * 3 * 1024 * 2 <= WS_END - WS_HALO, "ws map");
static_assert((size_t)32 * TKS * 160 * 2 <= KS_LAYER && (size_t)32 * 128 * TKS * 2 <= VTS_LAYER && (size_t)32 * TKP * 160 * 2 <= WS_VTP - WS_KP && (size_t)32 * 128 * TKP * 2 <= WS_KS - WS_VTP, "ws map 2");
constexpr int SQ_X0 = 0, SQ_X1 = 1, SQ_X2 = 2, SQ_Q0 = 3, SQ_SSD0 = 5, SQ_FFN0 = 7, SQ_N = 9;
static_assert((size_t)SQ_N * MT * 4 <= WS_ROPE - WS_SSQ, "ssq");

constexpr int LDS_BYTES = 147456;
#ifndef REP_ATT
#define REP_ATT 1
#endif
#ifndef REP_GU
#define REP_GU 1
#endif
constexpr int NPH = 16;

DI unsigned cvtpk(float lo, float hi) { f32x2_t v = {lo, hi}; bf16x2_t b = __builtin_convertvector(v, bf16x2_t); return __builtin_bit_cast(unsigned, b); }
DI bf16_t f2bf(float f) { return (bf16_t)(cvtpk(f, 0.f) & 0xffffu); }
DI float bf2f(bf16_t v) { return __uint_as_float((unsigned)v << 16); }
DI float bflo(unsigned w) { return __uint_as_float(w << 16); }
DI float bfhi(unsigned w) { return __uint_as_float(w & 0xffff0000u); }
DI u32x4 pack8(const float* v) { u32x4 w; w.x = cvtpk(v[0], v[1]); w.y = cvtpk(v[2], v[3]); w.z = cvtpk(v[4], v[5]); w.w = cvtpk(v[6], v[7]); return w; }
DI void unpack8(u32x4 w, float* v) { v[0] = bflo(w.x); v[1] = bfhi(w.x); v[2] = bflo(w.y); v[3] = bfhi(w.y); v[4] = bflo(w.z); v[5] = bfhi(w.z); v[6] = bflo(w.w); v[7] = bfhi(w.w); }
DI bf16x8 lds_r16(ldsp p) { return *(const LAS bf16x8*)p; }
DI void lds_w16(ldsp p, u32x4 v) { *(LAS u32x4*)p = v; }
DI int crow(int r, int hi) { return (r & 3) + 8 * (r >> 2) + 4 * hi; }
DI float wave_sum(float v) {
#pragma unroll
    for (int o = 1; o < 64; o <<= 1) v += __shfl_xor(v, o);
    return v;
}
DI float sigmoidf_(float x) { return __builtin_amdgcn_rcpf(1.f + __expf(-x)); }
#define MFMA32(a, b, c) __builtin_amdgcn_mfma_f32_32x32x16_bf16((a), (b), (c), 0, 0, 0)
#define LDS_WAIT() asm volatile("s_waitcnt lgkmcnt(0)" ::: "memory")

namespace pg8 {
constexpr int BM = 256, BK = 64, HALF = 128, HTB = HALF * BK * 2, STAGE_BYTES = 8 * HTB, NXCD = 8, WGM = 8;
DI int lds_byte(int r, int c) { const int st = (r >> 4) * 2 + (c >> 5), rr = r & 15, cc = c & 31, ob = rr * 64 + cc * 2; return st * 1024 + (ob ^ (((ob >> 9) & 1) << 5)); }
DI void stage_rc(int b, int& R, int& C) { const int st = b / 1024, sb = b % 1024, swz = sb ^ (((sb >> 9) & 1) << 5); R = (st >> 1) * 16 + swz / 64; C = (st & 1) * 32 + (swz % 64) / 2; }
DI int perm32(int rho) { const int n = rho >> 4, i = rho & 15; return 8 * (i >> 2) + 4 * n + (i & 3); }
struct Unit { int pm, pn; };
struct Gemm { const bf16_t* A; const bf16_t* Bt; int M, N, K, lda, ldb; };
struct StaticOrder {
    int nM, nN, nwg, G, c;
    DI void init(int M, int N, int G_, int c_) { nM = M / BM; nN = N / BM; nwg = nM * nN; G = G_; c = c_; }
    DI bool next(int i, Unit& u) const {
        const long L = (long)i * G + c; if (L >= nwg) return false;
        int wgid = (int)L; { const int q = nwg / NXCD, r = nwg % NXCD, xcd = wgid % NXCD, off = wgid / NXCD; wgid = (xcd < r ? xcd * (q + 1) : r * (q + 1) + (xcd - r) * q) + off; }
        const int nig = WGM * nN, gid = wgid / nig, fm = gid * WGM, gsz = (nM - fm) < WGM ? (nM - fm) : WGM;
        u.pm = fm + ((wgid % nig) % gsz); u.pn = (wgid % nig) / gsz; return true;
    }
};
template <class Epi, bool ALIGN_EPI>
DI void gemm_phase(ldsp lds, const Gemm g, const StaticOrder& S, const Epi& E) {
    int tid_ = threadIdx.x; asm volatile("" : "+v"(tid_));
    const int tid = tid_, wid = __builtin_amdgcn_readfirstlane(tid >> 6), lane = tid & 63, wr = wid >> 2, wc = wid & 3, fr = lane & 15, fq = lane >> 4;
    const int K = g.K, nt = K / BK;
    unsigned voffA[2], voffB[2];
#pragma unroll
    for (int i = 0; i < 2; ++i) { int R, C; stage_rc(tid * 16 + i * 8192, R, C); const int Rb = Epi::PERM ? ((R & ~31) + perm32(R & 31)) : R;
        voffA[i] = (unsigned)(R * g.lda + C) * 2u; voffB[i] = (unsigned)(Rb * g.ldb + C) * 2u; }
    const size_t kstep = (size_t)(BK * 2);
    const size_t hstepA = (size_t)HALF * g.lda * 2, hstepB = (size_t)HALF * g.ldb * 2;
    const size_t tstepA = 2 * hstepA, tstepB = 2 * hstepB;
    const unsigned ldsw = (unsigned)wid * 1024u;
    const int aoff = lds_byte(wr * 64 + fr, fq * 8), boff = lds_byte(wc * 32 + fr, fq * 8);
#define PG8_SA(b, h) (((b) * 2 + (h)) * HTB)
#define PG8_SB(b, h) ((4 + (b) * 2 + (h)) * HTB)
#define PG8_STAGE(bufoff, gbase, voff) do { _Pragma("unroll") for (int _i = 0; _i < 2; ++_i) \
        __builtin_amdgcn_global_load_lds((const unsigned*)((const char*)(gbase) + (voff)[_i]), (LAS unsigned*)(lds + (bufoff) + ldsw + _i * 8192), 16, 0, 0); } while (0)
#define PG8_LDA(dst, b, h) do { _Pragma("unroll") for (int m = 0; m < 4; ++m) _Pragma("unroll") for (int k = 0; k < 2; ++k) dst[m][k] = *(const LAS bf16x8*)(lds + PG8_SA(b, h) + aoff + m * 2048 + k * 1024); } while (0)
#define PG8_LDB(dst, b, h) do { _Pragma("unroll") for (int n = 0; n < 2; ++n) _Pragma("unroll") for (int k = 0; k < 2; ++k) dst[n][k] = *(const LAS bf16x8*)(lds + PG8_SB(b, h) + boff + n * 2048 + k * 1024); } while (0)
#define PG8_MMA(ai, bj, At, Bt) do { __builtin_amdgcn_s_setprio(1); _Pragma("unroll") for (int m = 0; m < 4; ++m) _Pragma("unroll") for (int n = 0; n < 2; ++n) _Pragma("unroll") for (int k = 0; k < 2; ++k) \
        acc[ai][bj][m][n] = __builtin_amdgcn_mfma_f32_16x16x32_bf16(Bt[n][k], At[m][k], acc[ai][bj][m][n], 0, 0, 0); __builtin_amdgcn_s_setprio(0); } while (0)
#define PG8_WAIT_V(n) asm volatile("s_waitcnt vmcnt(" #n ")" ::: "memory")
#define PG8_WAIT_L(n) asm volatile("s_waitcnt lgkmcnt(" #n ")" ::: "memory")
#define PG8_BAR __builtin_amdgcn_s_barrier()
#define PG8_SCHED __builtin_amdgcn_sched_barrier(0)
    Unit cur, nxt; int ui = 0;
    if (!S.next(0, cur)) return;
    f32x4 acc[2][2][4][2];
#pragma unroll
    for (int a = 0; a < 2; ++a)
#pragma unroll
        for (int b = 0; b < 2; ++b)
#pragma unroll
            for (int m = 0; m < 4; ++m)
#pragma unroll
                for (int n = 0; n < 2; ++n) acc[a][b][m][n] = (f32x4){0.f, 0.f, 0.f, 0.f};
    bf16x8 At[4][2], B0[2][2], B1[2][2];
    const char* cA = (const char*)g.A + (size_t)cur.pm * tstepA; const char* cB = (const char*)g.Bt + (size_t)cur.pn * tstepB;
    PG8_STAGE(PG8_SB(0, 0), cB, voffB); PG8_STAGE(PG8_SB(0, 1), cB + hstepB, voffB); PG8_STAGE(PG8_SA(0, 0), cA, voffA); PG8_STAGE(PG8_SA(0, 1), cA + hstepA, voffA);
    if (wr == 1) PG8_BAR;
    PG8_WAIT_V(2); PG8_BAR;
    PG8_STAGE(PG8_SB(1, 0), cB + kstep, voffB); PG8_STAGE(PG8_SA(1, 0), cA + kstep, voffA); PG8_STAGE(PG8_SB(1, 1), cB + hstepB + kstep, voffB);
    PG8_WAIT_V(6); PG8_BAR;
    for (;;) {
        const bool has_next = S.next(ui + 1, nxt);
        const char* nA = has_next ? (const char*)g.A + (size_t)nxt.pm * tstepA : cA; const char* nB = has_next ? (const char*)g.Bt + (size_t)nxt.pn * tstepB : cB;
        for (int t = 0; t < nt; t += 2) {
            const bool last = (t == nt - 2);
            const char* a1 = cA + (size_t)(t + 1) * kstep;
            const char* a2 = last ? nA : cA + (size_t)(t + 2) * kstep; const char* b2 = last ? nB : cB + (size_t)(t + 2) * kstep;
            const char* a3 = a2 + kstep; const char* b3 = b2 + kstep;
            PG8_LDB(B0, 0, 0); PG8_LDB(B1, 0, 1); PG8_SCHED; PG8_LDA(At, 0, 0); PG8_STAGE(PG8_SA(1, 1), a1 + hstepA, voffA);
            PG8_WAIT_V(8); PG8_WAIT_L(0); PG8_BAR; PG8_MMA(0, 0, At, B0); PG8_MMA(0, 1, At, B1); PG8_BAR; PG8_SCHED;
            PG8_LDA(At, 0, 1); PG8_STAGE(PG8_SB(0, 0), b2, voffB); PG8_STAGE(PG8_SB(0, 1), b2 + hstepB, voffB); PG8_STAGE(PG8_SA(0, 0), a2, voffA);
            PG8_WAIT_V(8); PG8_WAIT_L(0); PG8_BAR; PG8_MMA(1, 0, At, B0); PG8_MMA(1, 1, At, B1); PG8_BAR; PG8_SCHED;
            PG8_LDB(B0, 1, 0); PG8_LDB(B1, 1, 1); PG8_SCHED; PG8_LDA(At, 1, 0); PG8_STAGE(PG8_SA(0, 1), a2 + hstepA, voffA);
            PG8_WAIT_V(8); PG8_WAIT_L(0); PG8_BAR; PG8_MMA(0, 0, At, B0); PG8_MMA(0, 1, At, B1); PG8_BAR; PG8_SCHED;
            PG8_LDA(At, 1, 1); PG8_STAGE(PG8_SB(1, 0), b3, voffB); PG8_STAGE(PG8_SB(1, 1), b3 + hstepB, voffB); PG8_STAGE(PG8_SA(1, 0), a3, voffA);
            PG8_WAIT_V(8); PG8_WAIT_L(0); PG8_BAR; PG8_MMA(1, 0, At, B0); PG8_MMA(1, 1, At, B1); PG8_BAR; PG8_SCHED;
        }
        if constexpr (ALIGN_EPI) { if (wr == 0) PG8_BAR; }
        E(acc, cur, wr, wc, fr, fq);
        if (!has_next) break;
#pragma unroll
        for (int a = 0; a < 2; ++a)
#pragma unroll
            for (int b = 0; b < 2; ++b)
#pragma unroll
                for (int m = 0; m < 4; ++m)
#pragma unroll
                    for (int n = 0; n < 2; ++n) acc[a][b][m][n] = (f32x4){0.f, 0.f, 0.f, 0.f};
        cur = nxt; cA = nA; cB = nB; ++ui;
        if constexpr (ALIGN_EPI) { if (wr == 1) PG8_BAR; }
    }
    PG8_WAIT_V(0);
    if constexpr (!ALIGN_EPI) { if (wr == 0) PG8_BAR; }
    PG8_BAR;
#undef PG8_SA
#undef PG8_SB
#undef PG8_STAGE
#undef PG8_LDA
#undef PG8_LDB
#undef PG8_MMA
#undef PG8_WAIT_V
#undef PG8_WAIT_L
#undef PG8_BAR
#undef PG8_SCHED
}
}
using pg8::Unit;
typedef const f32x4 (&AccRef)[2][2][4][2];

DI float dot4(f32x4 v) { return (v[0] * v[0] + v[1] * v[1]) + (v[2] * v[2] + v[3] * v[3]); }
DI u32x4 pack44(f32x4 a, f32x4 b) { u32x4 w; w.x = cvtpk(a[0], a[1]); w.y = cvtpk(a[2], a[3]); w.z = cvtpk(b[0], b[1]); w.w = cvtpk(b[2], b[3]); return w; }

struct EpiInproj {
    static constexpr bool PERM = true;
    bf16_t* O; const float* ssqx; float* ssqq; bf16_t* halo;
    DI void operator()(AccRef acc, const Unit& u, int wr, int wc, int fr, int fq) const {
        { int t_ = threadIdx.x; asm volatile("" : "+v"(t_)); fr = t_ & 15; fq = (t_ >> 4) & 3; }
        const int col0 = u.pn * 256 + wc * 32 + 8 * fq;
        float rr[2][4];
#pragma unroll
        for (int ai = 0; ai < 2; ++ai)
#pragma unroll
            for (int m = 0; m < 4; ++m) rr[ai][m] = ssqx[u.pm * 256 + ai * 128 + wr * 64 + m * 16 + fr];
#pragma unroll
        for (int ai = 0; ai < 2; ++ai)
#pragma unroll
            for (int m = 0; m < 4; ++m) {
                const int row = u.pm * 256 + ai * 128 + wr * 64 + m * 16 + fr;
                const float r = __builtin_amdgcn_rsqf(rr[ai][m] * (1.f / 1024.f) + EPS);
                float s = 0.f;
#pragma unroll
                for (int bj = 0; bj < 2; ++bj) { const f32x4 v0 = acc[ai][bj][m][0] * r, v1 = acc[ai][bj][m][1] * r; s += dot4(v0) + dot4(v1);
                    const u32x4 pk = pack44(v0, v1); *(u32x4*)(O + (size_t)row * NPROJ + col0 + bj * 128) = pk;
                    if (u.pn >= 2 && u.pn < 6 && (row & 63) >= 61) *(u32x4*)(halo + ((size_t)(row >> 6) * 3 + (row & 63) - 61) * 1024 + col0 + bj * 128 - C_XBC) = pk; }
                if (u.pn == 6) { s += __shfl_xor(s, 16); s += __shfl_xor(s, 32); if (fq == 0) unsafeAtomicAdd(ssqq + row, s); }
                asm volatile("" ::: "memory");
            }
    }
};
struct EpiQ {
    static constexpr bool PERM = false;
    bf16_t* Q; const float* ssqq; const float* rope;
    DI void operator()(AccRef acc, const Unit& u, int wr, int wc, int fr, int fq) const {
        { int t_ = threadIdx.x; asm volatile("" : "+v"(t_)); fr = t_ & 15; fq = (t_ >> 4) & 3; }
        float rr[2][4];
#pragma unroll
        for (int ai = 0; ai < 2; ++ai)
#pragma unroll
            for (int m = 0; m < 4; ++m) rr[ai][m] = ssqq[u.pm * 256 + ai * 128 + wr * 64 + m * 16 + fr];
#pragma unroll
        for (int ai = 0; ai < 2; ++ai)
#pragma unroll
            for (int m = 0; m < 4; ++m) {
                const int row = u.pm * 256 + ai * 128 + wr * 64 + m * 16 + fr;
                const float r = __builtin_amdgcn_rsqf(rr[ai][m] * (1.f / 256.f) + EPS);
                bf16_t* qr = Q + (size_t)row * QW + u.pn * 256 + wc * 32 + 4 * fq;
                if (u.pn < 4) {
#pragma unroll
                    for (int bj = 0; bj < 2; ++bj)
#pragma unroll
                        for (int n = 0; n < 2; ++n) { const f32x4 v = acc[ai][bj][m][n] * r; u32x2 w; w.x = cvtpk(v[0], v[1]); w.y = cvtpk(v[2], v[3]); *(u32x2*)(qr + bj * 128 + n * 16) = w; }
                } else {
                    const int pos = row < MP ? (row & 2047) : 1024 + ((row - MP) & 63);
                    const f32x4 cs = *(const f32x4*)(rope + pos * 32 + 4 * fq), sn = *(const f32x4*)(rope + pos * 32 + 16 + 4 * fq);
#pragma unroll
                    for (int bj = 0; bj < 2; ++bj) { const f32x4 x1 = acc[ai][bj][m][0] * r, x2 = acc[ai][bj][m][1] * r; const f32x4 o1 = x1 * cs - x2 * sn, o2 = x1 * sn + x2 * cs;
                        u32x2 w; w.x = cvtpk(o1[0], o1[1]); w.y = cvtpk(o1[2], o1[3]); *(u32x2*)(qr + bj * 128) = w; w.x = cvtpk(o2[0], o2[1]); w.y = cvtpk(o2[2], o2[3]); *(u32x2*)(qr + bj * 128 + 16) = w; }
                }
                asm volatile("" ::: "memory");
            }
    }
};
struct EpiRes {
    static constexpr bool PERM = true;
    bf16_t* XB; const float* ssq_scale; float* ssq_next;
    DI void operator()(AccRef acc, const Unit& u, int wr, int wc, int fr, int fq) const {
        { int t_ = threadIdx.x; asm volatile("" : "+v"(t_)); fr = t_ & 15; fq = (t_ >> 4) & 3; }
        const int col0 = u.pn * 256 + wc * 32 + 8 * fq;
        float rr[2][4];
#pragma unroll
        for (int ai = 0; ai < 2; ++ai)
#pragma unroll
            for (int m = 0; m < 4; ++m) rr[ai][m] = ssq_scale ? ssq_scale[u.pm * 256 + ai * 128 + wr * 64 + m * 16 + fr] : 0.f;
#pragma unroll
        for (int ai = 0; ai < 2; ++ai) {
            u32x4 bw[4][2];
#pragma unroll
            for (int m = 0; m < 4; ++m)
#pragma unroll
                for (int bj = 0; bj < 2; ++bj) bw[m][bj] = *(const u32x4*)(XB + (size_t)(u.pm * 256 + ai * 128 + wr * 64 + m * 16 + fr) * DM + col0 + bj * 128);
#pragma unroll
            for (int m = 0; m < 4; ++m) {
                const int row = u.pm * 256 + ai * 128 + wr * 64 + m * 16 + fr;
                const float rs = ssq_scale ? __builtin_amdgcn_rsqf(rr[ai][m] * (1.f / 512.f) + EPS) : 1.f;
                float s = 0.f;
#pragma unroll
                for (int bj = 0; bj < 2; ++bj) { bf16_t* xp = XB + (size_t)row * DM + col0 + bj * 128;
                    const u32x4 w4 = bw[m][bj];
                    const f32x4 b0 = {bflo(w4.x), bfhi(w4.x), bflo(w4.y), bfhi(w4.y)}, b1 = {bflo(w4.z), bfhi(w4.z), bflo(w4.w), bfhi(w4.w)};
                    const f32x4 v0 = b0 + acc[ai][bj][m][0] * rs, v1 = b1 + acc[ai][bj][m][1] * rs; s += dot4(v0) + dot4(v1);
                    *(u32x4*)xp = pack44(v0, v1); }
                s += __shfl_xor(s, 16); s += __shfl_xor(s, 32); if (fq == 0) unsafeAtomicAdd(ssq_next + row, s);
            }
            asm volatile("" ::: "memory");
        }
    }
};
struct EpiGU {
    static constexpr bool PERM = true;
    bf16_t* H; const float* ssq;
    DI void operator()(AccRef acc, const Unit& u, int wr, int wc, int fr, int fq) const {
        { int t_ = threadIdx.x; asm volatile("" : "+v"(t_)); fr = t_ & 15; fq = (t_ >> 4) & 3; }
        const int col0 = u.pn * 128 + wc * 32 + 8 * fq;
        float rr[2][4];
#pragma unroll
        for (int ai = 0; ai < 2; ++ai)
#pragma unroll
            for (int m = 0; m < 4; ++m) rr[ai][m] = ssq[u.pm * 256 + ai * 128 + wr * 64 + m * 16 + fr];
#pragma unroll
        for (int ai = 0; ai < 2; ++ai)
#pragma unroll
            for (int m = 0; m < 4; ++m) {
                const int row = u.pm * 256 + ai * 128 + wr * 64 + m * 16 + fr;
                const float r = __builtin_amdgcn_rsqf(rr[ai][m] * (1.f / 1024.f) + EPS);
                f32x4 h[2];
#pragma unroll
                for (int n = 0; n < 2; ++n) { const f32x4 gt = acc[ai][0][m][n] * r, up = acc[ai][1][m][n] * r, tt = acc[ai][0][m][n] * (r * -1.4426950408889634f);
                    f32x4 e;
#pragma unroll
                    for (int j = 0; j < 4; ++j) e[j] = __builtin_amdgcn_exp2f(tt[j]);
                    const f32x4 d = e + 1.f; f32x4 rc;
#pragma unroll
                    for (int j = 0; j < 4; ++j) rc[j] = __builtin_amdgcn_rcpf(d[j]);
                    h[n] = (gt * rc) * up; }
                *(u32x4*)(H + (size_t)row * FF + col0) = pack44(h[0], h[1]);
                asm volatile("" ::: "memory");
            }
    }
};

struct Args { const float* in[25]; float* out; unsigned char* ws; int ph_lo, ph_hi; };
struct Frame {
    ldsp lds; int tid, lane, wave, G, bid;
    const float* const* in; float* out; unsigned char* ws;
    DI float* ssq(int i) const { return (float*)(ws + WS_SSQ) + (size_t)i * MT; }
    DI bf16_t* wt(int l, size_t off) const { return (bf16_t*)(ws + WS_W + (size_t)l * W_LAYER + off); }
};
enum { I_XP = 0, I_XS, I_CCKV, I_CKR, I_SSM, I_CONV, I_WIN, I_WUQ, I_WUK, I_WUV, I_WOUT, I_NMIX, I_QN, I_KVN, I_SSDN, I_CW, I_CB, I_DTB, I_ALOG, I_DSKIP, I_NFFN, I_WG, I_WU, I_WD, I_NFIN };

DI void transpose_item(const float* W, int Nsrc, int sc, const float* gain, float gscale, bf16_t* WT, int ldk, int n0, int k0, LAS float* scr, int lane) {
    float tv[32];
#pragma unroll
    for (int i = 0; i < 32; ++i) { const int kk = 2 * i + (lane >> 5); tv[i] = sc >= 0 ? W[(size_t)(k0 + kk) * Nsrc + sc] : 0.f; }
#pragma unroll
    for (int i = 0; i < 32; ++i) { const int kk = 2 * i + (lane >> 5); scr[kk * 33 + (lane & 31)] = tv[i] * (gain ? gain[k0 + kk] : 1.f) * gscale; }
    LDS_WAIT(); asm volatile("" ::: "memory");
    const int c = lane & 7;
#pragma unroll
    for (int j = 0; j < 4; ++j) { const int n = (lane >> 3) + 8 * j; const LAS float* s = scr + (8 * c) * 33 + n;
        u32x4 o; o.x = cvtpk(s[0 * 33], s[1 * 33]); o.y = cvtpk(s[2 * 33], s[3 * 33]); o.z = cvtpk(s[4 * 33], s[5 * 33]); o.w = cvtpk(s[6 * 33], s[7 * 33]);
        *(u32x4*)(WT + (size_t)(n0 + n) * ldk + k0 + 8 * c) = o; }
    LDS_WAIT(); asm volatile("" ::: "memory");
}
DI int src_col_in(int n) { return n < 1536 ? n : n < 1792 ? 1544 + (n - 1536) : n < 1920 ? 1800 + (n - 1792) : n < 1952 ? 1928 + (n - 1920) : n < 1960 ? 1536 + (n - 1952) : -1; }

DI void kv_write_tile(const Frame& F, bf16_t* Kdst, bf16_t* VTdst, int ldvt) {
    int tid = threadIdx.x; asm volatile("" : "+v"(tid)); ldsp T = F.lds;
#pragma unroll
    for (int rr = 0; rr < 3; ++rr) { const int i = tid + rr * 512; if (i < 1280) { const int row = i / 20, pc = i % 20;
        *(u32x4*)(Kdst + (size_t)row * 160 + 8 * pc) = *(const LAS u32x4*)(T + row * 336 + 16 * pc); } }
    const int d = tid >> 2, g = tid & 3;
    const LAS bf16_t* col = (const LAS bf16_t*)T + d;
    unsigned w[8];
#pragma unroll
    for (int hh = 0; hh < 2; ++hh)
#pragma unroll
        for (int a = 0; a < 2; ++a)
#pragma unroll
            for (int i2 = 0; i2 < 2; ++i2) { const int k0 = 16 * g + 8 * a + 4 * hh + 2 * i2;
                w[hh * 4 + a * 2 + i2] = (unsigned)col[(size_t)k0 * 168] | ((unsigned)col[(size_t)(k0 + 1) * 168] << 16); }
    bf16_t* vp = VTdst + (size_t)d * ldvt + 16 * g;
    *(u32x4*)vp = (u32x4){w[0], w[1], w[2], w[3]}; *(u32x4*)(vp + 8) = (u32x4){w[4], w[5], w[6], w[7]};
}

DI void p0_prologue(const Frame& F) {
    const int gw = F.bid * 8 + F.wave, NGW = F.G * 8, gt = F.bid * 512 + F.tid, NT = F.G * 512;
    { float* z = F.ssq(1); for (size_t i = gt; i < (size_t)(SQ_N - 1) * MT; i += NT) z[i] = 0.f; }
    for (int i = gt; i < 2048 * 16; i += NT) { const int pos = i >> 4, j = i & 15;
        const double inv = exp(-9.210340371976184 * (double)j / 16.0), ang = (double)pos * inv;
        const double kq = rint(ang * 0.15915494309189535), x = ang - kq * 6.283185307179586, x2 = x * x;
        double ts = x, sn = x, tc = 1.0, cs = 1.0;
        for (int n = 1; n <= 14; ++n) { tc *= -x2 / (double)((2 * n - 1) * (2 * n)); cs += tc; ts *= -x2 / (double)((2 * n) * (2 * n + 1)); sn += ts; }
        float* rt = (float*)(F.ws + WS_ROPE); rt[pos * 32 + j] = (float)cs; rt[pos * 32 + 16 + j] = (float)sn; }
    LAS float* scr = (LAS float*)(F.lds + F.wave * 16384);
    constexpr int I_IN = 16 * 64, I_GU = 16 * 176, I_DN = 44 * 32, I_OS = 16 * 32, I_QR = 4 * 8, I_L = I_IN + I_GU + I_DN + I_OS + I_QR;
    const int l31 = F.lane & 31;
    for (int it = gw; it < 2 * I_L; it += NGW) {
        const int l = it / I_L; int r = it % I_L;
        if (r < I_IN) { const int kb = r / 64, nb = r % 64; transpose_item(F.in[I_WIN] + (size_t)l * 1024 * 1960, 1960, src_col_in(nb * 32 + l31), F.in[I_NMIX] + l * 1024, 1.f, F.wt(l, WO_IN), 1024, nb * 32, kb * 64, scr, F.lane); continue; } r -= I_IN;
        if (r < I_GU) { const int kb = r / 176, nb = r % 176, n0 = nb * 32, j = n0 >> 8, rr = n0 & 255;
            transpose_item(F.in[rr < 128 ? I_WG : I_WU] + (size_t)l * 1024 * FF, FF, 128 * j + (rr & 127) + l31, F.in[I_NFFN] + l * 1024, 1.f, F.wt(l, WO_GU), 1024, n0, kb * 64, scr, F.lane); continue; } r -= I_GU;
        if (r < I_DN) { const int kb = r / 32, nb = r % 32; transpose_item(F.in[I_WD] + (size_t)l * FF * 1024, 1024, nb * 32 + l31, nullptr, 1.f, F.wt(l, WO_DN), FF, nb * 32, kb * 64, scr, F.lane); continue; } r -= I_DN;
        if (r < I_OS) { const int kb = r / 32, nb = r % 32; transpose_item(F.in[I_WOUT] + (size_t)l * 1024 * 1024, 1024, nb * 32 + l31, kb < 8 ? F.in[I_SSDN] + l * 512 : nullptr, 1.f, F.wt(l, WO_OUT), AOW, nb * 32, kb * 64, scr, F.lane); continue; } r -= I_OS;
        { const int kb = r / 8, h = r % 8; transpose_item(F.in[I_WUQ] + (size_t)l * 256 * 768, 768, h * 96 + 64 + l31, F.in[I_QN] + l * 256, QSCALE, F.wt(l, WO_Q), 256, 1024 + h * 32, kb * 64, scr, F.lane); }
    }
    for (int idx = gt; idx < 2 * 1024 * 256; idx += NT) { const int k = idx & 255, n = (idx >> 8) & 1023, l = idx >> 18, h = n >> 7, lq = n & 127;
        const float* uq = F.in[I_WUQ] + (size_t)l * 256 * 768 + (size_t)k * 768 + h * 96; const float* uk = F.in[I_WUK] + (size_t)l * 128 * 512 + lq * 512 + h * 64;
        float s = 0.f;
#pragma unroll
        for (int d4 = 0; d4 < 16; ++d4) { const f32x4 a = ((const f32x4*)uq)[d4], bq = ((const f32x4*)uk)[d4]; s += (a[0] * bq[0] + a[1] * bq[1]) + (a[2] * bq[2] + a[3] * bq[3]); }
        F.wt(l, WO_Q)[(size_t)n * 256 + k] = f2bf(s * F.in[I_QN][l * 256 + k] * QSCALE); }
    for (int idx = gt; idx < 2 * 8 * 64 * 128; idx += NT) { const int pos = idx & 127, dv = (idx >> 7) & 63, h = (idx >> 13) & 7, l = idx >> 16;
        const int G = pos >> 4, hh = (pos >> 3) & 1, a = (pos >> 2) & 1, i = pos & 3, d = 16 * G + 8 * a + 4 * hh + i;
        F.wt(l, WO_UV)[(size_t)(h * 64 + dv) * 128 + pos] = f2bf(F.in[I_WUV][(size_t)l * 128 * 512 + (size_t)d * 512 + h * 64 + dv]); }
    { float* sq = F.ssq(SQ_X0); bf16_t* XB = (bf16_t*)(F.ws + WS_XB);
      for (int row4 = gw * 4; row4 < MT; row4 += NGW * 4) {
        f32x4 v[4][4];
#pragma unroll
        for (int q = 0; q < 4; ++q) { const int row = row4 + q; const float* xr = row < MP ? F.in[I_XP] + (size_t)row * DM : F.in[I_XS] + (size_t)(row - MP) * DM;
#pragma unroll
            for (int j = 0; j < 4; ++j) v[q][j] = ((const f32x4*)xr)[F.lane + 64 * j]; }
#pragma unroll
        for (int q = 0; q < 4; ++q) { const int row = row4 + q; float s = 0.f;
#pragma unroll
            for (int j = 0; j < 4; ++j) { s += dot4(v[q][j]); u32x2 w; w.x = cvtpk(v[q][j][0], v[q][j][1]); w.y = cvtpk(v[q][j][2], v[q][j][3]); ((u32x2*)(XB + (size_t)row * DM))[F.lane + 64 * j] = w; }
            s = wave_sum(s);
            if (F.lane == 0) sq[row] = s; } } }
    __syncthreads();
    for (int u = F.bid; u < 2 * 32 * 16; u += F.G) { const int l = u >> 9, b = (u >> 4) & 31, pb = u & 15;
        const int pos = F.tid >> 3, part = F.tid & 7; const size_t tok = ((size_t)(l * 32 + b) * 1024 + pb * 64 + pos);
        const f32x4* cs = (const f32x4*)(F.in[I_CCKV] + tok * 128 + part * 16); float v[16];
#pragma unroll
        for (int j = 0; j < 4; ++j) { const f32x4 t = cs[j]; v[4 * j] = t[0]; v[4 * j + 1] = t[1]; v[4 * j + 2] = t[2]; v[4 * j + 3] = t[3]; }
        lds_w16(F.lds + pos * 336 + part * 32, pack8(v)); lds_w16(F.lds + pos * 336 + part * 32 + 16, pack8(v + 8));
        const f32x4 kr = *(const f32x4*)(F.in[I_CKR] + tok * 32 + part * 4); u32x2 w; w.x = cvtpk(kr[0], kr[1]); w.y = cvtpk(kr[2], kr[3]);
        *(LAS u32x2*)(F.lds + pos * 336 + 256 + part * 8) = w;
        __syncthreads();
        kv_write_tile(F, (bf16_t*)(F.ws + WS_KS + l * KS_LAYER) + ((size_t)b * TKS + pb * 64) * 160, (bf16_t*)(F.ws + WS_VTS + l * VTS_LAYER) + (size_t)b * 128 * TKS + pb * 64, TKS);
        __syncthreads();
    }
}

DI void kvprep_unit(const Frame& F, int l, int u) {
    const bool smp = u >= 1024; const int b = smp ? u - 1024 : u >> 5, c = smp ? 0 : u & 31, T = smp ? 64 : 2048;
    const size_t row0 = smp ? (size_t)MP + b * 64 : (size_t)b * 2048 + c * 64;
    const bf16_t* PROJ = (const bf16_t*)(F.ws + WS_PROJ);
    int tid_ = threadIdx.x; asm volatile("" : "+v"(tid_));
    const int tk = tid_ >> 3, part = tid_ & 7, t = c * 64 + tk, pos = smp ? 1024 + t : t;
    const bf16_t* pr = PROJ + (row0 + tk) * NPROJ;
    float v[16]; { const u32x4 a = *(const u32x4*)(pr + C_CKV + part * 16), bb = *(const u32x4*)(pr + C_CKV + part * 16 + 8); unpack8(a, v); unpack8(bb, v + 8); }
    float s = 0.f;
#pragma unroll
    for (int i = 0; i < 16; ++i) s += v[i] * v[i];
    s += __shfl_xor(s, 1); s += __shfl_xor(s, 2); s += __shfl_xor(s, 4);
    const float rs = rsqrtf(s * (1.f / 128.f) + EPS); const float* gk = F.in[I_KVN] + l * 128 + part * 16;
#pragma unroll
    for (int i = 0; i < 16; ++i) v[i] = v[i] * rs * gk[i];
    float* ock = F.out + (smp ? O_CKVS + ((size_t)(l * 32 + b) * 64 + t) * 128 : O_CKVP + ((size_t)(l * 32 + b) * 2048 + t) * 128) + part * 16;
#pragma unroll
    for (int j = 0; j < 4; ++j) ((f32x4*)ock)[j] = (f32x4){v[4 * j], v[4 * j + 1], v[4 * j + 2], v[4 * j + 3]};
    lds_w16(F.lds + tk * 336 + part * 32, pack8(v)); lds_w16(F.lds + tk * 336 + part * 32 + 16, pack8(v + 8));
    { const unsigned w1 = *(const unsigned*)(pr + C_KR + 2 * part), w2 = *(const unsigned*)(pr + C_KR + 16 + 2 * part);
      const float* rt = (const float*)(F.ws + WS_ROPE) + pos * 32 + 2 * part;
      const float x1a = bflo(w1), x1b = bfhi(w1), x2a = bflo(w2), x2b = bfhi(w2), ca = rt[0], cb = rt[1], sa = rt[16], sb = rt[17];
      const float o1a = x1a * ca - x2a * sa, o1b = x1b * cb - x2b * sb, o2a = x1a * sa + x2a * ca, o2b = x1b * sb + x2b * cb;
      float* okr = F.out + (smp ? O_KRS + ((size_t)(l * 32 + b) * 64 + t) * 32 : O_KRP + ((size_t)(l * 32 + b) * 2048 + t) * 32);
      *(f32x2_t*)(okr + 2 * part) = (f32x2_t){o1a, o1b}; *(f32x2_t*)(okr + 16 + 2 * part) = (f32x2_t){o2a, o2b};
      *(LAS unsigned*)(F.lds + tk * 336 + 256 + 4 * part) = cvtpk(o1a, o1b); *(LAS unsigned*)(F.lds + tk * 336 + 256 + 32 + 4 * part) = cvtpk(o2a, o2b); }
    __syncthreads();
    if (smp) kv_write_tile(F, (bf16_t*)(F.ws + WS_KS + l * KS_LAYER) + ((size_t)b * TKS + 1024) * 160, (bf16_t*)(F.ws + WS_VTS + l * VTS_LAYER) + (size_t)b * 128 * TKS + 1024, TKS);
    else kv_write_tile(F, (bf16_t*)(F.ws + WS_KP) + ((size_t)b * TKP + c * 64) * 160, (bf16_t*)(F.ws + WS_VTP) + (size_t)b * 128 * TKP + c * 64, TKP);
    __syncthreads();
}

DI void conv_unit(const Frame& F, int l, int u) {
    int tid_ = threadIdx.x; asm volatile("" : "+v"(tid_));
    const int cg = tid_ & 127, rs = tid_ >> 7, ch = 8 * cg;
    const bool smp = u >= 1024; const int b = smp ? u - 1024 : u >> 5, c = smp ? 0 : u & 31;
    bf16_t* PROJ = (bf16_t*)(F.ws + WS_PROJ); const bf16_t* HALO = (const bf16_t*)(F.ws + WS_HALO);
    const size_t row0 = (size_t)u * 64;
    const int tk = tid_ >> 3, part = tid_ & 7, t = c * 64 + tk, pos = smp ? 1024 + t : t;
    const bf16_t* pr = PROJ + (row0 + tk) * NPROJ;
    const u32x4 kva = *(const u32x4*)(pr + C_CKV + part * 16), kvb = *(const u32x4*)(pr + C_CKV + part * 16 + 8);
    const unsigned kw1 = *(const unsigned*)(pr + C_KR + 2 * part), kw2 = *(const unsigned*)(pr + C_KR + 16 + 2 * part);
    u32x4 uu[19];
#pragma unroll
    for (int i = 0; i < 19; ++i) { const int lr = 16 * rs - 3 + i;
        if (lr >= 0) uu[i] = *(const u32x4*)(PROJ + (row0 + lr) * NPROJ + C_XBC + ch);
        else if (c != 0) uu[i] = *(const u32x4*)(HALO + ((size_t)(u - 1) * 3 + (lr + 3)) * 1024 + ch);
        else if (!smp) uu[i] = (u32x4){0u, 0u, 0u, 0u};
        else { const float* sc = F.in[I_CONV] + ((size_t)(l * 32 + b) * 3 + (lr + 3)) * 1024 + ch; float t8[8];
#pragma unroll
            for (int e = 0; e < 8; ++e) t8[e] = sc[e];
            uu[i] = pack8(t8); } }
    if (smp || c == 31) { if (tid_ < 384) { const int k = tid_ >> 7; float t8[8]; unpack8(*(const u32x4*)(HALO + ((size_t)u * 3 + k) * 1024 + ch), t8);
        float* oc = F.out + (smp ? O_CONVS : O_CONVP) + ((size_t)(l * 32 + b) * 3 + k) * 1024 + ch;
        *(f32x4*)oc = (f32x4){t8[0], t8[1], t8[2], t8[3]}; *(f32x4*)(oc + 4) = (f32x4){t8[4], t8[5], t8[6], t8[7]}; } }
    asm volatile("s_waitcnt vmcnt(0)" ::: "memory"); __syncthreads();
    { float v[16]; unpack8(kva, v); unpack8(kvb, v + 8);
      float s = 0.f;
#pragma unroll
      for (int i = 0; i < 16; ++i) s += v[i] * v[i];
      s += __shfl_xor(s, 1); s += __shfl_xor(s, 2); s += __shfl_xor(s, 4);
      const float rsn = rsqrtf(s * (1.f / 128.f) + EPS); const float* gk = F.in[I_KVN] + l * 128 + part * 16;
#pragma unroll
      for (int i = 0; i < 16; ++i) v[i] = v[i] * rsn * gk[i];
      float* ock = F.out + (smp ? O_CKVS + ((size_t)(l * 32 + b) * 64 + t) * 128 : O_CKVP + ((size_t)(l * 32 + b) * 2048 + t) * 128) + part * 16;
#pragma unroll
      for (int j = 0; j < 4; ++j) ((f32x4*)ock)[j] = (f32x4){v[4 * j], v[4 * j + 1], v[4 * j + 2], v[4 * j + 3]};
      lds_w16(F.lds + tk * 336 + part * 32, pack8(v)); lds_w16(F.lds + tk * 336 + part * 32 + 16, pack8(v + 8));
      const float* rt = (const float*)(F.ws + WS_ROPE) + pos * 32 + 2 * part;
      const float x1a = bflo(kw1), x1b = bfhi(kw1), x2a = bflo(kw2), x2b = bfhi(kw2), ca = rt[0], cb2 = rt[1], sa = rt[16], sb = rt[17];
      const float o1a = x1a * ca - x2a * sa, o1b = x1b * cb2 - x2b * sb, o2a = x1a * sa + x2a * ca, o2b = x1b * sb + x2b * cb2;
      float* okr = F.out + (smp ? O_KRS + ((size_t)(l * 32 + b) * 64 + t) * 32 : O_KRP + ((size_t)(l * 32 + b) * 2048 + t) * 32);
      *(f32x2_t*)(okr + 2 * part) = (f32x2_t){o1a, o1b}; *(f32x2_t*)(okr + 16 + 2 * part) = (f32x2_t){o2a, o2b};
      *(LAS unsigned*)(F.lds + tk * 336 + 256 + 4 * part) = cvtpk(o1a, o1b); *(LAS unsigned*)(F.lds + tk * 336 + 256 + 32 + 4 * part) = cvtpk(o2a, o2b); }
    const float* cw = F.in[I_CW] + (size_t)l * 4 * 1024 + ch; const float* cb = F.in[I_CB] + l * 1024 + ch;
#pragma unroll
    for (int half = 0; half < 2; ++half) {
        unsigned rowpk[8][4];
#pragma unroll
        for (int e2 = 0; e2 < 4; ++e2) {
            const f32x2_t w0 = {cw[2 * e2], cw[2 * e2 + 1]}, w1 = {cw[1024 + 2 * e2], cw[1024 + 2 * e2 + 1]}, w2 = {cw[2048 + 2 * e2], cw[2048 + 2 * e2 + 1]}, w3 = {cw[3072 + 2 * e2], cw[3072 + 2 * e2 + 1]}, bs = {cb[2 * e2], cb[2 * e2 + 1]};
#pragma unroll
            for (int i = 0; i < 8; ++i) { const int ii = 8 * half + i;
                const f32x2_t a0 = {bflo(uu[ii][e2]), bfhi(uu[ii][e2])}, a1 = {bflo(uu[ii + 1][e2]), bfhi(uu[ii + 1][e2])}, a2 = {bflo(uu[ii + 2][e2]), bfhi(uu[ii + 2][e2])}, a3 = {bflo(uu[ii + 3][e2]), bfhi(uu[ii + 3][e2])};
                const f32x2_t v = bs + w0 * a0 + w1 * a1 + w2 * a2 + w3 * a3, tt = v * -1.4426950408889634f;
                f32x2_t e; e.x = __builtin_amdgcn_exp2f(tt.x); e.y = __builtin_amdgcn_exp2f(tt.y);
                const f32x2_t d = e + 1.f; f32x2_t rc; rc.x = __builtin_amdgcn_rcpf(d.x); rc.y = __builtin_amdgcn_rcpf(d.y);
                const f32x2_t o2 = v * rc; rowpk[i][e2] = cvtpk(o2.x, o2.y); }
        }
#pragma unroll
        for (int i = 0; i < 8; ++i) *(u32x4*)(PROJ + (row0 + 16 * rs + 8 * half + i) * NPROJ + C_XBC + ch) = (u32x4){rowpk[i][0], rowpk[i][1], rowpk[i][2], rowpk[i][3]};
        if (half == 0) {
            __syncthreads();
            if (smp) kv_write_tile(F, (bf16_t*)(F.ws + WS_KS + l * KS_LAYER) + ((size_t)b * TKS + 1024) * 160, (bf16_t*)(F.ws + WS_VTS + l * VTS_LAYER) + (size_t)b * 128 * TKS + 1024, TKS);
            else kv_write_tile(F, (bf16_t*)(F.ws + WS_KP) + ((size_t)b * TKP + c * 64) * 160, (bf16_t*)(F.ws + WS_VTP) + (size_t)b * 128 * TKP + c * 64, TKP);
        }
    }
    asm volatile("s_waitcnt vmcnt(0)" ::: "memory"); __syncthreads();
}

DI void ssd_unit(const Frame& F, int l, int kind, int b, int hd, bool do_ssq = true) {
    int tid_ = threadIdx.x; asm volatile("" : "+v"(tid_));
    const int tid = tid_, lane = tid & 63, w = F.wave, r = lane & 31, hi = lane >> 5, g = hd >> 2;
    const int nch = kind == 0 ? 32 : 1;
    const size_t rowbase = kind == 0 ? (size_t)b * 2048 : (size_t)MP + b * 64;
    const bf16_t* PROJ = (const bf16_t*)(F.ws + WS_PROJ); bf16_t* AO = (bf16_t*)(F.ws + WS_AO);
    ldsp L = F.lds;
    constexpr int O_CS = 0, O_BS = 17408, O_BWT = 34816, O_XT = 53248, O_XS = 62464, O_WS = 71680, O_HS = 80896, O_YS = 98304, O_DT = 115712, O_CUM = 116224;
    LAS float* dtS = (LAS float*)(L + O_DT); LAS float* cumS = (LAS float*)(L + O_CUM); LAS float* Ys = (LAS float*)(L + O_YS);
    const float Dsk = F.in[I_DSKIP][l * 8 + hd], dtb = F.in[I_DTB][l * 8 + hd], Aneg = -__expf(F.in[I_ALOG][l * 8 + hd]);
    const int pbh = w >> 2, nbh = w & 3;
    f32x16 hacc;
    float* hout = F.out + (kind == 0 ? O_SSMP : O_SSMS) + (size_t)((l * 32 + b) * 8 + hd) * 8192;
    if (kind == 0) {
#pragma unroll
        for (int i = 0; i < 16; ++i) hacc[i] = 0.f;
    } else { const float* h0 = F.in[I_SSM] + (size_t)((l * 32 + b) * 8 + hd) * 8192;
#pragma unroll
        for (int i = 0; i < 16; ++i) hacc[i] = h0[(32 * pbh + crow(i, hi)) * 128 + 32 * nbh + r]; }
#pragma unroll
    for (int i = 0; i < 16; ++i) *(LAS bf16_t*)(L + O_HS + (32 * pbh + crow(i, hi)) * 272 + (32 * nbh + r) * 2) = f2bf(hacc[i]);
    const int lbA = (w & 3) >> 1, sbA = w & 1;
    u32x4 uu[8]; float dtr_n = 0.f;
#define SSD_LOAD_UU(cc) do { const size_t row0_ = rowbase + 64 * (cc); const int cgl = tid >> 3, rsl = tid & 7; \
        const int chl = cgl < 8 ? hd * 64 + 8 * cgl : cgl < 24 ? 512 + g * 128 + 8 * (cgl - 8) : 768 + g * 128 + 8 * (cgl - 24); \
        if (tid < 320) { _Pragma("unroll") for (int i = 0; i < 8; ++i) uu[i] = *(const u32x4*)(PROJ + (row0_ + 8 * rsl + i) * NPROJ + C_XBC + chl); } } while (0)
#define SSD_SCAN(cc) do { const float dtr = dtr_n + dtb; const float dt = dtr > 20.f ? dtr : log1pf(__expf(dtr)); float a = dt * Aneg; \
        _Pragma("unroll") for (int off = 1; off < 64; off <<= 1) { const float t = __shfl_up(a, off); if (lane >= off) a += t; } \
        dtS[((cc) & 1) * 64 + lane] = dt; cumS[((cc) & 1) * 64 + lane] = a; } while (0)
    SSD_LOAD_UU(0);
    if (w == 7) { dtr_n = bf2f(PROJ[(rowbase + lane) * NPROJ + C_DT + hd]); SSD_SCAN(0); }
    __syncthreads();
    for (int c = 0; c < nch; ++c) {
        const size_t row0 = rowbase + 64 * c;
        int tl_ = threadIdx.x; asm volatile("" : "+v"(tl_));
        const int tid = tl_, lane = tid & 63, r = lane & 31, hi = lane >> 5;
        const int cg_ = tid >> 3, rs_ = tid & 7;
        const int ch = cg_ < 8 ? hd * 64 + 8 * cg_ : cg_ < 24 ? 512 + g * 128 + 8 * (cg_ - 8) : 768 + g * 128 + 8 * (cg_ - 24);
        const LAS float* dtC = dtS + (c & 1) * 64; const LAS float* cumC = cumS + (c & 1) * 64;
        const u32x4 zraw = *(const u32x4*)(PROJ + (row0 + (tid >> 3)) * NPROJ + C_Z + hd * 64 + 8 * (tid & 7));
        if (w == 7 && c + 1 < nch) dtr_n = bf2f(PROJ[(row0 + 64 + lane) * NPROJ + C_DT + hd]);
        if (tid < 320) {
            const int l0 = 8 * rs_;
            const bool isB = cg_ >= 8 && cg_ < 24;
            float we[8];
            { const float last = cumC[63];
#pragma unroll
              for (int i = 0; i < 8; ++i) we[i] = isB ? __expf(last - cumC[l0 + i]) * dtC[l0 + i] : 1.f; }
            const ldsp tdst = cg_ < 8 ? L + O_XT + (8 * cg_) * 144 + l0 * 2 : L + O_BWT + (8 * (cg_ - 8)) * 144 + l0 * 2;
            const ldsp rdst = cg_ < 8 ? L + O_XS + l0 * 144 + cg_ * 16 : isB ? L + O_BS + l0 * 272 + (cg_ - 8) * 16 : L + O_CS + l0 * 272 + (cg_ - 24) * 16;
            const int rstride = cg_ < 8 ? 144 : 272;
#pragma unroll
            for (int i = 0; i < 8; ++i) lds_w16(rdst + i * rstride, uu[i]);
            if (cg_ < 24) {
#pragma unroll
                for (int e2 = 0; e2 < 4; ++e2)
#pragma unroll
                    for (int q = 0; q < 2; ++q) { float t8[8];
#pragma unroll
                        for (int i = 0; i < 8; ++i) t8[i] = (q ? bfhi(uu[i][e2]) : bflo(uu[i][e2])) * we[i];
                        lds_w16(tdst + (2 * e2 + q) * 144, pack8(t8)); }
            }
        }
        if (c + 1 < nch) SSD_LOAD_UU(c + 1);
        __syncthreads();
        f32x16 accy;
#pragma unroll
        for (int i = 0; i < 16; ++i) accy[i] = 0.f;
        if (w < 4) {
            if (sbA <= lbA) {
#pragma unroll
                for (int ks = 0; ks < 8; ++ks) { const bf16x8 a = lds_r16(L + O_CS + (32 * lbA + r) * 272 + (16 * ks + 8 * hi) * 2), bb = lds_r16(L + O_BS + (32 * sbA + r) * 272 + (16 * ks + 8 * hi) * 2); accy = MFMA32(a, bb, accy); }
            }
            const int s = 32 * sbA + r; const float cs = cumC[s], ds = dtC[s];
#pragma unroll
            for (int i = 0; i < 16; ++i) { const int ll = 32 * lbA + crow(i, hi); const float val = s <= ll ? __expf(cumC[ll] - cs) * accy[i] * ds : 0.f;
                *(LAS bf16_t*)(L + O_WS + ll * 144 + s * 2) = f2bf(val); }
        } else {
#pragma unroll
            for (int ks = 0; ks < 8; ++ks) { const bf16x8 a = lds_r16(L + O_CS + (32 * lbA + r) * 272 + (16 * ks + 8 * hi) * 2), bb = lds_r16(L + O_HS + (32 * sbA + r) * 272 + (16 * ks + 8 * hi) * 2); accy = MFMA32(a, bb, accy); }
#pragma unroll
            for (int i = 0; i < 16; ++i) accy[i] *= __expf(cumC[32 * lbA + crow(i, hi)]);
        }
        __syncthreads();
        if (w >= 4) {
#pragma unroll
            for (int ks = 0; ks < 4; ++ks) { const bf16x8 a = lds_r16(L + O_WS + (32 * lbA + r) * 144 + (16 * ks + 8 * hi) * 2), bb = lds_r16(L + O_XT + (32 * sbA + r) * 144 + (16 * ks + 8 * hi) * 2); accy = MFMA32(a, bb, accy); }
#pragma unroll
            for (int i = 0; i < 16; ++i) Ys[(32 * lbA + crow(i, hi)) * 68 + 32 * sbA + r] = accy[i];
        }
        { const float el = __expf(cumC[63]);
#pragma unroll
          for (int i = 0; i < 16; ++i) hacc[i] *= el;
#pragma unroll
          for (int ks = 0; ks < 4; ++ks) { const bf16x8 a = lds_r16(L + O_XT + (32 * pbh + r) * 144 + (16 * ks + 8 * hi) * 2), bb = lds_r16(L + O_BWT + (32 * nbh + r) * 144 + (16 * ks + 8 * hi) * 2); hacc = MFMA32(a, bb, hacc); } }
        __syncthreads();
#pragma unroll
        for (int i = 0; i < 16; ++i) *(LAS bf16_t*)(L + O_HS + (32 * pbh + crow(i, hi)) * 272 + (32 * nbh + r) * 2) = f2bf(hacc[i]);
        if (w == 7 && c + 1 < nch) SSD_SCAN(c + 1);
        { const int el = tid >> 3, pg = tid & 7; const size_t row = row0 + el;
          const f32x4 y0 = *(const LAS f32x4*)(Ys + el * 68 + 8 * pg), y1 = *(const LAS f32x4*)(Ys + el * 68 + 8 * pg + 4);
          float xv[8], zv[8], ov[8];
          unpack8(*(const LAS u32x4*)(L + O_XS + el * 144 + pg * 16), xv);
          unpack8(zraw, zv);
          float s = 0.f;
#pragma unroll
          for (int e = 0; e < 8; ++e) { const float y = (e < 4 ? y0[e & 3] : y1[e & 3]) + Dsk * xv[e]; ov[e] = y * zv[e] * sigmoidf_(zv[e]); s += ov[e] * ov[e]; }
          *(u32x4*)(AO + row * AOW + hd * 64 + 8 * pg) = pack8(ov);
          s += __shfl_xor(s, 1); s += __shfl_xor(s, 2); s += __shfl_xor(s, 4);
          if (pg == 0 && do_ssq) unsafeAtomicAdd(F.ssq(SQ_SSD0 + l) + row, s); }
        __syncthreads();
    }
#undef SSD_LOAD_UU
#undef SSD_SCAN
#pragma unroll
    for (int i = 0; i < 16; ++i) hout[(32 * pbh + crow(i, hi)) * 128 + 32 * nbh + r] = hacc[i];
}

DI void attn_unit(const Frame& F, int l, int kind, int b, int c, int hf) {
    int tid_ = threadIdx.x; asm volatile("" : "+v"(tid_));
    const int tid = tid_, lane = tid & 63, w = F.wave, r = lane & 31, hi = lane >> 5;
    size_t rowq0; int nt, ldvt; const bf16_t* Kb; const bf16_t* VTb;
    if (kind == 0) { rowq0 = (size_t)b * 2048 + 64 * c + 32 * hf; nt = c + 1; ldvt = TKP; Kb = (const bf16_t*)(F.ws + WS_KP) + (size_t)b * TKP * 160; VTb = (const bf16_t*)(F.ws + WS_VTP) + (size_t)b * 128 * TKP; }
    else { rowq0 = (size_t)MP + b * 64 + 32 * hf; nt = 17; ldvt = TKS; Kb = (const bf16_t*)(F.ws + WS_KS + l * KS_LAYER) + (size_t)b * TKS * 160; VTb = (const bf16_t*)(F.ws + WS_VTS + l * VTS_LAYER) + (size_t)b * 128 * TKS; }
    ldsp L = F.lds;
    constexpr int KTB = 21504, VTB = 18432, O_K = 0, O_V = 3 * KTB;
    const bf16_t* qrow = (const bf16_t*)(F.ws + WS_Q) + (rowq0 + r) * QW;
    bf16x8 qf[10];
#pragma unroll
    for (int ks = 0; ks < 8; ++ks) qf[ks] = *(const bf16x8*)(qrow + w * 128 + 16 * ks + 8 * hi);
#pragma unroll
    for (int ks = 0; ks < 2; ++ks) qf[8 + ks] = *(const bf16x8*)(qrow + 1024 + w * 32 + 16 * ks + 8 * hi);
    unsigned goff[5];
#pragma unroll
    for (int i = 0; i < 5; ++i) { const int ci = w + 8 * i;
        if (ci < 21) { const int o = ci * 1024 + 16 * lane, row = o / 336; int cb = o % 336; if (cb >= 320) cb = 0; goff[i] = (unsigned)(row * 160 + (cb >> 1)); }
        else { const int o = (ci - 21) * 1024 + 16 * lane, d = o / 144; int cb = o % 144; if (cb >= 128) cb = 0; goff[i] = (unsigned)(d * ldvt + (cb >> 1)); } }
#define ATT_DMA(j, kbuf, vbuf) do { _Pragma("unroll") for (int i = 0; i < 5; ++i) { const int ci = w + 8 * i; \
        if (ci < 21) __builtin_amdgcn_global_load_lds((const unsigned*)(Kb + (size_t)(j) * 64 * 160 + goff[i]), (LAS unsigned*)(L + O_K + (kbuf) * KTB + ci * 1024), 16, 0, 0); \
        else if (ci < 39) __builtin_amdgcn_global_load_lds((const unsigned*)(VTb + (size_t)(j) * 64 + goff[i]), (LAS unsigned*)(L + O_V + (vbuf) * VTB + (ci - 21) * 1024), 16, 0, 0); } } while (0)
    ATT_DMA(0, 0, 0);
    if (nt > 1) ATT_DMA(1, 1, 1);
    f32x16 o[4];
#pragma unroll
    for (int d = 0; d < 4; ++d)
#pragma unroll
        for (int i = 0; i < 16; ++i) o[d][i] = 0.f;
    float mhat = 0.f, lsum = 0.f; f32x16 negm;
#pragma unroll
    for (int i = 0; i < 16; ++i) negm[i] = 0.f;
    f32x16 p0, p1; bf16x8 pb[4];
#define ATT_QK(kbuf) do { const ldsp kb_ = L + O_K + (kbuf) * KTB + r * 336 + 16 * hi; bf16x8 kf[6]; \
        _Pragma("unroll") for (int ks = 0; ks < 3; ++ks) { kf[2 * ks] = lds_r16(kb_ + 32 * ks); kf[2 * ks + 1] = lds_r16(kb_ + 32 * 336 + 32 * ks); } \
        __builtin_amdgcn_sched_barrier(0); \
        _Pragma("unroll") for (int ks = 0; ks < 10; ++ks) { const int sl = ks % 3; \
            if (ks == 0) { p0 = MFMA32(kf[0], qf[0], negm); p1 = MFMA32(kf[1], qf[0], negm); } \
            else { p0 = MFMA32(kf[2 * sl], qf[ks], p0); p1 = MFMA32(kf[2 * sl + 1], qf[ks], p1); } \
            if (ks + 3 < 10) { kf[2 * sl] = lds_r16(kb_ + 32 * (ks + 3)); kf[2 * sl + 1] = lds_r16(kb_ + 32 * 336 + 32 * (ks + 3)); } \
            __builtin_amdgcn_sched_barrier(0); } } while (0)
#define MX3(a, b, c) __builtin_fmaxf(__builtin_fmaxf((a), (b)), (c))
#define ATT_SM() do { float mx = MX3(p0[0], p0[1], p1[0]), mx2 = MX3(p1[1], p0[2], p1[2]); \
        _Pragma("unroll") for (int i = 3; i < 15; i += 2) { mx = MX3(mx, p0[i], p1[i]); mx2 = MX3(mx2, p0[i + 1], p1[i + 1]); } \
        mx = MX3(mx, mx2, p0[15]); mx = fmaxf(mx, p1[15]); \
        mx = fmaxf(mx, __shfl_xor(mx, 32)); \
          \
        if (__builtin_amdgcn_ballot_w64(mx > thr_) != 0ull) { const float dl = fmaxf(mx, flr_); mhat += dl; \
            _Pragma("unroll") for (int i = 0; i < 16; ++i) { p0[i] -= dl; p1[i] -= dl; } \
            _Pragma("unroll") for (int i = 0; i < 16; ++i) negm[i] = -mhat; \
            const float alpha = __builtin_amdgcn_exp2f(fminf(-dl, 60.f)); lsum *= alpha; \
            _Pragma("unroll") for (int d = 0; d < 4; ++d) _Pragma("unroll") for (int i = 0; i < 16; ++i) o[d][i] *= alpha; } \
        float ps = 0.f, ps2 = 0.f; \
        _Pragma("unroll") for (int i = 0; i < 16; ++i) { p0[i] = __builtin_amdgcn_exp2f(p0[i]); p1[i] = __builtin_amdgcn_exp2f(p1[i]); ps += p0[i]; ps2 += p1[i]; } \
        lsum += ps + ps2; \
        _Pragma("unroll") for (int kk = 0; kk < 2; ++kk) { u32x4 t; t.x = cvtpk(p0[8 * kk], p0[8 * kk + 1]); t.y = cvtpk(p0[8 * kk + 2], p0[8 * kk + 3]); t.z = cvtpk(p0[8 * kk + 4], p0[8 * kk + 5]); t.w = cvtpk(p0[8 * kk + 6], p0[8 * kk + 7]); pb[kk] = __builtin_bit_cast(bf16x8, t); \
            t.x = cvtpk(p1[8 * kk], p1[8 * kk + 1]); t.y = cvtpk(p1[8 * kk + 2], p1[8 * kk + 3]); t.z = cvtpk(p1[8 * kk + 4], p1[8 * kk + 5]); t.w = cvtpk(p1[8 * kk + 6], p1[8 * kk + 7]); pb[2 + kk] = __builtin_bit_cast(bf16x8, t); } } while (0)
#define ATT_PV(vbuf) do { const ldsp vb_ = L + O_V + (vbuf) * VTB + r * 144 + 16 * hi; bf16x8 vf[8]; \
        _Pragma("unroll") for (int q = 0; q < 2; ++q) _Pragma("unroll") for (int d = 0; d < 4; ++d) vf[4 * q + d] = lds_r16(vb_ + d * 32 * 144 + q * 32); \
        __builtin_amdgcn_sched_barrier(0); \
        _Pragma("unroll") for (int q = 0; q < 4; ++q) { _Pragma("unroll") for (int d = 0; d < 4; ++d) o[d] = MFMA32(vf[4 * (q & 1) + d], pb[q], o[d]); \
            if (q + 2 < 4) { _Pragma("unroll") for (int d = 0; d < 4; ++d) vf[4 * (q & 1) + d] = lds_r16(vb_ + d * 32 * 144 + (q + 2) * 32); } \
            __builtin_amdgcn_sched_barrier(0); } } while (0)
    asm volatile("s_waitcnt vmcnt(0)\n\ts_barrier" ::: "memory");
    int st = 0;
    for (int j = 0; j < nt; ++j) {
        const int st2 = st == 0 ? 2 : st - 1;
        if (j + 2 < nt) ATT_DMA(j + 2, st2, st2);
        int jz = j; asm volatile("" : "+s"(jz));
        const float thr_ = jz ? 8.f : -3e38f, flr_ = jz ? 0.f : -3e38f;
        ATT_QK(st); ATT_SM(); ATT_PV(st);
        if (j + 2 < nt) { if (w < 7) asm volatile("s_waitcnt vmcnt(5)\n\ts_barrier" ::: "memory"); else asm volatile("s_waitcnt vmcnt(4)\n\ts_barrier" ::: "memory"); }
        else asm volatile("s_waitcnt vmcnt(0)\n\ts_barrier" ::: "memory");
        st = st == 2 ? 0 : st + 1;
    }
#undef ATT_DMA
#undef ATT_QK
#undef ATT_SM
#undef MX3
#undef ATT_PV
    lsum += __shfl_xor(lsum, 32);
    const size_t row = rowq0 + r;
    const float inv = __builtin_amdgcn_rcpf(lsum);
    bf16x8 ob[8];
#pragma unroll
    for (int d = 0; d < 4; ++d)
#pragma unroll
        for (int kk = 0; kk < 2; ++kk) { u32x4 t; t.x = cvtpk(o[d][8 * kk] * inv, o[d][8 * kk + 1] * inv); t.y = cvtpk(o[d][8 * kk + 2] * inv, o[d][8 * kk + 3] * inv); t.z = cvtpk(o[d][8 * kk + 4] * inv, o[d][8 * kk + 5] * inv); t.w = cvtpk(o[d][8 * kk + 6] * inv, o[d][8 * kk + 7] * inv); ob[2 * d + kk] = __builtin_bit_cast(bf16x8, t); }
    const bf16_t* wuv = F.wt(l, WO_UV) + (size_t)(w * 64 + r) * 128 + 8 * hi;
    f32x16 D0, D1;
#pragma unroll
    for (int i = 0; i < 16; ++i) { D0[i] = 0.f; D1[i] = 0.f; }
#pragma unroll
    for (int s8 = 0; s8 < 8; ++s8) { const bf16x8 a0 = *(const bf16x8*)(wuv + 16 * s8), a1 = *(const bf16x8*)(wuv + 32 * 128 + 16 * s8); D0 = MFMA32(a0, ob[s8], D0); D1 = MFMA32(a1, ob[s8], D1); }
    const float fac = sqrtf(F.ssq(SQ_SSD0 + l)[row] * (1.f / 512.f) + EPS);
    bf16_t* orow = (bf16_t*)(F.ws + WS_AO) + row * AOW + 512 + w * 64 + 4 * hi;
#pragma unroll
    for (int q = 0; q < 4; ++q) { u32x2 t; t.x = cvtpk(D0[4 * q] * fac, D0[4 * q + 1] * fac); t.y = cvtpk(D0[4 * q + 2] * fac, D0[4 * q + 3] * fac); *(u32x2*)(orow + 8 * q) = t;
        t.x = cvtpk(D1[4 * q] * fac, D1[4 * q + 1] * fac); t.y = cvtpk(D1[4 * q + 2] * fac, D1[4 * q + 3] * fac); *(u32x2*)(orow + 32 + 8 * q) = t; }
}

#define XB_TMO      128
#define XB_XCNT(j)  (256  + 64 * (j))
#define XB_XSUB(j)  (1280 + 64 * (j))
#define XB_XGEN(j)  (2304 + 64 * (j))
#define XB_TOP      3328
#define XB_TOPGEN   3392
#define XCD_BAR_WORDS 3456
#define XB_SPIN_CAP (1u << 20)
DI unsigned xb_ld(unsigned* p)              { return __hip_atomic_load(p, __ATOMIC_RELAXED, __HIP_MEMORY_SCOPE_AGENT); }
DI unsigned xb_add(unsigned* p, unsigned v) { return __hip_atomic_fetch_add(p, v, __ATOMIC_RELAXED, __HIP_MEMORY_SCOPE_AGENT); }
DI unsigned xb_xcc_id() { return (unsigned)__builtin_amdgcn_s_getreg((3 << 11) | 20) & 0xFu; }
#define XB_SPIN(cond, bar) do { unsigned _sp = 0; while (cond) { __builtin_amdgcn_s_sleep(1); \
    if ((++_sp & 255u) == 0u) { if (xb_ld(&(bar)[XB_TMO])) break; if (_sp > XB_SPIN_CAP) { atomicAdd(&(bar)[XB_TMO], 1u); break; } } } } while (0)
struct XcdBarrier { unsigned* bar; unsigned x; volatile LAS unsigned* st; };
DI XcdBarrier xcd_barrier_post(unsigned* bar, volatile LAS unsigned* st) {
    XcdBarrier b; b.bar = bar; b.x = xb_xcc_id(); b.st = st;
    if (threadIdx.x == 0) (void)xb_add(&bar[XB_XCNT(b.x)], 1u);
    return b;
}
DI void xcd_barrier_complete(unsigned* bar, unsigned x, unsigned& nloc, unsigned& nx) {
    const unsigned G = gridDim.x * gridDim.y * gridDim.z;
    unsigned sum, cnt, mine, sp = 0u;
    for (;;) {
        sum = 0u; cnt = 0u; mine = 0u;
#pragma unroll
        for (unsigned j = 0; j < 16; ++j) { const unsigned c = xb_ld(&bar[XB_XCNT(j)]); sum += c; cnt += (c > 0u) ? 1u : 0u; mine = (j == x) ? c : mine; }
        if (sum == G) break;
        __builtin_amdgcn_s_sleep(1);
        if ((++sp & 255u) == 0u) { if (xb_ld(&bar[XB_TMO])) break; if (sp > XB_SPIN_CAP) { atomicAdd(&bar[XB_TMO], 1u); break; } }
    }
    nloc = mine > 0u ? mine : 1u; nx = cnt > 0u ? cnt : 1u;
}
DI void xcd_barrier(const XcdBarrier& b) {
    asm volatile("s_waitcnt vmcnt(0)" ::: "memory");
    __syncthreads();
    if (threadIdx.x == 0) {
        unsigned* bar = b.bar;
        __builtin_amdgcn_s_waitcnt(0);
        unsigned nloc = b.st[0], nx = b.st[1];
        if (nloc == 0u) { xcd_barrier_complete(bar, b.x, nloc, nx); b.st[0] = nloc; b.st[1] = nx; }
        const unsigned old = xb_add(&bar[XB_XSUB(b.x)], 1u);
        const unsigned gen = old / nloc;
        if (old + 1u == (gen + 1u) * nloc) {
            __builtin_amdgcn_fence(__ATOMIC_RELEASE, "agent");
            asm volatile("s_waitcnt vmcnt(0)" ::: "memory");
            const unsigned og = xb_add(&bar[XB_TOP], 1u);
            const unsigned tg = og / nx;
            if (og + 1u == (tg + 1u) * nx) xb_add(&bar[XB_TOPGEN], 1u);
            else XB_SPIN(xb_ld(&bar[XB_TOPGEN]) == tg, bar);
            __builtin_amdgcn_fence(__ATOMIC_ACQUIRE, "agent");
            xb_add(&bar[XB_XGEN(b.x)], 1u);
            asm volatile("s_waitcnt vmcnt(0)" ::: "memory");
        } else {
            XB_SPIN(xb_ld(&bar[XB_XGEN(b.x)]) == gen, bar);
            __builtin_amdgcn_fence(__ATOMIC_ACQUIRE, "agent");
            asm volatile("s_waitcnt vmcnt(0)" ::: "memory");
        }
    }
    __syncthreads();
}

__global__ void __launch_bounds__(512, 2) mk_fwd(Args args) {
    extern __shared__ __attribute__((aligned(16))) unsigned char lds_raw[];
    Frame F;
    F.lds = (ldsp)lds_raw; F.tid = threadIdx.x; F.lane = F.tid & 63; F.wave = __builtin_amdgcn_readfirstlane(F.tid >> 6); F.G = gridDim.x; F.bid = blockIdx.x;
    F.in = args.in; F.out = args.out; F.ws = args.ws;
    cg::grid_group grid = cg::this_grid();
    volatile LAS unsigned* MISC = (volatile LAS unsigned*)(F.lds + 131072 + 512);
    if (threadIdx.x < 4) MISC[threadIdx.x] = 0u;
    __syncthreads();
    XcdBarrier xbar = xcd_barrier_post((unsigned*)F.ws, MISC);
    const int lo = args.ph_lo, hi = args.ph_hi;
#define IN(k) (lo <= (k) && (k) < hi)
#define SEAM(k) do { if (IN(k) && IN((k) + 1)) { if (lo < 0) grid.sync(); else xcd_barrier(xbar); } } while (0)
    bf16_t* XB = (bf16_t*)(F.ws + WS_XB); bf16_t* AO = (bf16_t*)(F.ws + WS_AO); bf16_t* PROJ = (bf16_t*)(F.ws + WS_PROJ); bf16_t* Qb = (bf16_t*)(F.ws + WS_Q); bf16_t* Hb = (bf16_t*)(F.ws + WS_H);
    float* XR = F.out;

    if (IN(0)) { p0_prologue(F); }
    SEAM(0);
#ifdef PROBE_SYNC
    for (int i = 0; i < 20; ++i) grid.sync();
#endif
#ifdef PROBE_P0
    if (IN(0)) { p0_prologue(F); } grid.sync();
#endif
    for (int l = 0; l < 2; ++l) {
        const int p = 1 + 7 * l;
        { int t_ = threadIdx.x; asm volatile("" : "+v"(t_)); F.tid = t_; F.lane = t_ & 63; }
        if (IN(p)) {
            pg8::Gemm g{XB, F.wt(l, WO_IN), MT, NPROJ, DM, DM, DM}; pg8::StaticOrder S; S.init(MT, NPROJ, F.G, F.bid);
            EpiInproj E{PROJ, F.ssq(l == 0 ? SQ_X0 : SQ_X1), F.ssq(SQ_Q0 + l), (bf16_t*)(F.ws + WS_HALO)};
            pg8::gemm_phase<EpiInproj, true>(F.lds, g, S, E);
        }
        SEAM(p);
        if (IN(p + 1)) {
            for (int u = F.bid; u < 1056; u += F.G) conv_unit(F, l, u);
            asm volatile("s_waitcnt vmcnt(0) lgkmcnt(0)" ::: "memory"); __syncthreads();
            pg8::Gemm g{PROJ + C_CQ, F.wt(l, WO_Q), MT, QW, 256, NPROJ, 256}; pg8::StaticOrder S; S.init(MT, QW, F.G, F.bid);
            EpiQ E{Qb, F.ssq(SQ_Q0 + l), (const float*)(F.ws + WS_ROPE)};
            pg8::gemm_phase<EpiQ, true>(F.lds, g, S, E);
        }
        SEAM(p + 1);
        if (IN(p + 2)) {
            for (int u = F.bid; u < 256; u += F.G) ssd_unit(F, l, 0, u >> 3, u & 7);
            for (int u = F.bid; u < 256; u += F.G) ssd_unit(F, l, 1, u >> 3, u & 7);
        }
        SEAM(p + 2);
        if (IN(p + 3)) for (int rep = 0; rep < REP_ATT; ++rep) {
            if (rep) xcd_barrier(xbar);
            const bool xl = F.G == 256; const int nloc = xl ? 32 : F.G, lc = xl ? F.bid >> 3 : F.bid, ntot = xl ? 264 : 2112;
            for (int rd = 0; rd * nloc < ntot; ++rd) { const int pos = (rd & 1) ? nloc - 1 - lc : lc; const int lu = rd * nloc + pos; if (lu >= ntot) continue;
                const int level = xl ? lu >> 3 : lu >> 6, within = xl ? lu & 7 : lu & 63, b = xl ? 4 * (F.bid & 7) + (within >> 1) : within >> 1, hf = within & 1;
                attn_unit(F, l, level == 16 ? 1 : 0, b, level < 16 ? 31 - level : level == 16 ? 0 : 32 - level, hf); }
            asm volatile("s_waitcnt vmcnt(0) lgkmcnt(0)" ::: "memory"); __syncthreads();
        }
        SEAM(p + 3);
        if (IN(p + 4)) {
            pg8::Gemm g{AO, F.wt(l, WO_OUT), MT, DM, AOW, AOW, AOW}; pg8::StaticOrder S; S.init(MT, DM, F.G, F.bid);
            EpiRes E{XB, F.ssq(SQ_SSD0 + l), F.ssq(SQ_FFN0 + l)};
            pg8::gemm_phase<EpiRes, true>(F.lds, g, S, E);
        }
        SEAM(p + 4);
        if (IN(p + 5)) for (int rep = 0; rep < REP_GU; ++rep) {
            if (rep) xcd_barrier(xbar);
            pg8::Gemm g{XB, F.wt(l, WO_GU), MT, GUW, DM, DM, DM}; pg8::StaticOrder S; S.init(MT, GUW, F.G, F.bid);
            EpiGU E{Hb, F.ssq(SQ_FFN0 + l)};
            pg8::gemm_phase<EpiGU, true>(F.lds, g, S, E);
        }
        SEAM(p + 5);
        if (IN(p + 6)) {
            pg8::Gemm g{Hb, F.wt(l, WO_DN), MT, DM, FF, FF, FF}; pg8::StaticOrder S; S.init(MT, DM, F.G, F.bid);
            EpiRes E{XB, nullptr, F.ssq(SQ_X1 + l)};
            pg8::gemm_phase<EpiRes, true>(F.lds, g, S, E);
        }
        SEAM(p + 6);
    }
    if (IN(15)) {
        { int t_ = threadIdx.x; asm volatile("" : "+v"(t_)); F.tid = t_; F.lane = t_ & 63; }
        const float* sq = F.ssq(SQ_X2); const float* gf = F.in[I_NFIN];
        f32x4 gg[4];
#pragma unroll
        for (int j = 0; j < 4; ++j) gg[j] = ((const f32x4*)gf)[F.lane + 64 * j];
        for (int row4 = (F.bid * 8 + F.wave) * 4; row4 < MT; row4 += F.G * 8 * 4) {
            u32x2 xw[4][4]; float rs[4];
#pragma unroll
            for (int q = 0; q < 4; ++q) { const int row = row4 + q; rs[q] = sq[row];
#pragma unroll
                for (int j = 0; j < 4; ++j) xw[q][j] = ((const u32x2*)(XB + (size_t)row * DM))[F.lane + 64 * j]; }
#pragma unroll
            for (int q = 0; q < 4; ++q) { const int row = row4 + q; const float r = rsqrtf(rs[q] * (1.f / 1024.f) + EPS); f32x4* yr = (f32x4*)(XR + (size_t)row * DM);
#pragma unroll
                for (int j = 0; j < 4; ++j) { const f32x4 xv = {bflo(xw[q][j].x), bfhi(xw[q][j].x), bflo(xw[q][j].y), bfhi(xw[q][j].y)}; yr[F.lane + 64 * j] = xv * r * gg[j]; } } }
    }
#undef IN
#undef SEAM
}

extern "C" void kernel_launch(void* const* d_in, const int* in_sizes, int n_in, void* d_out, int out_size, void* d_ws, size_t ws_size, hipStream_t stream) {
    static int grid = 0;
    if (grid == 0) {
        if (n_in != 25 || (size_t)out_size != O_END || ws_size < WS_END) { fprintf(stderr, "kernel_launch: unexpected sizes n_in %d out %d ws %zu\n", n_in, out_size, ws_size); grid = -1; return; }
        int dev = 0, cus = 0, per_cu = 0;
        hipGetDevice(&dev); hipDeviceGetAttribute(&cus, hipDeviceAttributeMultiprocessorCount, dev);
        hipFuncSetAttribute((const void*)mk_fwd, hipFuncAttributeMaxDynamicSharedMemorySize, LDS_BYTES);
        hipOccupancyMaxActiveBlocksPerMultiprocessor(&per_cu, (const void*)mk_fwd, 512, LDS_BYTES);
        if (per_cu < 1) { fprintf(stderr, "kernel_launch: occupancy query says %d blocks/CU\n", per_cu); per_cu = 1; }
        (void)hipGetLastError();
        grid = cus;
        fprintf(stderr, "kernel_launch: grid %d (cus %d, per_cu %d)\n", grid, cus, per_cu);
    }
    if (grid < 0) return;
    if (hipMemsetAsync(d_ws, 0, 16384, stream) != hipSuccess) { fprintf(stderr, "kernel_launch: memset failed\n"); return; }
    Args a{};
    for (int i = 0; i < 25; ++i) a.in[i] = (const float*)d_in[i];
    a.out = (float*)d_out; a.ws = (unsigned char*)d_ws;
#if MK_N_LAUNCHES == 1
    a.ph_lo = 0; a.ph_hi = NPH;
    void* kargs[] = {&a};
    hipError_t e = hipLaunchCooperativeKernel((const void*)mk_fwd, dim3(grid), dim3(512), kargs, LDS_BYTES, stream);
    if (e != hipSuccess) fprintf(stderr, "cooperative launch failed: %s (grid %d)\n", hipGetErrorString(e), grid);
#else
    for (int p = 0; p < NPH; ++p) { a.ph_lo = p; a.ph_hi = p + 1; hipLaunchKernelGGL(mk_fwd, dim3(grid), dim3(512), LDS_BYTES, stream, a); }
#endif
}
```

```cpp
#include <hip/hip_runtime.h>
#include <hip/hip_cooperative_groups.h>
#include <cstdio>
#include <cstdint>
namespace cg = cooperative_groups;

#ifndef MK_N_LAUNCHES
#define MK_N_LAUNCHES 1
#endif

#define DI __device__ __forceinline__
#define LAS __attribute__((address_space(3)))
typedef unsigned short bf16_t;
typedef short bf16x8 __attribute__((ext_vector_type(8)));
typedef float f32x4 __attribute__((ext_vector_type(4)));
typedef float f32x16 __attribute__((ext_vector_type(16)));
typedef unsigned u32x4 __attribute__((ext_vector_type(4)));
typedef unsigned u32x2 __attribute__((ext_vector_type(2)));
typedef float f32x2_t __attribute__((ext_vector_type(2)));
typedef __bf16 bf16x2_t __attribute__((ext_vector_type(2)));
typedef LAS unsigned char* ldsp;

constexpr int MP = 65536, MS = 2048, MT = MP + MS;
constexpr int DM = 1024, NPROJ = 2048, QW = 1280, AOW = 1024, FF = 2816, GUW = 2 * FF;
constexpr int C_Z = 0, C_XBC = 512, C_CQ = 1536, C_CKV = 1792, C_KR = 1920, C_DT = 1952;
constexpr float EPS = 1e-6f;
constexpr float QSCALE = 0.10206207261596577f * 1.4426950408889634f;
constexpr int TKP = 2048, TKS = 1088;

constexpr size_t O_YP = 0, O_YS = O_YP + (size_t)MP * DM, O_CKVP = O_YS + (size_t)MS * DM, O_KRP = O_CKVP + (size_t)2 * 32 * 2048 * 128,
                 O_SSMP = O_KRP + (size_t)2 * 32 * 2048 * 32, O_CONVP = O_SSMP + (size_t)2 * 32 * 8 * 64 * 128, O_CKVS = O_CONVP + (size_t)2 * 32 * 3 * 1024,
                 O_KRS = O_CKVS + (size_t)2 * 32 * 64 * 128, O_SSMS = O_KRS + (size_t)2 * 32 * 64 * 32, O_CONVS = O_SSMS + (size_t)2 * 32 * 8 * 64 * 128,
                 O_END = O_CONVS + (size_t)2 * 32 * 3 * 1024;
constexpr size_t MiB = 1u << 20;
constexpr size_t WS_SSQ = 1 * MiB, WS_ROPE = 4 * MiB, WS_W = 8 * MiB, W_LAYER = 25 * MiB;
constexpr size_t WO_IN = 0, WO_Q = 4 * MiB, WO_UV = 4 * MiB + 640 * 1024, WO_OUT = 5 * MiB, WO_GU = 8 * MiB, WO_DN = 19 * MiB;
constexpr size_t WS_KP = 64 * MiB, WS_VTP = 84 * MiB, WS_KS = 100 * MiB, KS_LAYER = 11 * MiB, WS_VTS = 122 * MiB, VTS_LAYER = 9 * MiB;
constexpr size_t WS_XB = 144 * MiB, WS_AO = 276 * MiB, WS_PROJ = 474 * MiB, WS_Q = 738 * MiB, WS_H = WS_PROJ, WS_HALO = 903 * MiB, WS_END = 910 * MiB;
static_assert((size_t)MT * DM * 2 <= WS_AO - WS_XB && (size_t)MT * AOW * 2 <= WS_PROJ - WS_AO && (size_t)MT * NPROJ * 2 <= WS_Q - WS_PROJ && (size_t)MT * QW * 2 <= WS_HALO - WS_Q && (size_t)MT * FF * 2 <= WS_HALO - WS_H && (size_t)1056 * 3 * 1024 * 2 <= WS_END - WS_HALO, "ws map");
static_assert((size_t)32 * TKS * 160 * 2 <= KS_LAYER && (size_t)32 * 128 * TKS * 2 <= VTS_LAYER && (size_t)32 * TKP * 160 * 2 <= WS_VTP - WS_KP && (size_t)32 * 128 * TKP * 2 <= WS_KS - WS_VTP, "ws map 2");
constexpr int SQ_X0 = 0, SQ_X1 = 1, SQ_X2 = 2, SQ_Q0 = 3, SQ_SSD0 = 5, SQ_FFN0 = 7, SQ_N = 9;
static_assert((size_t)SQ_N * MT * 4 <= WS_ROPE - WS_SSQ, "ssq");

constexpr int LDS_BYTES = 147456;
#ifndef REP_ATT
#define REP_ATT 1
#endif
#ifndef REP_GU
#define REP_GU 1
#endif
constexpr int NPH = 16;

DI unsigned cvtpk(float lo, float hi) { f32x2_t v = {lo, hi}; bf16x2_t b = __builtin_convertvector(v, bf16x2_t); return __builtin_bit_cast(unsigned, b); }
DI bf16_t f2bf(float f) { return (bf16_t)(cvtpk(f, 0.f) & 0xffffu); }
DI float bf2f(bf16_t v) { return __uint_as_float((unsigned)v << 16); }
DI float bflo(unsigned w) { return __uint_as_float(w << 16); }
DI float bfhi(unsigned w) { return __uint_as_float(w & 0xffff0000u); }
DI u32x4 pack8(const float* v) { u32x4 w; w.x = cvtpk(v[0], v[1]); w.y = cvtpk(v[2], v[3]); w.z = cvtpk(v[4], v[5]); w.w = cvtpk(v[6], v[7]); return w; }
DI void unpack8(u32x4 w, float* v) { v[0] = bflo(w.x); v[1] = bfhi(w.x); v[2] = bflo(w.y); v[3] = bfhi(w.y); v[4] = bflo(w.z); v[5] = bfhi(w.z); v[6] = bflo(w.w); v[7] = bfhi(w.w); }
DI bf16x8 lds_r16(ldsp p) { return *(const LAS bf16x8*)p; }
DI void lds_w16(ldsp p, u32x4 v) { *(LAS u32x4*)p = v; }
DI int crow(int r, int hi) { return (r & 3) + 8 * (r >> 2) + 4 * hi; }
DI float wave_sum(float v) {
#pragma unroll
    for (int o = 1; o < 64; o <<= 1) v += __shfl_xor(v, o);
    return v;
}
DI float sigmoidf_(float x) { return __builtin_amdgcn_rcpf(1.f + __expf(-x)); }
#define MFMA32(a, b, c) __builtin_amdgcn_mfma_f32_32x32x16_bf16((a), (b), (c), 0, 0, 0)
#define LDS_WAIT() asm volatile("s_waitcnt lgkmcnt(0)" ::: "memory")

namespace pg8 {
constexpr int BM = 256, BK = 64, HALF = 128, HTB = HALF * BK * 2, STAGE_BYTES = 8 * HTB, NXCD = 8, WGM = 8;
DI int lds_byte(int r, int c) { const int st = (r >> 4) * 2 + (c >> 5), rr = r & 15, cc = c & 31, ob = rr * 64 + cc * 2; return st * 1024 + (ob ^ (((ob >> 9) & 1) << 5)); }
DI void stage_rc(int b, int& R, int& C) { const int st = b / 1024, sb = b % 1024, swz = sb ^ (((sb >> 9) & 1) << 5); R = (st >> 1) * 16 + swz / 64; C = (st & 1) * 32 + (swz % 64) / 2; }
DI int perm32(int rho) { const int n = rho >> 4, i = rho & 15; return 8 * (i >> 2) + 4 * n + (i & 3); }
struct Unit { int pm, pn; };
struct Gemm { const bf16_t* A; const bf16_t* Bt; int M, N, K, lda, ldb; };
struct StaticOrder {
    int nM, nN, nwg, G, c;
    DI void init(int M, int N, int G_, int c_) { nM = M / BM; nN = N / BM; nwg = nM * nN; G = G_; c = c_; }
    DI bool next(int i, Unit& u) const {
        const long L = (long)i * G + c; if (L >= nwg) return false;
        int wgid = (int)L; { const int q = nwg / NXCD, r = nwg % NXCD, xcd = wgid % NXCD, off = wgid / NXCD; wgid = (xcd < r ? xcd * (q + 1) : r * (q + 1) + (xcd - r) * q) + off; }
        const int nig = WGM * nN, gid = wgid / nig, fm = gid * WGM, gsz = (nM - fm) < WGM ? (nM - fm) : WGM;
        u.pm = fm + ((wgid % nig) % gsz); u.pn = (wgid % nig) / gsz; return true;
    }
};
template <class Epi, bool ALIGN_EPI>
DI void gemm_phase(ldsp lds, const Gemm g, const StaticOrder& S, const Epi& E) {
    int tid_ = threadIdx.x; asm volatile("" : "+v"(tid_));
    const int tid = tid_, wid = __builtin_amdgcn_readfirstlane(tid >> 6), lane = tid & 63, wr = wid >> 2, wc = wid & 3, fr = lane & 15, fq = lane >> 4;
    const int K = g.K, nt = K / BK;
    unsigned voffA[2], voffB[2];
#pragma unroll
    for (int i = 0; i < 2; ++i) { int R, C; stage_rc(tid * 16 + i * 8192, R, C); const int Rb = Epi::PERM ? ((R & ~31) + perm32(R & 31)) : R;
        voffA[i] = (unsigned)(R * g.lda + C) * 2u; voffB[i] = (unsigned)(Rb * g.ldb + C) * 2u; }
    const size_t kstep = (size_t)(BK * 2);
    const size_t hstepA = (size_t)HALF * g.lda * 2, hstepB = (size_t)HALF * g.ldb * 2;
    const size_t tstepA = 2 * hstepA, tstepB = 2 * hstepB;
    const unsigned ldsw = (unsigned)wid * 1024u;
    const int aoff = lds_byte(wr * 64 + fr, fq * 8), boff = lds_byte(wc * 32 + fr, fq * 8);
#define PG8_SA(b, h) (((b) * 2 + (h)) * HTB)
#define PG8_SB(b, h) ((4 + (b) * 2 + (h)) * HTB)
#define PG8_STAGE(bufoff, gbase, voff) do { _Pragma("unroll") for (int _i = 0; _i < 2; ++_i) \
        __builtin_amdgcn_global_load_lds((const unsigned*)((const char*)(gbase) + (voff)[_i]), (LAS unsigned*)(lds + (bufoff) + ldsw + _i * 8192), 16, 0, 0); } while (0)
#define PG8_LDA(dst, b, h) do { _Pragma("unroll") for (int m = 0; m < 4; ++m) _Pragma("unroll") for (int k = 0; k < 2; ++k) dst[m][k] = *(const LAS bf16x8*)(lds + PG8_SA(b, h) + aoff + m * 2048 + k * 1024); } while (0)
#define PG8_LDB(dst, b, h) do { _Pragma("unroll") for (int n = 0; n < 2; ++n) _Pragma("unroll") for (int k = 0; k < 2; ++k) dst[n][k] = *(const LAS bf16x8*)(lds + PG8_SB(b, h) + boff + n * 2048 + k * 1024); } while (0)
#define PG8_MMA(ai, bj, At, Bt) do { __builtin_amdgcn_s_setprio(1); _Pragma("unroll") for (int m = 0; m < 4; ++m) _Pragma("unroll") for (int n = 0; n < 2; ++n) _Pragma("unroll") for (int k = 0; k < 2; ++k) \
        acc[ai][bj][m][n] = __builtin_amdgcn_mfma_f32_16x16x32_bf16(Bt[n][k], At[m][k], acc[ai][bj][m][n], 0, 0, 0); __builtin_amdgcn_s_setprio(0); } while (0)
#define PG8_WAIT_V(n) asm volatile("s_waitcnt vmcnt(" #n ")" ::: "memory")
#define PG8_WAIT_L(n) asm volatile("s_waitcnt lgkmcnt(" #n ")" ::: "memory")
#define PG8_BAR __builtin_amdgcn_s_barrier()
#define PG8_SCHED __builtin_amdgcn_sched_barrier(0)
    Unit cur, nxt; int ui = 0;
    if (!S.next(0, cur)) return;
    f32x4 acc[2][2][4][2];
#pragma unroll
    for (int a = 0; a < 2; ++a)
#pragma unroll
        for (int b = 0; b < 2; ++b)
#pragma unroll
            for (int m = 0; m < 4; ++m)
#pragma unroll
                for (int n = 0; n < 2; ++n) acc[a][b][m][n] = (f32x4){0.f, 0.f, 0.f, 0.f};
    bf16x8 At[4][2], B0[2][2], B1[2][2];
    const char* cA = (const char*)g.A + (size_t)cur.pm * tstepA; const char* cB = (const char*)g.Bt + (size_t)cur.pn * tstepB;
    PG8_STAGE(PG8_SB(0, 0), cB, voffB); PG8_STAGE(PG8_SB(0, 1), cB + hstepB, voffB); PG8_STAGE(PG8_SA(0, 0), cA, voffA); PG8_STAGE(PG8_SA(0, 1), cA + hstepA, voffA);
    if (wr == 1) PG8_BAR;
    PG8_WAIT_V(2); PG8_BAR;
    PG8_STAGE(PG8_SB(1, 0), cB + kstep, voffB); PG8_STAGE(PG8_SA(1, 0), cA + kstep, voffA); PG8_STAGE(PG8_SB(1, 1), cB + hstepB + kstep, voffB);
    PG8_WAIT_V(6); PG8_BAR;
    for (;;) {
        const bool has_next = S.next(ui + 1, nxt);
        const char* nA = has_next ? (const char*)g.A + (size_t)nxt.pm * tstepA : cA; const char* nB = has_next ? (const char*)g.Bt + (size_t)nxt.pn * tstepB : cB;
        for (int t = 0; t < nt; t += 2) {
            const bool last = (t == nt - 2);
            const char* a1 = cA + (size_t)(t + 1) * kstep;
            const char* a2 = last ? nA : cA + (size_t)(t + 2) * kstep; const char* b2 = last ? nB : cB + (size_t)(t + 2) * kstep;
            const char* a3 = a2 + kstep; const char* b3 = b2 + kstep;
            PG8_LDB(B0, 0, 0); PG8_LDB(B1, 0, 1); PG8_SCHED; PG8_LDA(At, 0, 0); PG8_STAGE(PG8_SA(1, 1), a1 + hstepA, voffA);
            PG8_WAIT_V(8); PG8_WAIT_L(0); PG8_BAR; PG8_MMA(0, 0, At, B0); PG8_MMA(0, 1, At, B1); PG8_BAR; PG8_SCHED;
            PG8_LDA(At, 0, 1); PG8_STAGE(PG8_SB(0, 0), b2, voffB); PG8_STAGE(PG8_SB(0, 1), b2 + hstepB, voffB); PG8_STAGE(PG8_SA(0, 0), a2, voffA);
            PG8_WAIT_V(8); PG8_WAIT_L(0); PG8_BAR; PG8_MMA(1, 0, At, B0); PG8_MMA(1, 1, At, B1); PG8_BAR; PG8_SCHED;
            PG8_LDB(B0, 1, 0); PG8_LDB(B1, 1, 1); PG8_SCHED; PG8_LDA(At, 1, 0); PG8_STAGE(PG8_SA(0, 1), a2 + hstepA, voffA);
            PG8_WAIT_V(8); PG8_WAIT_L(0); PG8_BAR; PG8_MMA(0, 0, At, B0); PG8_MMA(0, 1, At, B1); PG8_BAR; PG8_SCHED;
            PG8_LDA(At, 1, 1); PG8_STAGE(PG8_SB(1, 0), b3, voffB); PG8_STAGE(PG8_SB(1, 1), b3 + hstepB, voffB); PG8_STAGE(PG8_SA(1, 0), a3, voffA);
            PG8_WAIT_V(8); PG8_WAIT_L(0); PG8_BAR; PG8_MMA(1, 0, At, B0); PG8_MMA(1, 1, At, B1); PG8_BAR; PG8_SCHED;
        }
        if constexpr (ALIGN_EPI) { if (wr == 0) PG8_BAR; }
        E(acc, cur, wr, wc, fr, fq);
        if (!has_next) break;
#pragma unroll
        for (int a = 0; a < 2; ++a)
#pragma unroll
            for (int b = 0; b < 2; ++b)
#pragma unroll
                for (int m = 0; m < 4; ++m)
#pragma unroll
                    for (int n = 0; n < 2; ++n) acc[a][b][m][n] = (f32x4){0.f, 0.f, 0.f, 0.f};
        cur = nxt; cA = nA; cB = nB; ++ui;
        if constexpr (ALIGN_EPI) { if (wr == 1) PG8_BAR; }
    }
    PG8_WAIT_V(0);
    if constexpr (!ALIGN_EPI) { if (wr == 0) PG8_BAR; }
    PG8_BAR;
#undef PG8_SA
#undef PG8_SB
#undef PG8_STAGE
#undef PG8_LDA
#undef PG8_LDB
#undef PG8_MMA
#undef PG8_WAIT_V
#undef PG8_WAIT_L
#undef PG8_BAR
#undef PG8_SCHED
}
}
using pg8::Unit;
typedef const f32x4 (&AccRef)[2][2][4][2];

DI float dot4(f32x4 v) { return (v[0] * v[0] + v[1] * v[1]) + (v[2] * v[2] + v[3] * v[3]); }
DI u32x4 pack44(f32x4 a, f32x4 b) { u32x4 w; w.x = cvtpk(a[0], a[1]); w.y = cvtpk(a[2], a[3]); w.z = cvtpk(b[0], b[1]); w.w = cvtpk(b[2], b[3]); return w; }

struct EpiInproj {
    static constexpr bool PERM = true;
    bf16_t* O; const float* ssqx; float* ssqq; bf16_t* halo;
    DI void operator()(AccRef acc, const Unit& u, int wr, int wc, int fr, int fq) const {
        { int t_ = threadIdx.x; asm volatile("" : "+v"(t_)); fr = t_ & 15; fq = (t_ >> 4) & 3; }
        const int col0 = u.pn * 256 + wc * 32 + 8 * fq;
        float rr[2][4];
#pragma unroll
        for (int ai = 0; ai < 2; ++ai)
#pragma unroll
            for (int m = 0; m < 4; ++m) rr[ai][m] = ssqx[u.pm * 256 + ai * 128 + wr * 64 + m * 16 + fr];
#pragma unroll
        for (int ai = 0; ai < 2; ++ai)
#pragma unroll
            for (int m = 0; m < 4; ++m) {
                const int row = u.pm * 256 + ai * 128 + wr * 64 + m * 16 + fr;
                const float r = __builtin_amdgcn_rsqf(rr[ai][m] * (1.f / 1024.f) + EPS);
                float s = 0.f;
#pragma unroll
                for (int bj = 0; bj < 2; ++bj) { const f32x4 v0 = acc[ai][bj][m][0] * r, v1 = acc[ai][bj][m][1] * r; s += dot4(v0) + dot4(v1);
                    const u32x4 pk = pack44(v0, v1); *(u32x4*)(O + (size_t)row * NPROJ + col0 + bj * 128) = pk;
                    if (u.pn >= 2 && u.pn < 6 && (row & 63) >= 61) *(u32x4*)(halo + ((size_t)(row >> 6) * 3 + (row & 63) - 61) * 1024 + col0 + bj * 128 - C_XBC) = pk; }
                if (u.pn == 6) { s += __shfl_xor(s, 16); s += __shfl_xor(s, 32); if (fq == 0) unsafeAtomicAdd(ssqq + row, s); }
                asm volatile("" ::: "memory");
            }
    }
};
struct EpiQ {
    static constexpr bool PERM = false;
    bf16_t* Q; const float* ssqq; const float* rope;
    DI void operator()(AccRef acc, const Unit& u, int wr, int wc, int fr, int fq) const {
        { int t_ = threadIdx.x; asm volatile("" : "+v"(t_)); fr = t_ & 15; fq = (t_ >> 4) & 3; }
        float rr[2][4];
#pragma unroll
        for (int ai = 0; ai < 2; ++ai)
#pragma unroll
            for (int m = 0; m < 4; ++m) rr[ai][m] = ssqq[u.pm * 256 + ai * 128 + wr * 64 + m * 16 + fr];
#pragma unroll
        for (int ai = 0; ai < 2; ++ai)
#pragma unroll
            for (int m = 0; m < 4; ++m) {
                const int row = u.pm * 256 + ai * 128 + wr * 64 + m * 16 + fr;
                const float r = __builtin_amdgcn_rsqf(rr[ai][m] * (1.f / 256.f) + EPS);
                bf16_t* qr = Q + (size_t)row * QW + u.pn * 256 + wc * 32 + 4 * fq;
                if (u.pn < 4) {
#pragma unroll
                    for (int bj = 0; bj < 2; ++bj)
#pragma unroll
                        for (int n = 0; n < 2; ++n) { const f32x4 v = acc[ai][bj][m][n] * r; u32x2 w; w.x = cvtpk(v[0], v[1]); w.y = cvtpk(v[2], v[3]); *(u32x2*)(qr + bj * 128 + n * 16) = w; }
                } else {
                    const int pos = row < MP ? (row & 2047) : 1024 + ((row - MP) & 63);
                    const f32x4 cs = *(const f32x4*)(rope + pos * 32 + 4 * fq), sn = *(const f32x4*)(rope + pos * 32 + 16 + 4 * fq);
#pragma unroll
                    for (int bj = 0; bj < 2; ++bj) { const f32x4 x1 = acc[ai][bj][m][0] * r, x2 = acc[ai][bj][m][1] * r; const f32x4 o1 = x1 * cs - x2 * sn, o2 = x1 * sn + x2 * cs;
                        u32x2 w; w.x = cvtpk(o1[0], o1[1]); w.y = cvtpk(o1[2], o1[3]); *(u32x2*)(qr + bj * 128) = w; w.x = cvtpk(o2[0], o2[1]); w.y = cvtpk(o2[2], o2[3]); *(u32x2*)(qr + bj * 128 + 16) = w; }
                }
                asm volatile("" ::: "memory");
            }
    }
};
struct EpiRes {
    static constexpr bool PERM = true;
    bf16_t* XB; const float* ssq_scale; float* ssq_next;
    DI void operator()(AccRef acc, const Unit& u, int wr, int wc, int fr, int fq) const {
        { int t_ = threadIdx.x; asm volatile("" : "+v"(t_)); fr = t_ & 15; fq = (t_ >> 4) & 3; }
        const int col0 = u.pn * 256 + wc * 32 + 8 * fq;
        float rr[2][4];
#pragma unroll
        for (int ai = 0; ai < 2; ++ai)
#pragma unroll
            for (int m = 0; m < 4; ++m) rr[ai][m] = ssq_scale ? ssq_scale[u.pm * 256 + ai * 128 + wr * 64 + m * 16 + fr] : 0.f;
#pragma unroll
        for (int ai = 0; ai < 2; ++ai) {
            u32x4 bw[4][2];
#pragma unroll
            for (int m = 0; m < 4; ++m)
#pragma unroll
                for (int bj = 0; bj < 2; ++bj) bw[m][bj] = *(const u32x4*)(XB + (size_t)(u.pm * 256 + ai * 128 + wr * 64 + m * 16 + fr) * DM + col0 + bj * 128);
#pragma unroll
            for (int m = 0; m < 4; ++m) {
                const int row = u.pm * 256 + ai * 128 + wr * 64 + m * 16 + fr;
                const float rs = ssq_scale ? __builtin_amdgcn_rsqf(rr[ai][m] * (1.f / 512.f) + EPS) : 1.f;
                float s = 0.f;
#pragma unroll
                for (int bj = 0; bj < 2; ++bj) { bf16_t* xp = XB + (size_t)row * DM + col0 + bj * 128;
                    const u32x4 w4 = bw[m][bj];
                    const f32x4 b0 = {bflo(w4.x), bfhi(w4.x), bflo(w4.y), bfhi(w4.y)}, b1 = {bflo(w4.z), bfhi(w4.z), bflo(w4.w), bfhi(w4.w)};
                    const f32x4 v0 = b0 + acc[ai][bj][m][0] * rs, v1 = b1 + acc[ai][bj][m][1] * rs; s += dot4(v0) + dot4(v1);
                    *(u32x4*)xp = pack44(v0, v1); }
                s += __shfl_xor(s, 16); s += __shfl_xor(s, 32); if (fq == 0) unsafeAtomicAdd(ssq_next + row, s);
            }
            asm volatile("" ::: "memory");
        }
    }
};
struct EpiGU {
    static constexpr bool PERM = true;
    bf16_t* H; const float* ssq;
    DI void operator()(AccRef acc, const Unit& u, int wr, int wc, int fr, int fq) const {
        { int t_ = threadIdx.x; asm volatile("" : "+v"(t_)); fr = t_ & 15; fq = (t_ >> 4) & 3; }
        const int col0 = u.pn * 128 + wc * 32 + 8 * fq;
        float rr[2][4];
#pragma unroll
        for (int ai = 0; ai < 2; ++ai)
#pragma unroll
            for (int m = 0; m < 4; ++m) rr[ai][m] = ssq[u.pm * 256 + ai * 128 + wr * 64 + m * 16 + fr];
#pragma unroll
        for (int ai = 0; ai < 2; ++ai)
#pragma unroll
            for (int m = 0; m < 4; ++m) {
                const int row = u.pm * 256 + ai * 128 + wr * 64 + m * 16 + fr;
                const float r = __builtin_amdgcn_rsqf(rr[ai][m] * (1.f / 1024.f) + EPS);
                f32x4 h[2];
#pragma unroll
                for (int n = 0; n < 2; ++n) { const f32x4 gt = acc[ai][0][m][n] * r, up = acc[ai][1][m][n] * r;
#pragma unroll
                    for (int j = 0; j < 4; ++j) h[n][j] = gt[j] * sigmoidf_(gt[j]) * up[j]; }
                *(u32x4*)(H + (size_t)row * FF + col0) = pack44(h[0], h[1]);
                asm volatile("" ::: "memory");
            }
    }
};

struct Args { const float* in[25]; float* out; unsigned char* ws; int ph_lo, ph_hi; };
struct Frame {
    ldsp lds; int tid, lane, wave, G, bid;
    const float* const* in; float* out; unsigned char* ws;
    DI float* ssq(int i) const { return (float*)(ws + WS_SSQ) + (size_t)i * MT; }
    DI bf16_t* wt(int l, size_t off) const { return (bf16_t*)(ws + WS_W + (size_t)l * W_LAYER + off); }
};
enum { I_XP = 0, I_XS, I_CCKV, I_CKR, I_SSM, I_CONV, I_WIN, I_WUQ, I_WUK, I_WUV, I_WOUT, I_NMIX, I_QN, I_KVN, I_SSDN, I_CW, I_CB, I_DTB, I_ALOG, I_DSKIP, I_NFFN, I_WG, I_WU, I_WD, I_NFIN };

DI void transpose_item(const float* W, int Nsrc, int sc, const float* gain, float gscale, bf16_t* WT, int ldk, int n0, int k0, LAS float* scr, int lane) {
    float tv[32];
#pragma unroll
    for (int i = 0; i < 32; ++i) { const int kk = 2 * i + (lane >> 5); tv[i] = sc >= 0 ? W[(size_t)(k0 + kk) * Nsrc + sc] : 0.f; }
#pragma unroll
    for (int i = 0; i < 32; ++i) { const int kk = 2 * i + (lane >> 5); scr[kk * 33 + (lane & 31)] = tv[i] * (gain ? gain[k0 + kk] : 1.f) * gscale; }
    LDS_WAIT(); asm volatile("" ::: "memory");
    const int c = lane & 7;
#pragma unroll
    for (int j = 0; j < 4; ++j) { const int n = (lane >> 3) + 8 * j; const LAS float* s = scr + (8 * c) * 33 + n;
        u32x4 o; o.x = cvtpk(s[0 * 33], s[1 * 33]); o.y = cvtpk(s[2 * 33], s[3 * 33]); o.z = cvtpk(s[4 * 33], s[5 * 33]); o.w = cvtpk(s[6 * 33], s[7 * 33]);
        *(u32x4*)(WT + (size_t)(n0 + n) * ldk + k0 + 8 * c) = o; }
    LDS_WAIT(); asm volatile("" ::: "memory");
}
DI int src_col_in(int n) { return n < 1536 ? n : n < 1792 ? 1544 + (n - 1536) : n < 1920 ? 1800 + (n - 1792) : n < 1952 ? 1928 + (n - 1920) : n < 1960 ? 1536 + (n - 1952) : -1; }

DI void kv_write_tile(const Frame& F, bf16_t* Kdst, bf16_t* VTdst, int ldvt) {
    int tid = threadIdx.x; asm volatile("" : "+v"(tid)); ldsp T = F.lds;
#pragma unroll
    for (int rr = 0; rr < 3; ++rr) { const int i = tid + rr * 512; if (i < 1280) { const int row = i / 20, pc = i % 20;
        *(u32x4*)(Kdst + (size_t)row * 160 + 8 * pc) = *(const LAS u32x4*)(T + row * 336 + 16 * pc); } }
    const int d = tid >> 2, g = tid & 3;
    const LAS bf16_t* col = (const LAS bf16_t*)T + d;
    unsigned w[8];
#pragma unroll
    for (int hh = 0; hh < 2; ++hh)
#pragma unroll
        for (int a = 0; a < 2; ++a)
#pragma unroll
            for (int i2 = 0; i2 < 2; ++i2) { const int k0 = 16 * g + 8 * a + 4 * hh + 2 * i2;
                w[hh * 4 + a * 2 + i2] = (unsigned)col[(size_t)k0 * 168] | ((unsigned)col[(size_t)(k0 + 1) * 168] << 16); }
    bf16_t* vp = VTdst + (size_t)d * ldvt + 16 * g;
    *(u32x4*)vp = (u32x4){w[0], w[1], w[2], w[3]}; *(u32x4*)(vp + 8) = (u32x4){w[4], w[5], w[6], w[7]};
}

DI void p0_prologue(const Frame& F) {
    const int gw = F.bid * 8 + F.wave, NGW = F.G * 8, gt = F.bid * 512 + F.tid, NT = F.G * 512;
    { float* z = F.ssq(1); for (size_t i = gt; i < (size_t)(SQ_N - 1) * MT; i += NT) z[i] = 0.f; }
    for (int i = gt; i < 2048 * 16; i += NT) { const int pos = i >> 4, j = i & 15;
        const double inv = exp(-9.210340371976184 * (double)j / 16.0), ang = (double)pos * inv;
        const double kq = rint(ang * 0.15915494309189535), x = ang - kq * 6.283185307179586, x2 = x * x;
        double ts = x, sn = x, tc = 1.0, cs = 1.0;
        for (int n = 1; n <= 14; ++n) { tc *= -x2 / (double)((2 * n - 1) * (2 * n)); cs += tc; ts *= -x2 / (double)((2 * n) * (2 * n + 1)); sn += ts; }
        float* rt = (float*)(F.ws + WS_ROPE); rt[pos * 32 + j] = (float)cs; rt[pos * 32 + 16 + j] = (float)sn; }
    LAS float* scr = (LAS float*)(F.lds + F.wave * 16384);
    constexpr int I_IN = 16 * 64, I_GU = 16 * 176, I_DN = 44 * 32, I_OS = 16 * 32, I_QR = 4 * 8, I_L = I_IN + I_GU + I_DN + I_OS + I_QR;
    const int l31 = F.lane & 31;
    for (int it = gw; it < 2 * I_L; it += NGW) {
        const int l = it / I_L; int r = it % I_L;
        if (r < I_IN) { const int kb = r / 64, nb = r % 64; transpose_item(F.in[I_WIN] + (size_t)l * 1024 * 1960, 1960, src_col_in(nb * 32 + l31), F.in[I_NMIX] + l * 1024, 1.f, F.wt(l, WO_IN), 1024, nb * 32, kb * 64, scr, F.lane); continue; } r -= I_IN;
        if (r < I_GU) { const int kb = r / 176, nb = r % 176, n0 = nb * 32, j = n0 >> 8, rr = n0 & 255;
            transpose_item(F.in[rr < 128 ? I_WG : I_WU] + (size_t)l * 1024 * FF, FF, 128 * j + (rr & 127) + l31, F.in[I_NFFN] + l * 1024, 1.f, F.wt(l, WO_GU), 1024, n0, kb * 64, scr, F.lane); continue; } r -= I_GU;
        if (r < I_DN) { const int kb = r / 32, nb = r % 32; transpose_item(F.in[I_WD] + (size_t)l * FF * 1024, 1024, nb * 32 + l31, nullptr, 1.f, F.wt(l, WO_DN), FF, nb * 32, kb * 64, scr, F.lane); continue; } r -= I_DN;
        if (r < I_OS) { const int kb = r / 32, nb = r % 32; transpose_item(F.in[I_WOUT] + (size_t)l * 1024 * 1024, 1024, nb * 32 + l31, kb < 8 ? F.in[I_SSDN] + l * 512 : nullptr, 1.f, F.wt(l, WO_OUT), AOW, nb * 32, kb * 64, scr, F.lane); continue; } r -= I_OS;
        { const int kb = r / 8, h = r % 8; transpose_item(F.in[I_WUQ] + (size_t)l * 256 * 768, 768, h * 96 + 64 + l31, F.in[I_QN] + l * 256, QSCALE, F.wt(l, WO_Q), 256, 1024 + h * 32, kb * 64, scr, F.lane); }
    }
    for (int idx = gt; idx < 2 * 1024 * 256; idx += NT) { const int k = idx & 255, n = (idx >> 8) & 1023, l = idx >> 18, h = n >> 7, lq = n & 127;
        const float* uq = F.in[I_WUQ] + (size_t)l * 256 * 768 + (size_t)k * 768 + h * 96; const float* uk = F.in[I_WUK] + (size_t)l * 128 * 512 + lq * 512 + h * 64;
        float s = 0.f;
#pragma unroll
        for (int d4 = 0; d4 < 16; ++d4) { const f32x4 a = ((const f32x4*)uq)[d4], bq = ((const f32x4*)uk)[d4]; s += (a[0] * bq[0] + a[1] * bq[1]) + (a[2] * bq[2] + a[3] * bq[3]); }
        F.wt(l, WO_Q)[(size_t)n * 256 + k] = f2bf(s * F.in[I_QN][l * 256 + k] * QSCALE); }
    for (int idx = gt; idx < 2 * 8 * 64 * 128; idx += NT) { const int pos = idx & 127, dv = (idx >> 7) & 63, h = (idx >> 13) & 7, l = idx >> 16;
        const int G = pos >> 4, hh = (pos >> 3) & 1, a = (pos >> 2) & 1, i = pos & 3, d = 16 * G + 8 * a + 4 * hh + i;
        F.wt(l, WO_UV)[(size_t)(h * 64 + dv) * 128 + pos] = f2bf(F.in[I_WUV][(size_t)l * 128 * 512 + (size_t)d * 512 + h * 64 + dv]); }
    { float* sq = F.ssq(SQ_X0); bf16_t* XB = (bf16_t*)(F.ws + WS_XB);
      for (int row4 = gw * 4; row4 < MT; row4 += NGW * 4) {
        f32x4 v[4][4];
#pragma unroll
        for (int q = 0; q < 4; ++q) { const int row = row4 + q; const float* xr = row < MP ? F.in[I_XP] + (size_t)row * DM : F.in[I_XS] + (size_t)(row - MP) * DM;
#pragma unroll
            for (int j = 0; j < 4; ++j) v[q][j] = ((const f32x4*)xr)[F.lane + 64 * j]; }
#pragma unroll
        for (int q = 0; q < 4; ++q) { const int row = row4 + q; float s = 0.f;
#pragma unroll
            for (int j = 0; j < 4; ++j) { s += dot4(v[q][j]); u32x2 w; w.x = cvtpk(v[q][j][0], v[q][j][1]); w.y = cvtpk(v[q][j][2], v[q][j][3]); ((u32x2*)(XB + (size_t)row * DM))[F.lane + 64 * j] = w; }
            s = wave_sum(s);
            if (F.lane == 0) sq[row] = s; } } }
    __syncthreads();
    for (int u = F.bid; u < 2 * 32 * 16; u += F.G) { const int l = u >> 9, b = (u >> 4) & 31, pb = u & 15;
        const int pos = F.tid >> 3, part = F.tid & 7; const size_t tok = ((size_t)(l * 32 + b) * 1024 + pb * 64 + pos);
        const f32x4* cs = (const f32x4*)(F.in[I_CCKV] + tok * 128 + part * 16); float v[16];
#pragma unroll
        for (int j = 0; j < 4; ++j) { const f32x4 t = cs[j]; v[4 * j] = t[0]; v[4 * j + 1] = t[1]; v[4 * j + 2] = t[2]; v[4 * j + 3] = t[3]; }
        lds_w16(F.lds + pos * 336 + part * 32, pack8(v)); lds_w16(F.lds + pos * 336 + part * 32 + 16, pack8(v + 8));
        const f32x4 kr = *(const f32x4*)(F.in[I_CKR] + tok * 32 + part * 4); u32x2 w; w.x = cvtpk(kr[0], kr[1]); w.y = cvtpk(kr[2], kr[3]);
        *(LAS u32x2*)(F.lds + pos * 336 + 256 + part * 8) = w;
        __syncthreads();
        kv_write_tile(F, (bf16_t*)(F.ws + WS_KS + l * KS_LAYER) + ((size_t)b * TKS + pb * 64) * 160, (bf16_t*)(F.ws + WS_VTS + l * VTS_LAYER) + (size_t)b * 128 * TKS + pb * 64, TKS);
        __syncthreads();
    }
}

DI void kvprep_unit(const Frame& F, int l, int u) {
    const bool smp = u >= 1024; const int b = smp ? u - 1024 : u >> 5, c = smp ? 0 : u & 31, T = smp ? 64 : 2048;
    const size_t row0 = smp ? (size_t)MP + b * 64 : (size_t)b * 2048 + c * 64;
    const bf16_t* PROJ = (const bf16_t*)(F.ws + WS_PROJ);
    int tid_ = threadIdx.x; asm volatile("" : "+v"(tid_));
    const int tk = tid_ >> 3, part = tid_ & 7, t = c * 64 + tk, pos = smp ? 1024 + t : t;
    const bf16_t* pr = PROJ + (row0 + tk) * NPROJ;
    float v[16]; { const u32x4 a = *(const u32x4*)(pr + C_CKV + part * 16), bb = *(const u32x4*)(pr + C_CKV + part * 16 + 8); unpack8(a, v); unpack8(bb, v + 8); }
    float s = 0.f;
#pragma unroll
    for (int i = 0; i < 16; ++i) s += v[i] * v[i];
    s += __shfl_xor(s, 1); s += __shfl_xor(s, 2); s += __shfl_xor(s, 4);
    const float rs = rsqrtf(s * (1.f / 128.f) + EPS); const float* gk = F.in[I_KVN] + l * 128 + part * 16;
#pragma unroll
    for (int i = 0; i < 16; ++i) v[i] = v[i] * rs * gk[i];
    float* ock = F.out + (smp ? O_CKVS + ((size_t)(l * 32 + b) * 64 + t) * 128 : O_CKVP + ((size_t)(l * 32 + b) * 2048 + t) * 128) + part * 16;
#pragma unroll
    for (int j = 0; j < 4; ++j) ((f32x4*)ock)[j] = (f32x4){v[4 * j], v[4 * j + 1], v[4 * j + 2], v[4 * j + 3]};
    lds_w16(F.lds + tk * 336 + part * 32, pack8(v)); lds_w16(F.lds + tk * 336 + part * 32 + 16, pack8(v + 8));
    { const unsigned w1 = *(const unsigned*)(pr + C_KR + 2 * part), w2 = *(const unsigned*)(pr + C_KR + 16 + 2 * part);
      const float* rt = (const float*)(F.ws + WS_ROPE) + pos * 32 + 2 * part;
      const float x1a = bflo(w1), x1b = bfhi(w1), x2a = bflo(w2), x2b = bfhi(w2), ca = rt[0], cb = rt[1], sa = rt[16], sb = rt[17];
      const float o1a = x1a * ca - x2a * sa, o1b = x1b * cb - x2b * sb, o2a = x1a * sa + x2a * ca, o2b = x1b * sb + x2b * cb;
      float* okr = F.out + (smp ? O_KRS + ((size_t)(l * 32 + b) * 64 + t) * 32 : O_KRP + ((size_t)(l * 32 + b) * 2048 + t) * 32);
      *(f32x2_t*)(okr + 2 * part) = (f32x2_t){o1a, o1b}; *(f32x2_t*)(okr + 16 + 2 * part) = (f32x2_t){o2a, o2b};
      *(LAS unsigned*)(F.lds + tk * 336 + 256 + 4 * part) = cvtpk(o1a, o1b); *(LAS unsigned*)(F.lds + tk * 336 + 256 + 32 + 4 * part) = cvtpk(o2a, o2b); }
    __syncthreads();
    if (smp) kv_write_tile(F, (bf16_t*)(F.ws + WS_KS + l * KS_LAYER) + ((size_t)b * TKS + 1024) * 160, (bf16_t*)(F.ws + WS_VTS + l * VTS_LAYER) + (size_t)b * 128 * TKS + 1024, TKS);
    else kv_write_tile(F, (bf16_t*)(F.ws + WS_KP) + ((size_t)b * TKP + c * 64) * 160, (bf16_t*)(F.ws + WS_VTP) + (size_t)b * 128 * TKP + c * 64, TKP);
    __syncthreads();
}

DI void conv_unit(const Frame& F, int l, int u) {
    int tid_ = threadIdx.x; asm volatile("" : "+v"(tid_));
    const int cg = tid_ & 127, rs = tid_ >> 7, ch = 8 * cg;
    const bool smp = u >= 1024; const int b = smp ? u - 1024 : u >> 5, c = smp ? 0 : u & 31;
    bf16_t* PROJ = (bf16_t*)(F.ws + WS_PROJ); const bf16_t* HALO = (const bf16_t*)(F.ws + WS_HALO);
    const size_t row0 = (size_t)u * 64;
    const int tk = tid_ >> 3, part = tid_ & 7, t = c * 64 + tk, pos = smp ? 1024 + t : t;
    const bf16_t* pr = PROJ + (row0 + tk) * NPROJ;
    const u32x4 kva = *(const u32x4*)(pr + C_CKV + part * 16), kvb = *(const u32x4*)(pr + C_CKV + part * 16 + 8);
    const unsigned kw1 = *(const unsigned*)(pr + C_KR + 2 * part), kw2 = *(const unsigned*)(pr + C_KR + 16 + 2 * part);
    u32x4 uu[19];
#pragma unroll
    for (int i = 0; i < 19; ++i) { const int lr = 16 * rs - 3 + i;
        if (lr >= 0) uu[i] = *(const u32x4*)(PROJ + (row0 + lr) * NPROJ + C_XBC + ch);
        else if (c != 0) uu[i] = *(const u32x4*)(HALO + ((size_t)(u - 1) * 3 + (lr + 3)) * 1024 + ch);
        else if (!smp) uu[i] = (u32x4){0u, 0u, 0u, 0u};
        else { const float* sc = F.in[I_CONV] + ((size_t)(l * 32 + b) * 3 + (lr + 3)) * 1024 + ch; float t8[8];
#pragma unroll
            for (int e = 0; e < 8; ++e) t8[e] = sc[e];
            uu[i] = pack8(t8); } }
    if (smp || c == 31) { if (tid_ < 384) { const int k = tid_ >> 7; float t8[8]; unpack8(*(const u32x4*)(HALO + ((size_t)u * 3 + k) * 1024 + ch), t8);
        float* oc = F.out + (smp ? O_CONVS : O_CONVP) + ((size_t)(l * 32 + b) * 3 + k) * 1024 + ch;
        *(f32x4*)oc = (f32x4){t8[0], t8[1], t8[2], t8[3]}; *(f32x4*)(oc + 4) = (f32x4){t8[4], t8[5], t8[6], t8[7]}; } }
    asm volatile("s_waitcnt vmcnt(0)" ::: "memory"); __syncthreads();
    { float v[16]; unpack8(kva, v); unpack8(kvb, v + 8);
      float s = 0.f;
#pragma unroll
      for (int i = 0; i < 16; ++i) s += v[i] * v[i];
      s += __shfl_xor(s, 1); s += __shfl_xor(s, 2); s += __shfl_xor(s, 4);
      const float rsn = rsqrtf(s * (1.f / 128.f) + EPS); const float* gk = F.in[I_KVN] + l * 128 + part * 16;
#pragma unroll
      for (int i = 0; i < 16; ++i) v[i] = v[i] * rsn * gk[i];
      float* ock = F.out + (smp ? O_CKVS + ((size_t)(l * 32 + b) * 64 + t) * 128 : O_CKVP + ((size_t)(l * 32 + b) * 2048 + t) * 128) + part * 16;
#pragma unroll
      for (int j = 0; j < 4; ++j) ((f32x4*)ock)[j] = (f32x4){v[4 * j], v[4 * j + 1], v[4 * j + 2], v[4 * j + 3]};
      lds_w16(F.lds + tk * 336 + part * 32, pack8(v)); lds_w16(F.lds + tk * 336 + part * 32 + 16, pack8(v + 8));
      const float* rt = (const float*)(F.ws + WS_ROPE) + pos * 32 + 2 * part;
      const float x1a = bflo(kw1), x1b = bfhi(kw1), x2a = bflo(kw2), x2b = bfhi(kw2), ca = rt[0], cb2 = rt[1], sa = rt[16], sb = rt[17];
      const float o1a = x1a * ca - x2a * sa, o1b = x1b * cb2 - x2b * sb, o2a = x1a * sa + x2a * ca, o2b = x1b * sb + x2b * cb2;
      float* okr = F.out + (smp ? O_KRS + ((size_t)(l * 32 + b) * 64 + t) * 32 : O_KRP + ((size_t)(l * 32 + b) * 2048 + t) * 32);
      *(f32x2_t*)(okr + 2 * part) = (f32x2_t){o1a, o1b}; *(f32x2_t*)(okr + 16 + 2 * part) = (f32x2_t){o2a, o2b};
      *(LAS unsigned*)(F.lds + tk * 336 + 256 + 4 * part) = cvtpk(o1a, o1b); *(LAS unsigned*)(F.lds + tk * 336 + 256 + 32 + 4 * part) = cvtpk(o2a, o2b); }
    const float* cw = F.in[I_CW] + (size_t)l * 4 * 1024 + ch; const float* cb = F.in[I_CB] + l * 1024 + ch;
#pragma unroll
    for (int half = 0; half < 2; ++half) {
        unsigned rowpk[8][4];
#pragma unroll
        for (int e2 = 0; e2 < 4; ++e2) {
            float oo[2][8];
#pragma unroll
            for (int q = 0; q < 2; ++q) { const int e = 2 * e2 + q; const float w0 = cw[e], w1 = cw[1024 + e], w2 = cw[2048 + e], w3 = cw[3072 + e], bs = cb[e];
#pragma unroll
                for (int i = 0; i < 8; ++i) { const int ii = 8 * half + i;
                    const float a0 = q ? bfhi(uu[ii][e2]) : bflo(uu[ii][e2]), a1 = q ? bfhi(uu[ii + 1][e2]) : bflo(uu[ii + 1][e2]), a2 = q ? bfhi(uu[ii + 2][e2]) : bflo(uu[ii + 2][e2]), a3 = q ? bfhi(uu[ii + 3][e2]) : bflo(uu[ii + 3][e2]);
                    const float v = bs + w0 * a0 + w1 * a1 + w2 * a2 + w3 * a3; oo[q][i] = v * sigmoidf_(v); } }
#pragma unroll
            for (int i = 0; i < 8; ++i) rowpk[i][e2] = cvtpk(oo[0][i], oo[1][i]);
        }
#pragma unroll
        for (int i = 0; i < 8; ++i) *(u32x4*)(PROJ + (row0 + 16 * rs + 8 * half + i) * NPROJ + C_XBC + ch) = (u32x4){rowpk[i][0], rowpk[i][1], rowpk[i][2], rowpk[i][3]};
        if (half == 0) {
            __syncthreads();
            if (smp) kv_write_tile(F, (bf16_t*)(F.ws + WS_KS + l * KS_LAYER) + ((size_t)b * TKS + 1024) * 160, (bf16_t*)(F.ws + WS_VTS + l * VTS_LAYER) + (size_t)b * 128 * TKS + 1024, TKS);
            else kv_write_tile(F, (bf16_t*)(F.ws + WS_KP) + ((size_t)b * TKP + c * 64) * 160, (bf16_t*)(F.ws + WS_VTP) + (size_t)b * 128 * TKP + c * 64, TKP);
        }
    }
    asm volatile("s_waitcnt vmcnt(0)" ::: "memory"); __syncthreads();
}

DI void ssd_unit(const Frame& F, int l, int kind, int b, int hd, bool do_ssq = true) {
    int tid_ = threadIdx.x; asm volatile("" : "+v"(tid_));
    const int tid = tid_, lane = tid & 63, w = F.wave, r = lane & 31, hi = lane >> 5, g = hd >> 2;
    const int nch = kind == 0 ? 32 : 1;
    const size_t rowbase = kind == 0 ? (size_t)b * 2048 : (size_t)MP + b * 64;
    const bf16_t* PROJ = (const bf16_t*)(F.ws + WS_PROJ); bf16_t* AO = (bf16_t*)(F.ws + WS_AO);
    ldsp L = F.lds;
    constexpr int O_CS = 0, O_BS = 17408, O_BWT = 34816, O_XT = 53248, O_XS = 62464, O_WS = 71680, O_HS = 80896, O_YS = 98304, O_DT = 115712, O_CUM = 116224, O_XS2 = 116736;
    LAS float* dtS = (LAS float*)(L + O_DT); LAS float* cumS = (LAS float*)(L + O_CUM); LAS float* Ys = (LAS float*)(L + O_YS);
    const float Dsk = F.in[I_DSKIP][l * 8 + hd], dtb = F.in[I_DTB][l * 8 + hd], Aneg = -__expf(F.in[I_ALOG][l * 8 + hd]);
    const int pbh = w >> 2, nbh = w & 3;
    f32x16 hacc;
    float* hout = F.out + (kind == 0 ? O_SSMP : O_SSMS) + (size_t)((l * 32 + b) * 8 + hd) * 8192;
    if (kind == 0) {
#pragma unroll
        for (int i = 0; i < 16; ++i) hacc[i] = 0.f;
    } else { const float* h0 = F.in[I_SSM] + (size_t)((l * 32 + b) * 8 + hd) * 8192;
#pragma unroll
        for (int i = 0; i < 16; ++i) hacc[i] = h0[(32 * pbh + crow(i, hi)) * 128 + 32 * nbh + r]; }
#pragma unroll
    for (int i = 0; i < 16; ++i) *(LAS bf16_t*)(L + O_HS + (32 * pbh + crow(i, hi)) * 272 + (32 * nbh + r) * 2) = f2bf(hacc[i]);
    const int lbA = (w & 3) >> 1, sbA = w & 1;
    u32x4 uu[8]; float dtr_n = 0.f;
#define SSD_LOAD_UU(cc) do { const size_t row0_ = rowbase + 64 * (cc); const int cgl = tid >> 3, rsl = tid & 7; \
        const int chl = cgl < 8 ? hd * 64 + 8 * cgl : cgl < 24 ? 512 + g * 128 + 8 * (cgl - 8) : 768 + g * 128 + 8 * (cgl - 24); \
        if (tid < 320) { _Pragma("unroll") for (int i = 0; i < 8; ++i) uu[i] = *(const u32x4*)(PROJ + (row0_ + 8 * rsl + i) * NPROJ + C_XBC + chl); } } while (0)
#define SSD_SCAN(cc) do { const float dtr = dtr_n + dtb; const float dt = dtr > 20.f ? dtr : log1pf(__expf(dtr)); float a = dt * Aneg; \
        _Pragma("unroll") for (int off = 1; off < 64; off <<= 1) { const float t = __shfl_up(a, off); if (lane >= off) a += t; } \
        dtS[((cc) & 1) * 64 + lane] = dt; cumS[((cc) & 1) * 64 + lane] = a; } while (0)
#define SSD_EPI(row0e, xsoff) do { const int el = tid >> 3, pg = tid & 7; const size_t row = (row0e) + el; \
        const f32x4 y0 = *(const LAS f32x4*)(Ys + el * 68 + 8 * pg), y1 = *(const LAS f32x4*)(Ys + el * 68 + 8 * pg + 4); \
        float xv[8], zv[8], ov[8]; \
        unpack8(*(const LAS u32x4*)(L + (xsoff) + el * 144 + pg * 16), xv); unpack8(zk, zv); \
        float s = 0.f; \
        _Pragma("unroll") for (int e = 0; e < 8; ++e) { const float y = (e < 4 ? y0[e & 3] : y1[e & 3]) + Dsk * xv[e]; ov[e] = y * zv[e] * sigmoidf_(zv[e]); s += ov[e] * ov[e]; } \
        *(u32x4*)(AO + row * AOW + hd * 64 + 8 * pg) = pack8(ov); \
        s += __shfl_xor(s, 1); s += __shfl_xor(s, 2); s += __shfl_xor(s, 4); \
        if (pg == 0 && do_ssq) unsafeAtomicAdd(F.ssq(SQ_SSD0 + l) + row, s); } while (0)
    SSD_LOAD_UU(0);
    if (w == 7) { dtr_n = bf2f(PROJ[(rowbase + lane) * NPROJ + C_DT + hd]); SSD_SCAN(0); if (nch > 1) dtr_n = bf2f(PROJ[(rowbase + 64 + lane) * NPROJ + C_DT + hd]); }
    u32x4 zk = (u32x4){0u, 0u, 0u, 0u};
    __syncthreads();
    for (int c = 0; c < nch; ++c) {
        const size_t row0 = rowbase + 64 * c;
        int tl_ = threadIdx.x; asm volatile("" : "+v"(tl_));
        const int tid = tl_, lane = tid & 63, r = lane & 31, hi = lane >> 5;
        const int cg_ = tid >> 3, rs_ = tid & 7;
        const LAS float* dtC = dtS + (c & 1) * 64; const LAS float* cumC = cumS + (c & 1) * 64;
        const int xsC = (c & 1) ? O_XS2 : O_XS;
        if (c > 0) {
#pragma unroll
            for (int i = 0; i < 16; ++i) *(LAS bf16_t*)(L + O_HS + (32 * pbh + crow(i, hi)) * 272 + (32 * nbh + r) * 2) = f2bf(hacc[i]);
            SSD_EPI(row0 - 64, (c & 1) ? O_XS : O_XS2);
        }
        zk = *(const u32x4*)(PROJ + (row0 + (tid >> 3)) * NPROJ + C_Z + hd * 64 + 8 * (tid & 7));
        if (w == 7 && c + 1 < nch) { SSD_SCAN(c + 1); if (c + 2 < nch) dtr_n = bf2f(PROJ[(row0 + 128 + lane) * NPROJ + C_DT + hd]); }
        if (tid < 320) {
            const int l0 = 8 * rs_;
            const bool isB = cg_ >= 8 && cg_ < 24;
            float we[8];
            { const float last = cumC[63];
#pragma unroll
              for (int i = 0; i < 8; ++i) we[i] = isB ? __expf(last - cumC[l0 + i]) * dtC[l0 + i] : 1.f; }
            const ldsp tdst = cg_ < 8 ? L + O_XT + (8 * cg_) * 144 + l0 * 2 : L + O_BWT + (8 * (cg_ - 8)) * 144 + l0 * 2;
            const ldsp rdst = cg_ < 8 ? L + xsC + l0 * 144 + cg_ * 16 : isB ? L + O_BS + l0 * 272 + (cg_ - 8) * 16 : L + O_CS + l0 * 272 + (cg_ - 24) * 16;
            const int rstride = cg_ < 8 ? 144 : 272;
#pragma unroll
            for (int i = 0; i < 8; ++i) lds_w16(rdst + i * rstride, uu[i]);
            if (cg_ < 24) {
#pragma unroll
                for (int e2 = 0; e2 < 4; ++e2)
#pragma unroll
                    for (int q = 0; q < 2; ++q) { float t8[8];
#pragma unroll
                        for (int i = 0; i < 8; ++i) t8[i] = (q ? bfhi(uu[i][e2]) : bflo(uu[i][e2])) * we[i];
                        lds_w16(tdst + (2 * e2 + q) * 144, pack8(t8)); }
            }
        }
        if (c + 1 < nch) SSD_LOAD_UU(c + 1);
        __syncthreads();
        f32x16 accy;
#pragma unroll
        for (int i = 0; i < 16; ++i) accy[i] = 0.f;
        if (w < 4) {
            if (sbA <= lbA) {
#pragma unroll
                for (int ks = 0; ks < 8; ++ks) { const bf16x8 a = lds_r16(L + O_CS + (32 * lbA + r) * 272 + (16 * ks + 8 * hi) * 2), bb = lds_r16(L + O_BS + (32 * sbA + r) * 272 + (16 * ks + 8 * hi) * 2); accy = MFMA32(a, bb, accy); }
            }
            const int s = 32 * sbA + r; const float cs = cumC[s], ds = dtC[s];
#pragma unroll
            for (int i = 0; i < 16; ++i) { const int ll = 32 * lbA + crow(i, hi); const float val = s <= ll ? __expf(cumC[ll] - cs) * accy[i] * ds : 0.f;
                *(LAS bf16_t*)(L + O_WS + ll * 144 + s * 2) = f2bf(val); }
        } else {
#pragma unroll
            for (int ks = 0; ks < 8; ++ks) { const bf16x8 a = lds_r16(L + O_CS + (32 * lbA + r) * 272 + (16 * ks + 8 * hi) * 2), bb = lds_r16(L + O_HS + (32 * sbA + r) * 272 + (16 * ks + 8 * hi) * 2); accy = MFMA32(a, bb, accy); }
#pragma unroll
            for (int i = 0; i < 16; ++i) accy[i] *= __expf(cumC[32 * lbA + crow(i, hi)]);
        }
        __syncthreads();
        if (w >= 4) {
#pragma unroll
            for (int ks = 0; ks < 4; ++ks) { const bf16x8 a = lds_r16(L + O_WS + (32 * lbA + r) * 144 + (16 * ks + 8 * hi) * 2), bb = lds_r16(L + O_XT + (32 * sbA + r) * 144 + (16 * ks + 8 * hi) * 2); accy = MFMA32(a, bb, accy); }
#pragma unroll
            for (int i = 0; i < 16; ++i) Ys[(32 * lbA + crow(i, hi)) * 68 + 32 * sbA + r] = accy[i];
        }
        { const float el = __expf(cumC[63]);
#pragma unroll
          for (int i = 0; i < 16; ++i) hacc[i] *= el;
#pragma unroll
          for (int ks = 0; ks < 4; ++ks) { const bf16x8 a = lds_r16(L + O_XT + (32 * pbh + r) * 144 + (16 * ks + 8 * hi) * 2), bb = lds_r16(L + O_BWT + (32 * nbh + r) * 144 + (16 * ks + 8 * hi) * 2); hacc = MFMA32(a, bb, hacc); } }
        __syncthreads();
    }
    SSD_EPI(rowbase + 64 * (nch - 1), ((nch - 1) & 1) ? O_XS2 : O_XS);
    __syncthreads();
#undef SSD_EPI
#undef SSD_LOAD_UU
#undef SSD_SCAN
#pragma unroll
    for (int i = 0; i < 16; ++i) hout[(32 * pbh + crow(i, hi)) * 128 + 32 * nbh + r] = hacc[i];
}

DI void attn_unit(const Frame& F, int l, int kind, int b, int c, int hf) {
    int tid_ = threadIdx.x; asm volatile("" : "+v"(tid_));
    const int tid = tid_, lane = tid & 63, w = F.wave, r = lane & 31, hi = lane >> 5;
    size_t rowq0; int nt, ldvt; const bf16_t* Kb; const bf16_t* VTb;
    if (kind == 0) { rowq0 = (size_t)b * 2048 + 64 * c + 32 * hf; nt = c + 1; ldvt = TKP; Kb = (const bf16_t*)(F.ws + WS_KP) + (size_t)b * TKP * 160; VTb = (const bf16_t*)(F.ws + WS_VTP) + (size_t)b * 128 * TKP; }
    else { rowq0 = (size_t)MP + b * 64 + 32 * hf; nt = 17; ldvt = TKS; Kb = (const bf16_t*)(F.ws + WS_KS + l * KS_LAYER) + (size_t)b * TKS * 160; VTb = (const bf16_t*)(F.ws + WS_VTS + l * VTS_LAYER) + (size_t)b * 128 * TKS; }
    ldsp L = F.lds;
    constexpr int KTB = 21504, VTB = 18432, O_K = 0, O_V = 3 * KTB;
    const bf16_t* qrow = (const bf16_t*)(F.ws + WS_Q) + (rowq0 + r) * QW;
    bf16x8 qf[10];
#pragma unroll
    for (int ks = 0; ks < 8; ++ks) qf[ks] = *(const bf16x8*)(qrow + w * 128 + 16 * ks + 8 * hi);
#pragma unroll
    for (int ks = 0; ks < 2; ++ks) qf[8 + ks] = *(const bf16x8*)(qrow + 1024 + w * 32 + 16 * ks + 8 * hi);
    unsigned goff[5];
#pragma unroll
    for (int i = 0; i < 5; ++i) { const int ci = w + 8 * i;
        if (ci < 21) { const int o = ci * 1024 + 16 * lane, row = o / 336; int cb = o % 336; if (cb >= 320) cb = 0; goff[i] = (unsigned)(row * 160 + (cb >> 1)); }
        else { const int o = (ci - 21) * 1024 + 16 * lane, d = o / 144; int cb = o % 144; if (cb >= 128) cb = 0; goff[i] = (unsigned)(d * ldvt + (cb >> 1)); } }
#define ATT_DMA(j, kbuf, vbuf) do { _Pragma("unroll") for (int i = 0; i < 5; ++i) { const int ci = w + 8 * i; \
        if (ci < 21) __builtin_amdgcn_global_load_lds((const unsigned*)(Kb + (size_t)(j) * 64 * 160 + goff[i]), (LAS unsigned*)(L + O_K + (kbuf) * KTB + ci * 1024), 16, 0, 0); \
        else if (ci < 39) __builtin_amdgcn_global_load_lds((const unsigned*)(VTb + (size_t)(j) * 64 + goff[i]), (LAS unsigned*)(L + O_V + (vbuf) * VTB + (ci - 21) * 1024), 16, 0, 0); } } while (0)
    ATT_DMA(0, 0, 0);
    if (nt > 1) ATT_DMA(1, 1, 1);
    f32x16 o[4];
#pragma unroll
    for (int d = 0; d < 4; ++d)
#pragma unroll
        for (int i = 0; i < 16; ++i) o[d][i] = 0.f;
    float mhat = 0.f, lsum = 0.f; f32x16 negm;
#pragma unroll
    for (int i = 0; i < 16; ++i) negm[i] = 0.f;
    f32x16 p0, p1; bf16x8 pb[4];
#define ATT_QK(kbuf) do { const ldsp kb_ = L + O_K + (kbuf) * KTB + r * 336 + 16 * hi; bf16x8 kf[6]; \
        _Pragma("unroll") for (int ks = 0; ks < 3; ++ks) { kf[2 * ks] = lds_r16(kb_ + 32 * ks); kf[2 * ks + 1] = lds_r16(kb_ + 32 * 336 + 32 * ks); } \
        __builtin_amdgcn_sched_barrier(0); \
        _Pragma("unroll") for (int ks = 0; ks < 10; ++ks) { const int sl = ks % 3; \
            if (ks == 0) { p0 = MFMA32(kf[0], qf[0], negm); p1 = MFMA32(kf[1], qf[0], negm); } \
            else { p0 = MFMA32(kf[2 * sl], qf[ks], p0); p1 = MFMA32(kf[2 * sl + 1], qf[ks], p1); } \
            if (ks + 3 < 10) { kf[2 * sl] = lds_r16(kb_ + 32 * (ks + 3)); kf[2 * sl + 1] = lds_r16(kb_ + 32 * 336 + 32 * (ks + 3)); } \
            __builtin_amdgcn_sched_barrier(0); } } while (0)
#define MX3(a, b, c) __builtin_fmaxf(__builtin_fmaxf((a), (b)), (c))
#define ATT_SM() do { float mx = MX3(p0[0], p0[1], p1[0]), mx2 = MX3(p1[1], p0[2], p1[2]); \
        _Pragma("unroll") for (int i = 3; i < 15; i += 2) { mx = MX3(mx, p0[i], p1[i]); mx2 = MX3(mx2, p0[i + 1], p1[i + 1]); } \
        mx = MX3(mx, mx2, p0[15]); mx = fmaxf(mx, p1[15]); \
        mx = fmaxf(mx, __shfl_xor(mx, 32)); \
          \
        if (__builtin_amdgcn_ballot_w64(mx > thr_) != 0ull) { const float dl = fmaxf(mx, flr_); mhat += dl; \
            _Pragma("unroll") for (int i = 0; i < 16; ++i) { p0[i] -= dl; p1[i] -= dl; } \
            _Pragma("unroll") for (int i = 0; i < 16; ++i) negm[i] = -mhat; \
            const float alpha = __builtin_amdgcn_exp2f(fminf(-dl, 60.f)); lsum *= alpha; \
            _Pragma("unroll") for (int d = 0; d < 4; ++d) _Pragma("unroll") for (int i = 0; i < 16; ++i) o[d][i] *= alpha; } \
        float ps = 0.f, ps2 = 0.f; \
        _Pragma("unroll") for (int i = 0; i < 16; ++i) { p0[i] = __builtin_amdgcn_exp2f(p0[i]); p1[i] = __builtin_amdgcn_exp2f(p1[i]); ps += p0[i]; ps2 += p1[i]; } \
        lsum += ps + ps2; \
        _Pragma("unroll") for (int kk = 0; kk < 2; ++kk) { u32x4 t; t.x = cvtpk(p0[8 * kk], p0[8 * kk + 1]); t.y = cvtpk(p0[8 * kk + 2], p0[8 * kk + 3]); t.z = cvtpk(p0[8 * kk + 4], p0[8 * kk + 5]); t.w = cvtpk(p0[8 * kk + 6], p0[8 * kk + 7]); pb[kk] = __builtin_bit_cast(bf16x8, t); \
            t.x = cvtpk(p1[8 * kk], p1[8 * kk + 1]); t.y = cvtpk(p1[8 * kk + 2], p1[8 * kk + 3]); t.z = cvtpk(p1[8 * kk + 4], p1[8 * kk + 5]); t.w = cvtpk(p1[8 * kk + 6], p1[8 * kk + 7]); pb[2 + kk] = __builtin_bit_cast(bf16x8, t); } } while (0)
#define ATT_PV(vbuf) do { const ldsp vb_ = L + O_V + (vbuf) * VTB + r * 144 + 16 * hi; bf16x8 vf[8]; \
        _Pragma("unroll") for (int q = 0; q < 2; ++q) _Pragma("unroll") for (int d = 0; d < 4; ++d) vf[4 * q + d] = lds_r16(vb_ + d * 32 * 144 + q * 32); \
        __builtin_amdgcn_sched_barrier(0); \
        _Pragma("unroll") for (int q = 0; q < 4; ++q) { _Pragma("unroll") for (int d = 0; d < 4; ++d) o[d] = MFMA32(vf[4 * (q & 1) + d], pb[q], o[d]); \
            if (q + 2 < 4) { _Pragma("unroll") for (int d = 0; d < 4; ++d) vf[4 * (q & 1) + d] = lds_r16(vb_ + d * 32 * 144 + (q + 2) * 32); } \
            __builtin_amdgcn_sched_barrier(0); } } while (0)
    asm volatile("s_waitcnt vmcnt(0)\n\ts_barrier" ::: "memory");
    int st = 0;
    for (int j = 0; j < nt; ++j) {
        const int st2 = st == 0 ? 2 : st - 1;
        if (j + 2 < nt) ATT_DMA(j + 2, st2, st2);
        int jz = j; asm volatile("" : "+s"(jz));
        const float thr_ = jz ? 8.f : -3e38f, flr_ = jz ? 0.f : -3e38f;
        ATT_QK(st); ATT_SM(); ATT_PV(st);
        if (j + 2 < nt) { if (w < 7) asm volatile("s_waitcnt vmcnt(5)\n\ts_barrier" ::: "memory"); else asm volatile("s_waitcnt vmcnt(4)\n\ts_barrier" ::: "memory"); }
        else asm volatile("s_waitcnt vmcnt(0)\n\ts_barrier" ::: "memory");
        st = st == 2 ? 0 : st + 1;
    }
#undef ATT_DMA
#undef ATT_QK
#undef ATT_SM
#undef MX3
#undef ATT_PV
    lsum += __shfl_xor(lsum, 32);
    const size_t row = rowq0 + r;
    const float inv = __builtin_amdgcn_rcpf(lsum);
    bf16x8 ob[8];
#pragma unroll
    for (int d = 0; d < 4; ++d)
#pragma unroll
        for (int kk = 0; kk < 2; ++kk) { u32x4 t; t.x = cvtpk(o[d][8 * kk] * inv, o[d][8 * kk + 1] * inv); t.y = cvtpk(o[d][8 * kk + 2] * inv, o[d][8 * kk + 3] * inv); t.z = cvtpk(o[d][8 * kk + 4] * inv, o[d][8 * kk + 5] * inv); t.w = cvtpk(o[d][8 * kk + 6] * inv, o[d][8 * kk + 7] * inv); ob[2 * d + kk] = __builtin_bit_cast(bf16x8, t); }
    const bf16_t* wuv = F.wt(l, WO_UV) + (size_t)(w * 64 + r) * 128 + 8 * hi;
    f32x16 D0, D1;
#pragma unroll
    for (int i = 0; i < 16; ++i) { D0[i] = 0.f; D1[i] = 0.f; }
#pragma unroll
    for (int s8 = 0; s8 < 8; ++s8) { const bf16x8 a0 = *(const bf16x8*)(wuv + 16 * s8), a1 = *(const bf16x8*)(wuv + 32 * 128 + 16 * s8); D0 = MFMA32(a0, ob[s8], D0); D1 = MFMA32(a1, ob[s8], D1); }
    const float fac = sqrtf(F.ssq(SQ_SSD0 + l)[row] * (1.f / 512.f) + EPS);
    bf16_t* orow = (bf16_t*)(F.ws + WS_AO) + row * AOW + 512 + w * 64 + 4 * hi;
#pragma unroll
    for (int q = 0; q < 4; ++q) { u32x2 t; t.x = cvtpk(D0[4 * q] * fac, D0[4 * q + 1] * fac); t.y = cvtpk(D0[4 * q + 2] * fac, D0[4 * q + 3] * fac); *(u32x2*)(orow + 8 * q) = t;
        t.x = cvtpk(D1[4 * q] * fac, D1[4 * q + 1] * fac); t.y = cvtpk(D1[4 * q + 2] * fac, D1[4 * q + 3] * fac); *(u32x2*)(orow + 32 + 8 * q) = t; }
}

#define XB_TMO      128
#define XB_XCNT(j)  (256  + 64 * (j))
#define XB_XSUB(j)  (1280 + 64 * (j))
#define XB_XGEN(j)  (2304 + 64 * (j))
#define XB_TOP      3328
#define XB_TOPGEN   3392
#define XCD_BAR_WORDS 3456
#define XB_SPIN_CAP (1u << 20)
DI unsigned xb_ld(unsigned* p)              { return __hip_atomic_load(p, __ATOMIC_RELAXED, __HIP_MEMORY_SCOPE_AGENT); }
DI unsigned xb_add(unsigned* p, unsigned v) { return __hip_atomic_fetch_add(p, v, __ATOMIC_RELAXED, __HIP_MEMORY_SCOPE_AGENT); }
DI unsigned xb_xcc_id() { return (unsigned)__builtin_amdgcn_s_getreg((3 << 11) | 20) & 0xFu; }
#define XB_SPIN(cond, bar) do { unsigned _sp = 0; while (cond) { __builtin_amdgcn_s_sleep(1); \
    if ((++_sp & 255u) == 0u) { if (xb_ld(&(bar)[XB_TMO])) break; if (_sp > XB_SPIN_CAP) { atomicAdd(&(bar)[XB_TMO], 1u); break; } } } } while (0)
struct XcdBarrier { unsigned* bar; unsigned x; volatile LAS unsigned* st; };
DI XcdBarrier xcd_barrier_post(unsigned* bar, volatile LAS unsigned* st) {
    XcdBarrier b; b.bar = bar; b.x = xb_xcc_id(); b.st = st;
    if (threadIdx.x == 0) (void)xb_add(&bar[XB_XCNT(b.x)], 1u);
    return b;
}
DI void xcd_barrier_complete(unsigned* bar, unsigned x, unsigned& nloc, unsigned& nx) {
    const unsigned G = gridDim.x * gridDim.y * gridDim.z;
    unsigned sum, cnt, mine, sp = 0u;
    for (;;) {
        sum = 0u; cnt = 0u; mine = 0u;
#pragma unroll
        for (unsigned j = 0; j < 16; ++j) { const unsigned c = xb_ld(&bar[XB_XCNT(j)]); sum += c; cnt += (c > 0u) ? 1u : 0u; mine = (j == x) ? c : mine; }
        if (sum == G) break;
        __builtin_amdgcn_s_sleep(1);
        if ((++sp & 255u) == 0u) { if (xb_ld(&bar[XB_TMO])) break; if (sp > XB_SPIN_CAP) { atomicAdd(&bar[XB_TMO], 1u); break; } }
    }
    nloc = mine > 0u ? mine : 1u; nx = cnt > 0u ? cnt : 1u;
}
DI void xcd_barrier(const XcdBarrier& b) {
    asm volatile("s_waitcnt vmcnt(0)" ::: "memory");
    __syncthreads();
    if (threadIdx.x == 0) {
        unsigned* bar = b.bar;
        __builtin_amdgcn_s_waitcnt(0);
        unsigned nloc = b.st[0], nx = b.st[1];
        if (nloc == 0u) { xcd_barrier_complete(bar, b.x, nloc, nx); b.st[0] = nloc; b.st[1] = nx; }
        const unsigned old = xb_add(&bar[XB_XSUB(b.x)], 1u);
        const unsigned gen = old / nloc;
        if (old + 1u == (gen + 1u) * nloc) {
            __builtin_amdgcn_fence(__ATOMIC_RELEASE, "agent");
            asm volatile("s_waitcnt vmcnt(0)" ::: "memory");
            const unsigned og = xb_add(&bar[XB_TOP], 1u);
            const unsigned tg = og / nx;
            if (og + 1u == (tg + 1u) * nx) xb_add(&bar[XB_TOPGEN], 1u);
            else XB_SPIN(xb_ld(&bar[XB_TOPGEN]) == tg, bar);
            __builtin_amdgcn_fence(__ATOMIC_ACQUIRE, "agent");
            xb_add(&bar[XB_XGEN(b.x)], 1u);
            asm volatile("s_waitcnt vmcnt(0)" ::: "memory");
        } else {
            XB_SPIN(xb_ld(&bar[XB_XGEN(b.x)]) == gen, bar);
            __builtin_amdgcn_fence(__ATOMIC_ACQUIRE, "agent");
            asm volatile("s_waitcnt vmcnt(0)" ::: "memory");
        }
    }
    __syncthreads();
}

__global__ void __launch_bounds__(512, 2) mk_fwd(Args args) {
    extern __shared__ __attribute__((aligned(16))) unsigned char lds_raw[];
    Frame F;
    F.lds = (ldsp)lds_raw; F.tid = threadIdx.x; F.lane = F.tid & 63; F.wave = __builtin_amdgcn_readfirstlane(F.tid >> 6); F.G = gridDim.x; F.bid = blockIdx.x;
    F.in = args.in; F.out = args.out; F.ws = args.ws;
    cg::grid_group grid = cg::this_grid();
    volatile LAS unsigned* MISC = (volatile LAS unsigned*)(F.lds + 131072 + 512);
    if (threadIdx.x < 4) MISC[threadIdx.x] = 0u;
    __syncthreads();
    XcdBarrier xbar = xcd_barrier_post((unsigned*)F.ws, MISC);
    const int lo = args.ph_lo, hi = args.ph_hi;
#define IN(k) (lo <= (k) && (k) < hi)
#define SEAM(k) do { if (IN(k) && IN((k) + 1)) { if (lo < 0) grid.sync(); else xcd_barrier(xbar); } } while (0)
    bf16_t* XB = (bf16_t*)(F.ws + WS_XB); bf16_t* AO = (bf16_t*)(F.ws + WS_AO); bf16_t* PROJ = (bf16_t*)(F.ws + WS_PROJ); bf16_t* Qb = (bf16_t*)(F.ws + WS_Q); bf16_t* Hb = (bf16_t*)(F.ws + WS_H);
    float* XR = F.out;

    if (IN(0)) { p0_prologue(F); }
    SEAM(0);
#ifdef PROBE_SYNC
    for (int i = 0; i < 20; ++i) grid.sync();
#endif
#ifdef PROBE_P0
    if (IN(0)) { p0_prologue(F); } grid.sync();
#endif
    for (int l = 0; l < 2; ++l) {
        const int p = 1 + 7 * l;
        { int t_ = threadIdx.x; asm volatile("" : "+v"(t_)); F.tid = t_; F.lane = t_ & 63; }
        if (IN(p)) {
            pg8::Gemm g{XB, F.wt(l, WO_IN), MT, NPROJ, DM, DM, DM}; pg8::StaticOrder S; S.init(MT, NPROJ, F.G, F.bid);
            EpiInproj E{PROJ, F.ssq(l == 0 ? SQ_X0 : SQ_X1), F.ssq(SQ_Q0 + l), (bf16_t*)(F.ws + WS_HALO)};
            pg8::gemm_phase<EpiInproj, true>(F.lds, g, S, E);
        }
        SEAM(p);
        if (IN(p + 1)) {
            for (int u = F.bid; u < 1056; u += F.G) conv_unit(F, l, u);
            asm volatile("s_waitcnt vmcnt(0) lgkmcnt(0)" ::: "memory"); __syncthreads();
            pg8::Gemm g{PROJ + C_CQ, F.wt(l, WO_Q), MT, QW, 256, NPROJ, 256}; pg8::StaticOrder S; S.init(MT, QW, F.G, F.bid);
            EpiQ E{Qb, F.ssq(SQ_Q0 + l), (const float*)(F.ws + WS_ROPE)};
            pg8::gemm_phase<EpiQ, true>(F.lds, g, S, E);
        }
        SEAM(p + 1);
        if (IN(p + 2)) {
            for (int u = F.bid; u < 256; u += F.G) ssd_unit(F, l, 0, u >> 3, u & 7);
            for (int u = F.bid; u < 256; u += F.G) ssd_unit(F, l, 1, u >> 3, u & 7);
        }
        SEAM(p + 2);
        if (IN(p + 3)) for (int rep = 0; rep < REP_ATT; ++rep) {
            if (rep) xcd_barrier(xbar);
            const bool xl = F.G == 256; const int nloc = xl ? 32 : F.G, lc = xl ? F.bid >> 3 : F.bid, ntot = xl ? 264 : 2112;
            for (int rd = 0; rd * nloc < ntot; ++rd) { const int pos = (rd & 1) ? nloc - 1 - lc : lc; const int lu = rd * nloc + pos; if (lu >= ntot) continue;
                const int level = xl ? lu >> 3 : lu >> 6, within = xl ? lu & 7 : lu & 63, b = xl ? 4 * (F.bid & 7) + (within >> 1) : within >> 1, hf = within & 1;
                attn_unit(F, l, level == 16 ? 1 : 0, b, level < 16 ? 31 - level : level == 16 ? 0 : 32 - level, hf); }
            asm volatile("s_waitcnt vmcnt(0) lgkmcnt(0)" ::: "memory"); __syncthreads();
        }
        SEAM(p + 3);
        if (IN(p + 4)) {
            pg8::Gemm g{AO, F.wt(l, WO_OUT), MT, DM, AOW, AOW, AOW}; pg8::StaticOrder S; S.init(MT, DM, F.G, F.bid);
            EpiRes E{XB, F.ssq(SQ_SSD0 + l), F.ssq(SQ_FFN0 + l)};
            pg8::gemm_phase<EpiRes, true>(F.lds, g, S, E);
        }
        SEAM(p + 4);
        if (IN(p + 5)) for (int rep = 0; rep < REP_GU; ++rep) {
            if (rep) xcd_barrier(xbar);
            pg8::Gemm g{XB, F.wt(l, WO_GU), MT, GUW, DM, DM, DM}; pg8::StaticOrder S; S.init(MT, GUW, F.G, F.bid);
            EpiGU E{Hb, F.ssq(SQ_FFN0 + l)};
            pg8::gemm_phase<EpiGU, true>(F.lds, g, S, E);
        }
        SEAM(p + 5);
        if (IN(p + 6)) {
            pg8::Gemm g{Hb, F.wt(l, WO_DN), MT, DM, FF, FF, FF}; pg8::StaticOrder S; S.init(MT, DM, F.G, F.bid);
            EpiRes E{XB, nullptr, F.ssq(SQ_X1 + l)};
            pg8::gemm_phase<EpiRes, true>(F.lds, g, S, E);
        }
        SEAM(p + 6);
    }
    if (IN(15)) {
        { int t_ = threadIdx.x; asm volatile("" : "+v"(t_)); F.tid = t_; F.lane = t_ & 63; }
        const float* sq = F.ssq(SQ_X2); const float* gf = F.in[I_NFIN];
        f32x4 gg[4];
#pragma unroll
        for (int j = 0; j < 4; ++j) gg[j] = ((const f32x4*)gf)[F.lane + 64 * j];
        for (int row4 = (F.bid * 8 + F.wave) * 4; row4 < MT; row4 += F.G * 8 * 4) {
            u32x2 xw[4][4]; float rs[4];
#pragma unroll
            for (int q = 0; q < 4; ++q) { const int row = row4 + q; rs[q] = sq[row];
#pragma unroll
                for (int j = 0; j < 4; ++j) xw[q][j] = ((const u32x2*)(XB + (size_t)row * DM))[F.lane + 64 * j]; }
#pragma unroll
            for (int q = 0; q < 4; ++q) { const int row = row4 + q; const float r = rsqrtf(rs[q] * (1.f / 1024.f) + EPS); f32x4* yr = (f32x4*)(XR + (size_t)row * DM);
#pragma unroll
                for (int j = 0; j < 4; ++j) { const f32x4 xv = {bflo(xw[q][j].x), bfhi(xw[q][j].x), bflo(xw[q][j].y), bfhi(xw[q][j].y)}; yr[F.lane + 64 * j] = xv * r * gg[j]; } } }
    }
#undef IN
#undef SEAM
}

extern "C" void kernel_launch(void* const* d_in, const int* in_sizes, int n_in, void* d_out, int out_size, void* d_ws, size_t ws_size, hipStream_t stream) {
    static int grid = 0;
    if (grid == 0) {
        if (n_in != 25 || (size_t)out_size != O_END || ws_size < WS_END) { fprintf(stderr, "kernel_launch: unexpected sizes n_in %d out %d ws %zu\n", n_in, out_size, ws_size); grid = -1; return; }
        int dev = 0, cus = 0, per_cu = 0;
        hipGetDevice(&dev); hipDeviceGetAttribute(&cus, hipDeviceAttributeMultiprocessorCount, dev);
        hipFuncSetAttribute((const void*)mk_fwd, hipFuncAttributeMaxDynamicSharedMemorySize, LDS_BYTES);
        hipOccupancyMaxActiveBlocksPerMultiprocessor(&per_cu, (const void*)mk_fwd, 512, LDS_BYTES);
        if (per_cu < 1) { fprintf(stderr, "kernel_launch: occupancy query says %d blocks/CU\n", per_cu); per_cu = 1; }
        (void)hipGetLastError();
        grid = cus;
        fprintf(stderr, "kernel_launch: grid %d (cus %d, per_cu %d)\n", grid, cus, per_cu);
    }
    if (grid < 0) return;
    if (hipMemsetAsync(d_ws, 0, 16384, stream) != hipSuccess) { fprintf(stderr, "kernel_launch: memset failed\n"); return; }
    Args a{};
    for (int i = 0; i < 25; ++i) a.in[i] = (const float*)d_in[i];
    a.out = (float*)d_out; a.ws = (unsigned char*)d_ws;
#if MK_N_LAUNCHES == 1
    a.ph_lo = 0; a.ph_hi = NPH;
    void* kargs[] = {&a};
    hipError_t e = hipLaunchCooperativeKernel((const void*)mk_fwd, dim3(grid), dim3(512), kargs, LDS_BYTES, stream);
    if (e != hipSuccess) fprintf(stderr, "cooperative launch failed: %s (grid %d)\n", hipGetErrorString(e), grid);
#else
    for (int p = 0; p < NPH; ++p) { a.ph_lo = p; a.ph_hi = p + 1; hipLaunchKernelGGL(mk_fwd, dim3(grid), dim3(512), LDS_BYTES, stream, a); }
#endif
}
```

```cpp
#include <hip/hip_runtime.h>
#include <hip/hip_cooperative_groups.h>
#include <cstdio>
#include <cstdint>
namespace cg = cooperative_groups;

#ifndef MK_N_LAUNCHES
#define MK_N_LAUNCHES 1
#endif

#define DI __device__ __forceinline__
#define LAS __attribute__((address_space(3)))
typedef unsigned short bf16_t;
typedef short bf16x8 __attribute__((ext_vector_type(8)));
typedef float f32x4 __attribute__((ext_vector_type(4)));
typedef float f32x16 __attribute__((ext_vector_type(16)));
typedef unsigned u32x4 __attribute__((ext_vector_type(4)));
typedef unsigned u32x2 __attribute__((ext_vector_type(2)));
typedef float f32x2_t __attribute__((ext_vector_type(2)));
typedef __bf16 bf16x2_t __attribute__((ext_vector_type(2)));
typedef LAS unsigned char* ldsp;

constexpr int MP = 65536, MS = 2048, MT = MP + MS;
constexpr int DM = 1024, NPROJ = 2048, QW = 1280, AOW = 1024, FF = 2816, GUW = 2 * FF;
constexpr int C_Z = 0, C_XBC = 512, C_CQ = 1536, C_CKV = 1792, C_KR = 1920, C_DT = 1952;
constexpr float EPS = 1e-6f;
constexpr float QSCALE = 0.10206207261596577f * 1.4426950408889634f;
constexpr int TKP = 2048, TKS = 1088;

constexpr size_t O_YP = 0, O_YS = O_YP + (size_t)MP * DM, O_CKVP = O_YS + (size_t)MS * DM, O_KRP = O_CKVP + (size_t)2 * 32 * 2048 * 128,
                 O_SSMP = O_KRP + (size_t)2 * 32 * 2048 * 32, O_CONVP = O_SSMP + (size_t)2 * 32 * 8 * 64 * 128, O_CKVS = O_CONVP + (size_t)2 * 32 * 3 * 1024,
                 O_KRS = O_CKVS + (size_t)2 * 32 * 64 * 128, O_SSMS = O_KRS + (size_t)2 * 32 * 64 * 32, O_CONVS = O_SSMS + (size_t)2 * 32 * 8 * 64 * 128,
                 O_END = O_CONVS + (size_t)2 * 32 * 3 * 1024;
constexpr size_t MiB = 1u << 20;
constexpr size_t WS_SSQ = 1 * MiB, WS_ROPE = 4 * MiB, WS_W = 8 * MiB, W_LAYER = 25 * MiB;
constexpr size_t WO_IN = 0, WO_Q = 4 * MiB, WO_UV = 4 * MiB + 640 * 1024, WO_OUT = 5 * MiB, WO_GU = 8 * MiB, WO_DN = 19 * MiB;
constexpr size_t WS_KP = 64 * MiB, WS_VTP = 84 * MiB, WS_KS = 100 * MiB, KS_LAYER = 11 * MiB, WS_VTS = 122 * MiB, VTS_LAYER = 9 * MiB;
constexpr size_t WS_XB = 144 * MiB, WS_AO = 276 * MiB, WS_PROJ = 474 * MiB, WS_Q = 738 * MiB, WS_H = WS_PROJ, WS_HALO = 903 * MiB, WS_END = 910 * MiB;
static_assert((size_t)MT * DM * 2 <= WS_AO - WS_XB && (size_t)MT * AOW * 2 <= WS_PROJ - WS_AO && (size_t)MT * NPROJ * 2 <= WS_Q - WS_PROJ && (size_t)MT * QW * 2 <= WS_HALO - WS_Q && (size_t)MT * FF * 2 <= WS_HALO - WS_H && (size_t)1056 * 3 * 1024 * 2 <= WS_END - WS_HALO, "ws map");
static_assert((size_t)32 * TKS * 160 * 2 <= KS_LAYER && (size_t)32 * 128 * TKS * 2 <= VTS_LAYER && (size_t)32 * TKP * 160 * 2 <= WS_VTP - WS_KP && (size_t)32 * 128 * TKP * 2 <= WS_KS - WS_VTP, "ws map 2");
constexpr int SQ_X0 = 0, SQ_X1 = 1, SQ_X2 = 2, SQ_Q0 = 3, SQ_SSD0 = 5, SQ_FFN0 = 7, SQ_N = 9;
static_assert((size_t)SQ_N * MT * 4 <= WS_ROPE - WS_SSQ, "ssq");

constexpr int LDS_BYTES = 147456;
#ifndef REP_ATT
#define REP_ATT 1
#endif
#ifndef REP_GU
#define REP_GU 1
#endif
constexpr int NPH = 16;

DI unsigned cvtpk(float lo, float hi) { f32x2_t v = {lo, hi}; bf16x2_t b = __builtin_convertvector(v, bf16x2_t); return __builtin_bit_cast(unsigned, b); }
DI bf16_t f2bf(float f) { return (bf16_t)(cvtpk(f, 0.f) & 0xffffu); }
DI float bf2f(bf16_t v) { return __uint_as_float((unsigned)v << 16); }
DI float bflo(unsigned w) { return __uint_as_float(w << 16); }
DI float bfhi(unsigned w) { return __uint_as_float(w & 0xffff0000u); }
DI u32x4 pack8(const float* v) { u32x4 w; w.x = cvtpk(v[0], v[1]); w.y = cvtpk(v[2], v[3]); w.z = cvtpk(v[4], v[5]); w.w = cvtpk(v[6], v[7]); return w; }
DI void unpack8(u32x4 w, float* v) { v[0] = bflo(w.x); v[1] = bfhi(w.x); v[2] = bflo(w.y); v[3] = bfhi(w.y); v[4] = bflo(w.z); v[5] = bfhi(w.z); v[6] = bflo(w.w); v[7] = bfhi(w.w); }
DI bf16x8 lds_r16(ldsp p) { return *(const LAS bf16x8*)p; }
DI void lds_w16(ldsp p, u32x4 v) { *(LAS u32x4*)p = v; }
DI int crow(int r, int hi) { return (r & 3) + 8 * (r >> 2) + 4 * hi; }
DI float wave_sum(float v) {
#pragma unroll
    for (int o = 1; o < 64; o <<= 1) v += __shfl_xor(v, o);
    return v;
}
DI float sigmoidf_(float x) { return __builtin_amdgcn_rcpf(1.f + __expf(-x)); }
#define MFMA32(a, b, c) __builtin_amdgcn_mfma_f32_32x32x16_bf16((a), (b), (c), 0, 0, 0)
#define LDS_WAIT() asm volatile("s_waitcnt lgkmcnt(0)" ::: "memory")

namespace pg8 {
constexpr int BM = 256, BK = 64, HALF = 128, HTB = HALF * BK * 2, STAGE_BYTES = 8 * HTB, NXCD = 8, WGM = 8;
DI int lds_byte(int r, int c) { const int st = (r >> 4) * 2 + (c >> 5), rr = r & 15, cc = c & 31, ob = rr * 64 + cc * 2; return st * 1024 + (ob ^ (((ob >> 9) & 1) << 5)); }
DI void stage_rc(int b, int& R, int& C) { const int st = b / 1024, sb = b % 1024, swz = sb ^ (((sb >> 9) & 1) << 5); R = (st >> 1) * 16 + swz / 64; C = (st & 1) * 32 + (swz % 64) / 2; }
DI int perm32(int rho) { const int n = rho >> 4, i = rho & 15; return 8 * (i >> 2) + 4 * n + (i & 3); }
struct Unit { int pm, pn; };
struct Gemm { const bf16_t* A; const bf16_t* Bt; int M, N, K, lda, ldb; };
struct StaticOrder {
    int nM, nN, nwg, G, c;
    DI void init(int M, int N, int G_, int c_) { nM = M / BM; nN = N / BM; nwg = nM * nN; G = G_; c = c_; }
    DI bool next(int i, Unit& u) const {
        const long L = (long)i * G + c; if (L >= nwg) return false;
        int wgid = (int)L; { const int q = nwg / NXCD, r = nwg % NXCD, xcd = wgid % NXCD, off = wgid / NXCD; wgid = (xcd < r ? xcd * (q + 1) : r * (q + 1) + (xcd - r) * q) + off; }
        const int nig = WGM * nN, gid = wgid / nig, fm = gid * WGM, gsz = (nM - fm) < WGM ? (nM - fm) : WGM;
        u.pm = fm + ((wgid % nig) % gsz); u.pn = (wgid % nig) / gsz; return true;
    }
};
template <class Epi, bool ALIGN_EPI>
DI void gemm_phase(ldsp lds, const Gemm g, const StaticOrder& S, const Epi& E) {
    int tid_ = threadIdx.x; asm volatile("" : "+v"(tid_));
    const int tid = tid_, wid = __builtin_amdgcn_readfirstlane(tid >> 6), lane = tid & 63, wr = wid >> 2, wc = wid & 3, fr = lane & 15, fq = lane >> 4;
    const int K = g.K, nt = K / BK;
    unsigned voffA[2], voffB[2];
#pragma unroll
    for (int i = 0; i < 2; ++i) { int R, C; stage_rc(tid * 16 + i * 8192, R, C); const int Rb = Epi::PERM ? ((R & ~31) + perm32(R & 31)) : R;
        voffA[i] = (unsigned)(R * g.lda + C) * 2u; voffB[i] = (unsigned)(Rb * g.ldb + C) * 2u; }
    const size_t kstep = (size_t)(BK * 2);
    const size_t hstepA = (size_t)HALF * g.lda * 2, hstepB = (size_t)HALF * g.ldb * 2;
    const size_t tstepA = 2 * hstepA, tstepB = 2 * hstepB;
    const unsigned ldsw = (unsigned)wid * 1024u;
    const int aoff = lds_byte(wr * 64 + fr, fq * 8), boff = lds_byte(wc * 32 + fr, fq * 8);
#define PG8_SA(b, h) (((b) * 2 + (h)) * HTB)
#define PG8_SB(b, h) ((4 + (b) * 2 + (h)) * HTB)
#define PG8_STAGE(bufoff, gbase, voff) do { _Pragma("unroll") for (int _i = 0; _i < 2; ++_i) \
        __builtin_amdgcn_global_load_lds((const unsigned*)((const char*)(gbase) + (voff)[_i]), (LAS unsigned*)(lds + (bufoff) + ldsw + _i * 8192), 16, 0, 0); } while (0)
#define PG8_LDA(dst, b, h) do { _Pragma("unroll") for (int m = 0; m < 4; ++m) _Pragma("unroll") for (int k = 0; k < 2; ++k) dst[m][k] = *(const LAS bf16x8*)(lds + PG8_SA(b, h) + aoff + m * 2048 + k * 1024); } while (0)
#define PG8_LDB(dst, b, h) do { _Pragma("unroll") for (int n = 0; n < 2; ++n) _Pragma("unroll") for (int k = 0; k < 2; ++k) dst[n][k] = *(const LAS bf16x8*)(lds + PG8_SB(b, h) + boff + n * 2048 + k * 1024); } while (0)
#define PG8_MMA(ai, bj, At, Bt) do { __builtin_amdgcn_s_setprio(1); _Pragma("unroll") for (int m = 0; m < 4; ++m) _Pragma("unroll") for (int n = 0; n < 2; ++n) _Pragma("unroll") for (int k = 0; k < 2; ++k) \
        acc[ai][bj][m][n] = __builtin_amdgcn_mfma_f32_16x16x32_bf16(Bt[n][k], At[m][k], acc[ai][bj][m][n], 0, 0, 0); __builtin_amdgcn_s_setprio(0); } while (0)
#define PG8_WAIT_V(n) asm volatile("s_waitcnt vmcnt(" #n ")" ::: "memory")
#define PG8_WAIT_L(n) asm volatile("s_waitcnt lgkmcnt(" #n ")" ::: "memory")
#define PG8_BAR __builtin_amdgcn_s_barrier()
#define PG8_SCHED __builtin_amdgcn_sched_barrier(0)
    Unit cur, nxt; int ui = 0;
    if (!S.next(0, cur)) return;
    f32x4 acc[2][2][4][2];
#pragma unroll
    for (int a = 0; a < 2; ++a)
#pragma unroll
        for (int b = 0; b < 2; ++b)
#pragma unroll
            for (int m = 0; m < 4; ++m)
#pragma unroll
                for (int n = 0; n < 2; ++n) acc[a][b][m][n] = (f32x4){0.f, 0.f, 0.f, 0.f};
    bf16x8 At[4][2], B0[2][2], B1[2][2];
    const char* cA = (const char*)g.A + (size_t)cur.pm * tstepA; const char* cB = (const char*)g.Bt + (size_t)cur.pn * tstepB;
    PG8_STAGE(PG8_SB(0, 0), cB, voffB); PG8_STAGE(PG8_SB(0, 1), cB + hstepB, voffB); PG8_STAGE(PG8_SA(0, 0), cA, voffA); PG8_STAGE(PG8_SA(0, 1), cA + hstepA, voffA);
    if (wr == 1) PG8_BAR;
    PG8_WAIT_V(2); PG8_BAR;
    PG8_STAGE(PG8_SB(1, 0), cB + kstep, voffB); PG8_STAGE(PG8_SA(1, 0), cA + kstep, voffA); PG8_STAGE(PG8_SB(1, 1), cB + hstepB + kstep, voffB);
    PG8_WAIT_V(6); PG8_BAR;
    for (;;) {
        const bool has_next = S.next(ui + 1, nxt);
        const char* nA = has_next ? (const char*)g.A + (size_t)nxt.pm * tstepA : cA; const char* nB = has_next ? (const char*)g.Bt + (size_t)nxt.pn * tstepB : cB;
        for (int t = 0; t < nt; t += 2) {
            const bool last = (t == nt - 2);
            const char* a1 = cA + (size_t)(t + 1) * kstep;
            const char* a2 = last ? nA : cA + (size_t)(t + 2) * kstep; const char* b2 = last ? nB : cB + (size_t)(t + 2) * kstep;
            const char* a3 = a2 + kstep; const char* b3 = b2 + kstep;
            PG8_LDB(B0, 0, 0); PG8_LDB(B1, 0, 1); PG8_SCHED; PG8_LDA(At, 0, 0); PG8_STAGE(PG8_SA(1, 1), a1 + hstepA, voffA);
            PG8_WAIT_V(8); PG8_WAIT_L(0); PG8_BAR; PG8_MMA(0, 0, At, B0); PG8_MMA(0, 1, At, B1); PG8_BAR; PG8_SCHED;
            PG8_LDA(At, 0, 1); PG8_STAGE(PG8_SB(0, 0), b2, voffB); PG8_STAGE(PG8_SB(0, 1), b2 + hstepB, voffB); PG8_STAGE(PG8_SA(0, 0), a2, voffA);
            PG8_WAIT_V(8); PG8_WAIT_L(0); PG8_BAR; PG8_MMA(1, 0, At, B0); PG8_MMA(1, 1, At, B1); PG8_BAR; PG8_SCHED;
            PG8_LDB(B0, 1, 0); PG8_LDB(B1, 1, 1); PG8_SCHED; PG8_LDA(At, 1, 0); PG8_STAGE(PG8_SA(0, 1), a2 + hstepA, voffA);
            PG8_WAIT_V(8); PG8_WAIT_L(0); PG8_BAR; PG8_MMA(0, 0, At, B0); PG8_MMA(0, 1, At, B1); PG8_BAR; PG8_SCHED;
            PG8_LDA(At, 1, 1); PG8_STAGE(PG8_SB(1, 0), b3, voffB); PG8_STAGE(PG8_SB(1, 1), b3 + hstepB, voffB); PG8_STAGE(PG8_SA(1, 0), a3, voffA);
            PG8_WAIT_V(8); PG8_WAIT_L(0); PG8_BAR; PG8_MMA(1, 0, At, B0); PG8_MMA(1, 1, At, B1); PG8_BAR; PG8_SCHED;
        }
        if constexpr (ALIGN_EPI) { if (wr == 0) PG8_BAR; }
        E(acc, cur, wr, wc, fr, fq);
        if (!has_next) break;
#pragma unroll
        for (int a = 0; a < 2; ++a)
#pragma unroll
            for (int b = 0; b < 2; ++b)
#pragma unroll
                for (int m = 0; m < 4; ++m)
#pragma unroll
                    for (int n = 0; n < 2; ++n) acc[a][b][m][n] = (f32x4){0.f, 0.f, 0.f, 0.f};
        cur = nxt; cA = nA; cB = nB; ++ui;
        if constexpr (ALIGN_EPI) { if (wr == 1) PG8_BAR; }
    }
    PG8_WAIT_V(0);
    if constexpr (!ALIGN_EPI) { if (wr == 0) PG8_BAR; }
    PG8_BAR;
#undef PG8_SA
#undef PG8_SB
#undef PG8_STAGE
#undef PG8_LDA
#undef PG8_LDB
#undef PG8_MMA
#undef PG8_WAIT_V
#undef PG8_WAIT_L
#undef PG8_BAR
#undef PG8_SCHED
}
}
using pg8::Unit;
typedef const f32x4 (&AccRef)[2][2][4][2];

DI float dot4(f32x4 v) { return (v[0] * v[0] + v[1] * v[1]) + (v[2] * v[2] + v[3] * v[3]); }
DI u32x4 pack44(f32x4 a, f32x4 b) { u32x4 w; w.x = cvtpk(a[0], a[1]); w.y = cvtpk(a[2], a[3]); w.z = cvtpk(b[0], b[1]); w.w = cvtpk(b[2], b[3]); return w; }

struct EpiInproj {
    static constexpr bool PERM = true;
    bf16_t* O; const float* ssqx; float* ssqq; bf16_t* halo;
    DI void operator()(AccRef acc, const Unit& u, int wr, int wc, int fr, int fq) const {
        { int t_ = threadIdx.x; asm volatile("" : "+v"(t_)); fr = t_ & 15; fq = (t_ >> 4) & 3; }
        const int col0 = u.pn * 256 + wc * 32 + 8 * fq;
        float rr[2][4];
#pragma unroll
        for (int ai = 0; ai < 2; ++ai)
#pragma unroll
            for (int m = 0; m < 4; ++m) rr[ai][m] = ssqx[u.pm * 256 + ai * 128 + wr * 64 + m * 16 + fr];
#pragma unroll
        for (int ai = 0; ai < 2; ++ai)
#pragma unroll
            for (int m = 0; m < 4; ++m) {
                const int row = u.pm * 256 + ai * 128 + wr * 64 + m * 16 + fr;
                const float r = __builtin_amdgcn_rsqf(rr[ai][m] * (1.f / 1024.f) + EPS);
                float s = 0.f;
#pragma unroll
                for (int bj = 0; bj < 2; ++bj) { const f32x4 v0 = acc[ai][bj][m][0] * r, v1 = acc[ai][bj][m][1] * r; s += dot4(v0) + dot4(v1);
                    const u32x4 pk = pack44(v0, v1); *(u32x4*)(O + (size_t)row * NPROJ + col0 + bj * 128) = pk;
                    if (u.pn >= 2 && u.pn < 6 && (row & 63) >= 61) *(u32x4*)(halo + ((size_t)(row >> 6) * 3 + (row & 63) - 61) * 1024 + col0 + bj * 128 - C_XBC) = pk; }
                if (u.pn == 6) { s += __shfl_xor(s, 16); s += __shfl_xor(s, 32); if (fq == 0) unsafeAtomicAdd(ssqq + row, s); }
                asm volatile("" ::: "memory");
            }
    }
};
struct EpiQ {
    static constexpr bool PERM = false;
    bf16_t* Q; const float* ssqq; const float* rope;
    DI void operator()(AccRef acc, const Unit& u, int wr, int wc, int fr, int fq) const {
        { int t_ = threadIdx.x; asm volatile("" : "+v"(t_)); fr = t_ & 15; fq = (t_ >> 4) & 3; }
        float rr[2][4];
#pragma unroll
        for (int ai = 0; ai < 2; ++ai)
#pragma unroll
            for (int m = 0; m < 4; ++m) rr[ai][m] = ssqq[u.pm * 256 + ai * 128 + wr * 64 + m * 16 + fr];
#pragma unroll
        for (int ai = 0; ai < 2; ++ai)
#pragma unroll
            for (int m = 0; m < 4; ++m) {
                const int row = u.pm * 256 + ai * 128 + wr * 64 + m * 16 + fr;
                const float r = __builtin_amdgcn_rsqf(rr[ai][m] * (1.f / 256.f) + EPS);
                bf16_t* qr = Q + (size_t)row * QW + u.pn * 256 + wc * 32 + 4 * fq;
                if (u.pn < 4) {
#pragma unroll
                    for (int bj = 0; bj < 2; ++bj)
#pragma unroll
                        for (int n = 0; n < 2; ++n) { const f32x4 v = acc[ai][bj][m][n] * r; u32x2 w; w.x = cvtpk(v[0], v[1]); w.y = cvtpk(v[2], v[3]); *(u32x2*)(qr + bj * 128 + n * 16) = w; }
                } else {
                    const int pos = row < MP ? (row & 2047) : 1024 + ((row - MP) & 63);
                    const f32x4 cs = *(const f32x4*)(rope + pos * 32 + 4 * fq), sn = *(const f32x4*)(rope + pos * 32 + 16 + 4 * fq);
#pragma unroll
                    for (int bj = 0; bj < 2; ++bj) { const f32x4 x1 = acc[ai][bj][m][0] * r, x2 = acc[ai][bj][m][1] * r; const f32x4 o1 = x1 * cs - x2 * sn, o2 = x1 * sn + x2 * cs;
                        u32x2 w; w.x = cvtpk(o1[0], o1[1]); w.y = cvtpk(o1[2], o1[3]); *(u32x2*)(qr + bj * 128) = w; w.x = cvtpk(o2[0], o2[1]); w.y = cvtpk(o2[2], o2[3]); *(u32x2*)(qr + bj * 128 + 16) = w; }
                }
                asm volatile("" ::: "memory");
            }
    }
};
struct EpiRes {
    static constexpr bool PERM = true;
    bf16_t* XB; const float* ssq_scale; float* ssq_next;
    DI void operator()(AccRef acc, const Unit& u, int wr, int wc, int fr, int fq) const {
        { int t_ = threadIdx.x; asm volatile("" : "+v"(t_)); fr = t_ & 15; fq = (t_ >> 4) & 3; }
        const int col0 = u.pn * 256 + wc * 32 + 8 * fq;
        float rr[2][4];
#pragma unroll
        for (int ai = 0; ai < 2; ++ai)
#pragma unroll
            for (int m = 0; m < 4; ++m) rr[ai][m] = ssq_scale ? ssq_scale[u.pm * 256 + ai * 128 + wr * 64 + m * 16 + fr] : 0.f;
#pragma unroll
        for (int ai = 0; ai < 2; ++ai) {
            u32x4 bw[4][2];
#pragma unroll
            for (int m = 0; m < 4; ++m)
#pragma unroll
                for (int bj = 0; bj < 2; ++bj) bw[m][bj] = *(const u32x4*)(XB + (size_t)(u.pm * 256 + ai * 128 + wr * 64 + m * 16 + fr) * DM + col0 + bj * 128);
#pragma unroll
            for (int m = 0; m < 4; ++m) {
                const int row = u.pm * 256 + ai * 128 + wr * 64 + m * 16 + fr;
                const float rs = ssq_scale ? __builtin_amdgcn_rsqf(rr[ai][m] * (1.f / 512.f) + EPS) : 1.f;
                float s = 0.f;
#pragma unroll
                for (int bj = 0; bj < 2; ++bj) { bf16_t* xp = XB + (size_t)row * DM + col0 + bj * 128;
                    const u32x4 w4 = bw[m][bj];
                    const f32x4 b0 = {bflo(w4.x), bfhi(w4.x), bflo(w4.y), bfhi(w4.y)}, b1 = {bflo(w4.z), bfhi(w4.z), bflo(w4.w), bfhi(w4.w)};
                    const f32x4 v0 = b0 + acc[ai][bj][m][0] * rs, v1 = b1 + acc[ai][bj][m][1] * rs; s += dot4(v0) + dot4(v1);
                    *(u32x4*)xp = pack44(v0, v1); }
                s += __shfl_xor(s, 16); s += __shfl_xor(s, 32); if (fq == 0) unsafeAtomicAdd(ssq_next + row, s);
            }
            asm volatile("" ::: "memory");
        }
    }
};
struct EpiGU {
    static constexpr bool PERM = true;
    bf16_t* H; const float* ssq;
    DI void operator()(AccRef acc, const Unit& u, int wr, int wc, int fr, int fq) const {
        { int t_ = threadIdx.x; asm volatile("" : "+v"(t_)); fr = t_ & 15; fq = (t_ >> 4) & 3; }
        const int col0 = u.pn * 128 + wc * 32 + 8 * fq;
        float rr[2][4];
#pragma unroll
        for (int ai = 0; ai < 2; ++ai)
#pragma unroll
            for (int m = 0; m < 4; ++m) rr[ai][m] = ssq[u.pm * 256 + ai * 128 + wr * 64 + m * 16 + fr];
#pragma unroll
        for (int ai = 0; ai < 2; ++ai)
#pragma unroll
            for (int m = 0; m < 4; ++m) {
                const int row = u.pm * 256 + ai * 128 + wr * 64 + m * 16 + fr;
                const float r = __builtin_amdgcn_rsqf(rr[ai][m] * (1.f / 1024.f) + EPS);
                f32x4 h[2];
#pragma unroll
                for (int n = 0; n < 2; ++n) { const f32x4 gt = acc[ai][0][m][n] * r, up = acc[ai][1][m][n] * r;
#pragma unroll
                    for (int j = 0; j < 4; ++j) h[n][j] = gt[j] * sigmoidf_(gt[j]) * up[j]; }
                *(u32x4*)(H + (size_t)row * FF + col0) = pack44(h[0], h[1]);
                asm volatile("" ::: "memory");
            }
    }
};

struct Args { const float* in[25]; float* out; unsigned char* ws; int ph_lo, ph_hi; };
struct Frame {
    ldsp lds; int tid, lane, wave, G, bid;
    const float* const* in; float* out; unsigned char* ws;
    DI float* ssq(int i) const { return (float*)(ws + WS_SSQ) + (size_t)i * MT; }
    DI bf16_t* wt(int l, size_t off) const { return (bf16_t*)(ws + WS_W + (size_t)l * W_LAYER + off); }
};
enum { I_XP = 0, I_XS, I_CCKV, I_CKR, I_SSM, I_CONV, I_WIN, I_WUQ, I_WUK, I_WUV, I_WOUT, I_NMIX, I_QN, I_KVN, I_SSDN, I_CW, I_CB, I_DTB, I_ALOG, I_DSKIP, I_NFFN, I_WG, I_WU, I_WD, I_NFIN };

DI void transpose_item(const float* W, int Nsrc, int sc, const float* gain, float gscale, bf16_t* WT, int ldk, int n0, int k0, LAS float* scr, int lane) {
    float tv[32];
#pragma unroll
    for (int i = 0; i < 32; ++i) { const int kk = 2 * i + (lane >> 5); tv[i] = sc >= 0 ? W[(size_t)(k0 + kk) * Nsrc + sc] : 0.f; }
#pragma unroll
    for (int i = 0; i < 32; ++i) { const int kk = 2 * i + (lane >> 5); scr[kk * 33 + (lane & 31)] = tv[i] * (gain ? gain[k0 + kk] : 1.f) * gscale; }
    LDS_WAIT(); asm volatile("" ::: "memory");
    const int c = lane & 7;
#pragma unroll
    for (int j = 0; j < 4; ++j) { const int n = (lane >> 3) + 8 * j; const LAS float* s = scr + (8 * c) * 33 + n;
        u32x4 o; o.x = cvtpk(s[0 * 33], s[1 * 33]); o.y = cvtpk(s[2 * 33], s[3 * 33]); o.z = cvtpk(s[4 * 33], s[5 * 33]); o.w = cvtpk(s[6 * 33], s[7 * 33]);
        *(u32x4*)(WT + (size_t)(n0 + n) * ldk + k0 + 8 * c) = o; }
    LDS_WAIT(); asm volatile("" ::: "memory");
}
DI int src_col_in(int n) { return n < 1536 ? n : n < 1792 ? 1544 + (n - 1536) : n < 1920 ? 1800 + (n - 1792) : n < 1952 ? 1928 + (n - 1920) : n < 1960 ? 1536 + (n - 1952) : -1; }

DI void kv_write_tile(const Frame& F, bf16_t* Kdst, bf16_t* VTdst, int ldvt) {
    int tid = threadIdx.x; asm volatile("" : "+v"(tid)); ldsp T = F.lds;
#pragma unroll
    for (int rr = 0; rr < 3; ++rr) { const int i = tid + rr * 512; if (i < 1280) { const int row = i / 20, pc = i % 20;
        *(u32x4*)(Kdst + (size_t)row * 160 + 8 * pc) = *(const LAS u32x4*)(T + row * 336 + 16 * pc); } }
    const int d = tid >> 2, g = tid & 3;
    const LAS bf16_t* col = (const LAS bf16_t*)T + d;
    unsigned w[8];
#pragma unroll
    for (int hh = 0; hh < 2; ++hh)
#pragma unroll
        for (int a = 0; a < 2; ++a)
#pragma unroll
            for (int i2 = 0; i2 < 2; ++i2) { const int k0 = 16 * g + 8 * a + 4 * hh + 2 * i2;
                w[hh * 4 + a * 2 + i2] = (unsigned)col[(size_t)k0 * 168] | ((unsigned)col[(size_t)(k0 + 1) * 168] << 16); }
    bf16_t* vp = VTdst + (size_t)d * ldvt + 16 * g;
    *(u32x4*)vp = (u32x4){w[0], w[1], w[2], w[3]}; *(u32x4*)(vp + 8) = (u32x4){w[4], w[5], w[6], w[7]};
}

DI void p0_prologue(const Frame& F) {
    const int gw = F.bid * 8 + F.wave, NGW = F.G * 8, gt = F.bid * 512 + F.tid, NT = F.G * 512;
    { float* z = F.ssq(1); for (size_t i = gt; i < (size_t)(SQ_N - 1) * MT; i += NT) z[i] = 0.f; }
    for (int i = gt; i < 2048 * 16; i += NT) { const int pos = i >> 4, j = i & 15;
        const double inv = exp(-9.210340371976184 * (double)j / 16.0), ang = (double)pos * inv;
        const double kq = rint(ang * 0.15915494309189535), x = ang - kq * 6.283185307179586, x2 = x * x;
        double ts = x, sn = x, tc = 1.0, cs = 1.0;
        for (int n = 1; n <= 14; ++n) { tc *= -x2 / (double)((2 * n - 1) * (2 * n)); cs += tc; ts *= -x2 / (double)((2 * n) * (2 * n + 1)); sn += ts; }
        float* rt = (float*)(F.ws + WS_ROPE); rt[pos * 32 + j] = (float)cs; rt[pos * 32 + 16 + j] = (float)sn; }
    LAS float* scr = (LAS float*)(F.lds + F.wave * 16384);
    constexpr int I_IN = 16 * 64, I_GU = 16 * 176, I_DN = 44 * 32, I_OS = 16 * 32, I_QR = 4 * 8, I_L = I_IN + I_GU + I_DN + I_OS + I_QR;
    const int l31 = F.lane & 31;
    for (int it = gw; it < 2 * I_L; it += NGW) {
        const int l = it / I_L; int r = it % I_L;
        if (r < I_IN) { const int kb = r / 64, nb = r % 64; transpose_item(F.in[I_WIN] + (size_t)l * 1024 * 1960, 1960, src_col_in(nb * 32 + l31), F.in[I_NMIX] + l * 1024, 1.f, F.wt(l, WO_IN), 1024, nb * 32, kb * 64, scr, F.lane); continue; } r -= I_IN;
        if (r < I_GU) { const int kb = r / 176, nb = r % 176, n0 = nb * 32, j = n0 >> 8, rr = n0 & 255;
            transpose_item(F.in[rr < 128 ? I_WG : I_WU] + (size_t)l * 1024 * FF, FF, 128 * j + (rr & 127) + l31, F.in[I_NFFN] + l * 1024, 1.f, F.wt(l, WO_GU), 1024, n0, kb * 64, scr, F.lane); continue; } r -= I_GU;
        if (r < I_DN) { const int kb = r / 32, nb = r % 32; transpose_item(F.in[I_WD] + (size_t)l * FF * 1024, 1024, nb * 32 + l31, nullptr, 1.f, F.wt(l, WO_DN), FF, nb * 32, kb * 64, scr, F.lane); continue; } r -= I_DN;
        if (r < I_OS) { const int kb = r / 32, nb = r % 32; transpose_item(F.in[I_WOUT] + (size_t)l * 1024 * 1024, 1024, nb * 32 + l31, kb < 8 ? F.in[I_SSDN] + l * 512 : nullptr, 1.f, F.wt(l, WO_OUT), AOW, nb * 32, kb * 64, scr, F.lane); continue; } r -= I_OS;
        { const int kb = r / 8, h = r % 8; transpose_item(F.in[I_WUQ] + (size_t)l * 256 * 768, 768, h * 96 + 64 + l31, F.in[I_QN] + l * 256, QSCALE, F.wt(l, WO_Q), 256, 1024 + h * 32, kb * 64, scr, F.lane); }
    }
    for (int idx = gt; idx < 2 * 1024 * 256; idx += NT) { const int k = idx & 255, n = (idx >> 8) & 1023, l = idx >> 18, h = n >> 7, lq = n & 127;
        const float* uq = F.in[I_WUQ] + (size_t)l * 256 * 768 + (size_t)k * 768 + h * 96; const float* uk = F.in[I_WUK] + (size_t)l * 128 * 512 + lq * 512 + h * 64;
        float s = 0.f;
#pragma unroll
        for (int d4 = 0; d4 < 16; ++d4) { const f32x4 a = ((const f32x4*)uq)[d4], bq = ((const f32x4*)uk)[d4]; s += (a[0] * bq[0] + a[1] * bq[1]) + (a[2] * bq[2] + a[3] * bq[3]); }
        F.wt(l, WO_Q)[(size_t)n * 256 + k] = f2bf(s * F.in[I_QN][l * 256 + k] * QSCALE); }
    for (int idx = gt; idx < 2 * 8 * 64 * 128; idx += NT) { const int pos = idx & 127, dv = (idx >> 7) & 63, h = (idx >> 13) & 7, l = idx >> 16;
        const int G = pos >> 4, hh = (pos >> 3) & 1, a = (pos >> 2) & 1, i = pos & 3, d = 16 * G + 8 * a + 4 * hh + i;
        F.wt(l, WO_UV)[(size_t)(h * 64 + dv) * 128 + pos] = f2bf(F.in[I_WUV][(size_t)l * 128 * 512 + (size_t)d * 512 + h * 64 + dv]); }
    { float* sq = F.ssq(SQ_X0); bf16_t* XB = (bf16_t*)(F.ws + WS_XB);
      for (int row4 = gw * 4; row4 < MT; row4 += NGW * 4) {
        f32x4 v[4][4];
#pragma unroll
        for (int q = 0; q < 4; ++q) { const int row = row4 + q; const float* xr = row < MP ? F.in[I_XP] + (size_t)row * DM : F.in[I_XS] + (size_t)(row - MP) * DM;
#pragma unroll
            for (int j = 0; j < 4; ++j) v[q][j] = ((const f32x4*)xr)[F.lane + 64 * j]; }
#pragma unroll
        for (int q = 0; q < 4; ++q) { const int row = row4 + q; float s = 0.f;
#pragma unroll
            for (int j = 0; j < 4; ++j) { s += dot4(v[q][j]); u32x2 w; w.x = cvtpk(v[q][j][0], v[q][j][1]); w.y = cvtpk(v[q][j][2], v[q][j][3]); ((u32x2*)(XB + (size_t)row * DM))[F.lane + 64 * j] = w; }
            s = wave_sum(s);
            if (F.lane == 0) sq[row] = s; } } }
    __syncthreads();
    for (int u = F.bid; u < 2 * 32 * 16; u += F.G) { const int l = u >> 9, b = (u >> 4) & 31, pb = u & 15;
        const int pos = F.tid >> 3, part = F.tid & 7; const size_t tok = ((size_t)(l * 32 + b) * 1024 + pb * 64 + pos);
        const f32x4* cs = (const f32x4*)(F.in[I_CCKV] + tok * 128 + part * 16); float v[16];
#pragma unroll
        for (int j = 0; j < 4; ++j) { const f32x4 t = cs[j]; v[4 * j] = t[0]; v[4 * j + 1] = t[1]; v[4 * j + 2] = t[2]; v[4 * j + 3] = t[3]; }
        lds_w16(F.lds + pos * 336 + part * 32, pack8(v)); lds_w16(F.lds + pos * 336 + part * 32 + 16, pack8(v + 8));
        const f32x4 kr = *(const f32x4*)(F.in[I_CKR] + tok * 32 + part * 4); u32x2 w; w.x = cvtpk(kr[0], kr[1]); w.y = cvtpk(kr[2], kr[3]);
        *(LAS u32x2*)(F.lds + pos * 336 + 256 + part * 8) = w;
        __syncthreads();
        kv_write_tile(F, (bf16_t*)(F.ws + WS_KS + l * KS_LAYER) + ((size_t)b * TKS + pb * 64) * 160, (bf16_t*)(F.ws + WS_VTS + l * VTS_LAYER) + (size_t)b * 128 * TKS + pb * 64, TKS);
        __syncthreads();
    }
}

DI void kvprep_unit(const Frame& F, int l, int u) {
    const bool smp = u >= 1024; const int b = smp ? u - 1024 : u >> 5, c = smp ? 0 : u & 31, T = smp ? 64 : 2048;
    const size_t row0 = smp ? (size_t)MP + b * 64 : (size_t)b * 2048 + c * 64;
    const bf16_t* PROJ = (const bf16_t*)(F.ws + WS_PROJ);
    int tid_ = threadIdx.x; asm volatile("" : "+v"(tid_));
    const int tk = tid_ >> 3, part = tid_ & 7, t = c * 64 + tk, pos = smp ? 1024 + t : t;
    const bf16_t* pr = PROJ + (row0 + tk) * NPROJ;
    float v[16]; { const u32x4 a = *(const u32x4*)(pr + C_CKV + part * 16), bb = *(const u32x4*)(pr + C_CKV + part * 16 + 8); unpack8(a, v); unpack8(bb, v + 8); }
    float s = 0.f;
#pragma unroll
    for (int i = 0; i < 16; ++i) s += v[i] * v[i];
    s += __shfl_xor(s, 1); s += __shfl_xor(s, 2); s += __shfl_xor(s, 4);
    const float rs = rsqrtf(s * (1.f / 128.f) + EPS); const float* gk = F.in[I_KVN] + l * 128 + part * 16;
#pragma unroll
    for (int i = 0; i < 16; ++i) v[i] = v[i] * rs * gk[i];
    float* ock = F.out + (smp ? O_CKVS + ((size_t)(l * 32 + b) * 64 + t) * 128 : O_CKVP + ((size_t)(l * 32 + b) * 2048 + t) * 128) + part * 16;
#pragma unroll
    for (int j = 0; j < 4; ++j) ((f32x4*)ock)[j] = (f32x4){v[4 * j], v[4 * j + 1], v[4 * j + 2], v[4 * j + 3]};
    lds_w16(F.lds + tk * 336 + part * 32, pack8(v)); lds_w16(F.lds + tk * 336 + part * 32 + 16, pack8(v + 8));
    { const unsigned w1 = *(const unsigned*)(pr + C_KR + 2 * part), w2 = *(const unsigned*)(pr + C_KR + 16 + 2 * part);
      const float* rt = (const float*)(F.ws + WS_ROPE) + pos * 32 + 2 * part;
      const float x1a = bflo(w1), x1b = bfhi(w1), x2a = bflo(w2), x2b = bfhi(w2), ca = rt[0], cb = rt[1], sa = rt[16], sb = rt[17];
      const float o1a = x1a * ca - x2a * sa, o1b = x1b * cb - x2b * sb, o2a = x1a * sa + x2a * ca, o2b = x1b * sb + x2b * cb;
      float* okr = F.out + (smp ? O_KRS + ((size_t)(l * 32 + b) * 64 + t) * 32 : O_KRP + ((size_t)(l * 32 + b) * 2048 + t) * 32);
      *(f32x2_t*)(okr + 2 * part) = (f32x2_t){o1a, o1b}; *(f32x2_t*)(okr + 16 + 2 * part) = (f32x2_t){o2a, o2b};
      *(LAS unsigned*)(F.lds + tk * 336 + 256 + 4 * part) = cvtpk(o1a, o1b); *(LAS unsigned*)(F.lds + tk * 336 + 256 + 32 + 4 * part) = cvtpk(o2a, o2b); }
    __syncthreads();
    if (smp) kv_write_tile(F, (bf16_t*)(F.ws + WS_KS + l * KS_LAYER) + ((size_t)b * TKS + 1024) * 160, (bf16_t*)(F.ws + WS_VTS + l * VTS_LAYER) + (size_t)b * 128 * TKS + 1024, TKS);
    else kv_write_tile(F, (bf16_t*)(F.ws + WS_KP) + ((size_t)b * TKP + c * 64) * 160, (bf16_t*)(F.ws + WS_VTP) + (size_t)b * 128 * TKP + c * 64, TKP);
    __syncthreads();
}

DI void conv_unit(const Frame& F, int l, int u) {
    int tid_ = threadIdx.x; asm volatile("" : "+v"(tid_));
    const int cg = tid_ & 127, rs = tid_ >> 7, ch = 8 * cg;
    const bool smp = u >= 1024; const int b = smp ? u - 1024 : u >> 5, c = smp ? 0 : u & 31;
    bf16_t* PROJ = (bf16_t*)(F.ws + WS_PROJ); const bf16_t* HALO = (const bf16_t*)(F.ws + WS_HALO);
    const size_t row0 = (size_t)u * 64;
    const int tk = tid_ >> 3, part = tid_ & 7, t = c * 64 + tk, pos = smp ? 1024 + t : t;
    const bf16_t* pr = PROJ + (row0 + tk) * NPROJ;
    const u32x4 kva = *(const u32x4*)(pr + C_CKV + part * 16), kvb = *(const u32x4*)(pr + C_CKV + part * 16 + 8);
    const unsigned kw1 = *(const unsigned*)(pr + C_KR + 2 * part), kw2 = *(const unsigned*)(pr + C_KR + 16 + 2 * part);
    u32x4 uu[19];
#pragma unroll
    for (int i = 0; i < 19; ++i) { const int lr = 16 * rs - 3 + i;
        if (lr >= 0) uu[i] = *(const u32x4*)(PROJ + (row0 + lr) * NPROJ + C_XBC + ch);
        else if (c != 0) uu[i] = *(const u32x4*)(HALO + ((size_t)(u - 1) * 3 + (lr + 3)) * 1024 + ch);
        else if (!smp) uu[i] = (u32x4){0u, 0u, 0u, 0u};
        else { const float* sc = F.in[I_CONV] + ((size_t)(l * 32 + b) * 3 + (lr + 3)) * 1024 + ch; float t8[8];
#pragma unroll
            for (int e = 0; e < 8; ++e) t8[e] = sc[e];
            uu[i] = pack8(t8); } }
    if (smp || c == 31) { if (tid_ < 384) { const int k = tid_ >> 7; float t8[8]; unpack8(*(const u32x4*)(HALO + ((size_t)u * 3 + k) * 1024 + ch), t8);
        float* oc = F.out + (smp ? O_CONVS : O_CONVP) + ((size_t)(l * 32 + b) * 3 + k) * 1024 + ch;
        *(f32x4*)oc = (f32x4){t8[0], t8[1], t8[2], t8[3]}; *(f32x4*)(oc + 4) = (f32x4){t8[4], t8[5], t8[6], t8[7]}; } }
    asm volatile("s_waitcnt vmcnt(0)" ::: "memory"); __syncthreads();
    { float v[16]; unpack8(kva, v); unpack8(kvb, v + 8);
      float s = 0.f;
#pragma unroll
      for (int i = 0; i < 16; ++i) s += v[i] * v[i];
      s += __shfl_xor(s, 1); s += __shfl_xor(s, 2); s += __shfl_xor(s, 4);
      const float rsn = rsqrtf(s * (1.f / 128.f) + EPS); const float* gk = F.in[I_KVN] + l * 128 + part * 16;
#pragma unroll
      for (int i = 0; i < 16; ++i) v[i] = v[i] * rsn * gk[i];
      float* ock = F.out + (smp ? O_CKVS + ((size_t)(l * 32 + b) * 64 + t) * 128 : O_CKVP + ((size_t)(l * 32 + b) * 2048 + t) * 128) + part * 16;
#pragma unroll
      for (int j = 0; j < 4; ++j) ((f32x4*)ock)[j] = (f32x4){v[4 * j], v[4 * j + 1], v[4 * j + 2], v[4 * j + 3]};
      lds_w16(F.lds + tk * 336 + part * 32, pack8(v)); lds_w16(F.lds + tk * 336 + part * 32 + 16, pack8(v + 8));
      const float* rt = (const float*)(F.ws + WS_ROPE) + pos * 32 + 2 * part;
      const float x1a = bflo(kw1), x1b = bfhi(kw1), x2a = bflo(kw2), x2b = bfhi(kw2), ca = rt[0], cb2 = rt[1], sa = rt[16], sb = rt[17];
      const float o1a = x1a * ca - x2a * sa, o1b = x1b * cb2 - x2b * sb, o2a = x1a * sa + x2a * ca, o2b = x1b * sb + x2b * cb2;
      float* okr = F.out + (smp ? O_KRS + ((size_t)(l * 32 + b) * 64 + t) * 32 : O_KRP + ((size_t)(l * 32 + b) * 2048 + t) * 32);
      *(f32x2_t*)(okr + 2 * part) = (f32x2_t){o1a, o1b}; *(f32x2_t*)(okr + 16 + 2 * part) = (f32x2_t){o2a, o2b};
      *(LAS unsigned*)(F.lds + tk * 336 + 256 + 4 * part) = cvtpk(o1a, o1b); *(LAS unsigned*)(F.lds + tk * 336 + 256 + 32 + 4 * part) = cvtpk(o2a, o2b); }
    const float* cw = F.in[I_CW] + (size_t)l * 4 * 1024 + ch; const float* cb = F.in[I_CB] + l * 1024 + ch;
#pragma unroll
    for (int half = 0; half < 2; ++half) {
        unsigned rowpk[8][4];
#pragma unroll
        for (int e2 = 0; e2 < 4; ++e2) {
            float oo[2][8];
#pragma unroll
            for (int q = 0; q < 2; ++q) { const int e = 2 * e2 + q; const float w0 = cw[e], w1 = cw[1024 + e], w2 = cw[2048 + e], w3 = cw[3072 + e], bs = cb[e];
#pragma unroll
                for (int i = 0; i < 8; ++i) { const int ii = 8 * half + i;
                    const float a0 = q ? bfhi(uu[ii][e2]) : bflo(uu[ii][e2]), a1 = q ? bfhi(uu[ii + 1][e2]) : bflo(uu[ii + 1][e2]), a2 = q ? bfhi(uu[ii + 2][e2]) : bflo(uu[ii + 2][e2]), a3 = q ? bfhi(uu[ii + 3][e2]) : bflo(uu[ii + 3][e2]);
                    const float v = bs + w0 * a0 + w1 * a1 + w2 * a2 + w3 * a3; oo[q][i] = v * sigmoidf_(v); } }
#pragma unroll
            for (int i = 0; i < 8; ++i) rowpk[i][e2] = cvtpk(oo[0][i], oo[1][i]);
        }
#pragma unroll
        for (int i = 0; i < 8; ++i) *(u32x4*)(PROJ + (row0 + 16 * rs + 8 * half + i) * NPROJ + C_XBC + ch) = (u32x4){rowpk[i][0], rowpk[i][1], rowpk[i][2], rowpk[i][3]};
        if (half == 0) {
            __syncthreads();
            if (smp) kv_write_tile(F, (bf16_t*)(F.ws + WS_KS + l * KS_LAYER) + ((size_t)b * TKS + 1024) * 160, (bf16_t*)(F.ws + WS_VTS + l * VTS_LAYER) + (size_t)b * 128 * TKS + 1024, TKS);
            else kv_write_tile(F, (bf16_t*)(F.ws + WS_KP) + ((size_t)b * TKP + c * 64) * 160, (bf16_t*)(F.ws + WS_VTP) + (size_t)b * 128 * TKP + c * 64, TKP);
        }
    }
    asm volatile("s_waitcnt vmcnt(0)" ::: "memory"); __syncthreads();
}

DI void ssd_unit(const Frame& F, int l, int kind, int b, int hd, bool do_ssq = true) {
    int tid_ = threadIdx.x; asm volatile("" : "+v"(tid_));
    const int tid = tid_, lane = tid & 63, w = F.wave, r = lane & 31, hi = lane >> 5, g = hd >> 2;
    const int nch = kind == 0 ? 32 : 1;
    const size_t rowbase = kind == 0 ? (size_t)b * 2048 : (size_t)MP + b * 64;
    const bf16_t* PROJ = (const bf16_t*)(F.ws + WS_PROJ); bf16_t* AO = (bf16_t*)(F.ws + WS_AO);
    ldsp L = F.lds;
    constexpr int O_CS = 0, O_BS = 17408, O_BWT = 34816, O_XT = 53248, O_XS = 62464, O_WS = 71680, O_HS = 80896, O_YS = 98304, O_DT = 115712, O_CUM = 116224, O_XS2 = 116736;
    LAS float* dtS = (LAS float*)(L + O_DT); LAS float* cumS = (LAS float*)(L + O_CUM); LAS float* Ys = (LAS float*)(L + O_YS);
    const float Dsk = F.in[I_DSKIP][l * 8 + hd], dtb = F.in[I_DTB][l * 8 + hd], Aneg = -__expf(F.in[I_ALOG][l * 8 + hd]);
    const int pbh = w >> 2, nbh = w & 3;
    f32x16 hacc;
    float* hout = F.out + (kind == 0 ? O_SSMP : O_SSMS) + (size_t)((l * 32 + b) * 8 + hd) * 8192;
    if (kind == 0) {
#pragma unroll
        for (int i = 0; i < 16; ++i) hacc[i] = 0.f;
    } else { const float* h0 = F.in[I_SSM] + (size_t)((l * 32 + b) * 8 + hd) * 8192;
#pragma unroll
        for (int i = 0; i < 16; ++i) hacc[i] = h0[(32 * pbh + crow(i, hi)) * 128 + 32 * nbh + r]; }
#pragma unroll
    for (int i = 0; i < 16; ++i) *(LAS bf16_t*)(L + O_HS + (32 * pbh + crow(i, hi)) * 272 + (32 * nbh + r) * 2) = f2bf(hacc[i]);
    const int lbA = (w & 3) >> 1, sbA = w & 1;
    u32x4 uu[8]; float dtr_n = 0.f;
#define SSD_LOAD_UU(cc) do { const size_t row0_ = rowbase + 64 * (cc); const int cgl = tid >> 3, rsl = tid & 7; \
        const int chl = cgl < 8 ? hd * 64 + 8 * cgl : cgl < 24 ? 512 + g * 128 + 8 * (cgl - 8) : 768 + g * 128 + 8 * (cgl - 24); \
        if (tid < 320) { _Pragma("unroll") for (int i = 0; i < 8; ++i) uu[i] = *(const u32x4*)(PROJ + (row0_ + 8 * rsl + i) * NPROJ + C_XBC + chl); } } while (0)
#define SSD_SCAN(cc) do { const float dtr = dtr_n + dtb; const float dt = dtr > 20.f ? dtr : log1pf(__expf(dtr)); float a = dt * Aneg; \
        _Pragma("unroll") for (int off = 1; off < 64; off <<= 1) { const float t = __shfl_up(a, off); if (lane >= off) a += t; } \
        dtS[((cc) & 1) * 64 + lane] = dt; cumS[((cc) & 1) * 64 + lane] = a; } while (0)
#define SSD_EPI(row0e, xsoff) do { const int el = tid >> 3, pg = tid & 7; const size_t row = (row0e) + el; \
        const f32x4 y0 = *(const LAS f32x4*)(Ys + el * 68 + 8 * pg), y1 = *(const LAS f32x4*)(Ys + el * 68 + 8 * pg + 4); \
        float xv[8], zv[8], ov[8]; \
        unpack8(*(const LAS u32x4*)(L + (xsoff) + el * 144 + pg * 16), xv); unpack8(zk, zv); \
        float s = 0.f; \
        _Pragma("unroll") for (int e = 0; e < 8; ++e) { const float y = (e < 4 ? y0[e & 3] : y1[e & 3]) + Dsk * xv[e]; ov[e] = y * zv[e] * sigmoidf_(zv[e]); s += ov[e] * ov[e]; } \
        *(u32x4*)(AO + row * AOW + hd * 64 + 8 * pg) = pack8(ov); \
        s += __shfl_xor(s, 1); s += __shfl_xor(s, 2); s += __shfl_xor(s, 4); \
        if (pg == 0 && do_ssq) unsafeAtomicAdd(F.ssq(SQ_SSD0 + l) + row, s); } while (0)
    SSD_LOAD_UU(0);
    if (w == 7) { dtr_n = bf2f(PROJ[(rowbase + lane) * NPROJ + C_DT + hd]); SSD_SCAN(0); if (nch > 1) dtr_n = bf2f(PROJ[(rowbase + 64 + lane) * NPROJ + C_DT + hd]); }
    u32x4 zk = (u32x4){0u, 0u, 0u, 0u};
    __syncthreads();
    for (int c = 0; c < nch; ++c) {
        const size_t row0 = rowbase + 64 * c;
        int tl_ = threadIdx.x; asm volatile("" : "+v"(tl_));
        const int tid = tl_, lane = tid & 63, r = lane & 31, hi = lane >> 5;
        const int cg_ = tid >> 3, rs_ = tid & 7;
        const LAS float* dtC = dtS + (c & 1) * 64; const LAS float* cumC = cumS + (c & 1) * 64;
        const int xsC = (c & 1) ? O_XS2 : O_XS;
        if (c > 0) {
#pragma unroll
            for (int i = 0; i < 16; ++i) *(LAS bf16_t*)(L + O_HS + (32 * pbh + crow(i, hi)) * 272 + (32 * nbh + r) * 2) = f2bf(hacc[i]);
            SSD_EPI(row0 - 64, (c & 1) ? O_XS : O_XS2);
        }
        zk = *(const u32x4*)(PROJ + (row0 + (tid >> 3)) * NPROJ + C_Z + hd * 64 + 8 * (tid & 7));
        if (w == 7 && c + 1 < nch) { SSD_SCAN(c + 1); if (c + 2 < nch) dtr_n = bf2f(PROJ[(row0 + 128 + lane) * NPROJ + C_DT + hd]); }
        if (tid < 320) {
            const int l0 = 8 * rs_;
            const bool isB = cg_ >= 8 && cg_ < 24;
            float we[8];
            { const float last = cumC[63];
#pragma unroll
              for (int i = 0; i < 8; ++i) we[i] = isB ? __expf(last - cumC[l0 + i]) * dtC[l0 + i] : 1.f; }
            const ldsp tdst = cg_ < 8 ? L + O_XT + (8 * cg_) * 144 + l0 * 2 : L + O_BWT + (8 * (cg_ - 8)) * 144 + l0 * 2;
            const ldsp rdst = cg_ < 8 ? L + xsC + l0 * 144 + cg_ * 16 : isB ? L + O_BS + l0 * 272 + (cg_ - 8) * 16 : L + O_CS + l0 * 272 + (cg_ - 24) * 16;
            const int rstride = cg_ < 8 ? 144 : 272;
#pragma unroll
            for (int i = 0; i < 8; ++i) lds_w16(rdst + i * rstride, uu[i]);
            if (cg_ < 24) {
#pragma unroll
                for (int e2 = 0; e2 < 4; ++e2)
#pragma unroll
                    for (int q = 0; q < 2; ++q) { float t8[8];
#pragma unroll
                        for (int i = 0; i < 8; ++i) t8[i] = (q ? bfhi(uu[i][e2]) : bflo(uu[i][e2])) * we[i];
                        lds_w16(tdst + (2 * e2 + q) * 144, pack8(t8)); }
            }
        }
        if (c + 1 < nch) SSD_LOAD_UU(c + 1);
        __syncthreads();
        f32x16 accy;
#pragma unroll
        for (int i = 0; i < 16; ++i) accy[i] = 0.f;
        if (w < 4) {
            if (sbA <= lbA) {
#pragma unroll
                for (int ks = 0; ks < 8; ++ks) { const bf16x8 a = lds_r16(L + O_CS + (32 * lbA + r) * 272 + (16 * ks + 8 * hi) * 2), bb = lds_r16(L + O_BS + (32 * sbA + r) * 272 + (16 * ks + 8 * hi) * 2); accy = MFMA32(a, bb, accy); }
            }
            const int s = 32 * sbA + r; const float cs = cumC[s], ds = dtC[s];
#pragma unroll
            for (int i = 0; i < 16; ++i) { const int ll = 32 * lbA + crow(i, hi); const float val = s <= ll ? __expf(cumC[ll] - cs) * accy[i] * ds : 0.f;
                *(LAS bf16_t*)(L + O_WS + ll * 144 + s * 2) = f2bf(val); }
        } else {
#pragma unroll
            for (int ks = 0; ks < 8; ++ks) { const bf16x8 a = lds_r16(L + O_CS + (32 * lbA + r) * 272 + (16 * ks + 8 * hi) * 2), bb = lds_r16(L + O_HS + (32 * sbA + r) * 272 + (16 * ks + 8 * hi) * 2); accy = MFMA32(a, bb, accy); }
#pragma unroll
            for (int i = 0; i < 16; ++i) accy[i] *= __expf(cumC[32 * lbA + crow(i, hi)]);
        }
        __syncthreads();
        if (w >= 4) {
#pragma unroll
            for (int ks = 0; ks < 4; ++ks) { const bf16x8 a = lds_r16(L + O_WS + (32 * lbA + r) * 144 + (16 * ks + 8 * hi) * 2), bb = lds_r16(L + O_XT + (32 * sbA + r) * 144 + (16 * ks + 8 * hi) * 2); accy = MFMA32(a, bb, accy); }
#pragma unroll
            for (int i = 0; i < 16; ++i) Ys[(32 * lbA + crow(i, hi)) * 68 + 32 * sbA + r] = accy[i];
        }
        { const float el = __expf(cumC[63]);
#pragma unroll
          for (int i = 0; i < 16; ++i) hacc[i] *= el;
#pragma unroll
          for (int ks = 0; ks < 4; ++ks) { const bf16x8 a = lds_r16(L + O_XT + (32 * pbh + r) * 144 + (16 * ks + 8 * hi) * 2), bb = lds_r16(L + O_BWT + (32 * nbh + r) * 144 + (16 * ks + 8 * hi) * 2); hacc = MFMA32(a, bb, hacc); } }
        __syncthreads();
    }
    SSD_EPI(rowbase + 64 * (nch - 1), ((nch - 1) & 1) ? O_XS2 : O_XS);
    __syncthreads();
#undef SSD_EPI
#undef SSD_LOAD_UU
#undef SSD_SCAN
#pragma unroll
    for (int i = 0; i < 16; ++i) hout[(32 * pbh + crow(i, hi)) * 128 + 32 * nbh + r] = hacc[i];
}

DI void attn_unit(const Frame& F, int l, int kind, int b, int c, int hf) {
    int tid_ = threadIdx.x; asm volatile("" : "+v"(tid_));
    const int tid = tid_, lane = tid & 63, w = F.wave, r = lane & 31, hi = lane >> 5;
    size_t rowq0; int nt, ldvt; const bf16_t* Kb; const bf16_t* VTb;
    if (kind == 0) { rowq0 = (size_t)b * 2048 + 64 * c + 32 * hf; nt = c + 1; ldvt = TKP; Kb = (const bf16_t*)(F.ws + WS_KP) + (size_t)b * TKP * 160; VTb = (const bf16_t*)(F.ws + WS_VTP) + (size_t)b * 128 * TKP; }
    else { rowq0 = (size_t)MP + b * 64 + 32 * hf; nt = 17; ldvt = TKS; Kb = (const bf16_t*)(F.ws + WS_KS + l * KS_LAYER) + (size_t)b * TKS * 160; VTb = (const bf16_t*)(F.ws + WS_VTS + l * VTS_LAYER) + (size_t)b * 128 * TKS; }
    ldsp L = F.lds;
    constexpr int KTB = 21504, VTB = 18432, O_K = 0, O_V = 3 * KTB;
    const bf16_t* qrow = (const bf16_t*)(F.ws + WS_Q) + (rowq0 + r) * QW;
    bf16x8 qf[10];
#pragma unroll
    for (int ks = 0; ks < 8; ++ks) qf[ks] = *(const bf16x8*)(qrow + w * 128 + 16 * ks + 8 * hi);
#pragma unroll
    for (int ks = 0; ks < 2; ++ks) qf[8 + ks] = *(const bf16x8*)(qrow + 1024 + w * 32 + 16 * ks + 8 * hi);
    unsigned goff[5];
#pragma unroll
    for (int i = 0; i < 5; ++i) { const int ci = w + 8 * i;
        if (ci < 21) { const int o = ci * 1024 + 16 * lane, row = o / 336; int cb = o % 336; if (cb >= 320) cb = 0; goff[i] = (unsigned)(row * 160 + (cb >> 1)); }
        else { const int o = (ci - 21) * 1024 + 16 * lane, d = o / 144; int cb = o % 144; if (cb >= 128) cb = 0; goff[i] = (unsigned)(d * ldvt + (cb >> 1)); } }
#define ATT_DMA(j, kbuf, vbuf) do { _Pragma("unroll") for (int i = 0; i < 5; ++i) { const int ci = w + 8 * i; \
        if (ci < 21) __builtin_amdgcn_global_load_lds((const unsigned*)(Kb + (size_t)(j) * 64 * 160 + goff[i]), (LAS unsigned*)(L + O_K + (kbuf) * KTB + ci * 1024), 16, 0, 0); \
        else if (ci < 39) __builtin_amdgcn_global_load_lds((const unsigned*)(VTb + (size_t)(j) * 64 + goff[i]), (LAS unsigned*)(L + O_V + (vbuf) * VTB + (ci - 21) * 1024), 16, 0, 0); } } while (0)
    ATT_DMA(0, 0, 0);
    if (nt > 1) ATT_DMA(1, 1, 1);
    f32x16 o[4];
#pragma unroll
    for (int d = 0; d < 4; ++d)
#pragma unroll
        for (int i = 0; i < 16; ++i) o[d][i] = 0.f;
    float mhat = 0.f, lsum = 0.f; f32x16 negm;
#pragma unroll
    for (int i = 0; i < 16; ++i) negm[i] = 0.f;
    f32x16 p0, p1; bf16x8 pb[4];
#define ATT_QK(kbuf) do { const ldsp kb_ = L + O_K + (kbuf) * KTB + r * 336 + 16 * hi; bf16x8 kf[6]; \
        _Pragma("unroll") for (int ks = 0; ks < 3; ++ks) { kf[2 * ks] = lds_r16(kb_ + 32 * ks); kf[2 * ks + 1] = lds_r16(kb_ + 32 * 336 + 32 * ks); } \
        __builtin_amdgcn_sched_barrier(0); \
        _Pragma("unroll") for (int ks = 0; ks < 10; ++ks) { const int sl = ks % 3; \
            if (ks == 0) { p0 = MFMA32(kf[0], qf[0], negm); p1 = MFMA32(kf[1], qf[0], negm); } \
            else { p0 = MFMA32(kf[2 * sl], qf[ks], p0); p1 = MFMA32(kf[2 * sl + 1], qf[ks], p1); } \
            if (ks + 3 < 10) { kf[2 * sl] = lds_r16(kb_ + 32 * (ks + 3)); kf[2 * sl + 1] = lds_r16(kb_ + 32 * 336 + 32 * (ks + 3)); } \
            __builtin_amdgcn_sched_barrier(0); } } while (0)
#define MX3(a, b, c) __builtin_fmaxf(__builtin_fmaxf((a), (b)), (c))
#define ATT_SM() do { float mx = MX3(p0[0], p0[1], p1[0]), mx2 = MX3(p1[1], p0[2], p1[2]); \
        _Pragma("unroll") for (int i = 3; i < 15; i += 2) { mx = MX3(mx, p0[i], p1[i]); mx2 = MX3(mx2, p0[i + 1], p1[i + 1]); } \
        mx = MX3(mx, mx2, p0[15]); mx = fmaxf(mx, p1[15]); \
        mx = fmaxf(mx, __shfl_xor(mx, 32)); \
          \
        if (__builtin_amdgcn_ballot_w64(mx > thr_) != 0ull) { const float dl = fmaxf(mx, flr_); mhat += dl; \
            _Pragma("unroll") for (int i = 0; i < 16; ++i) { p0[i] -= dl; p1[i] -= dl; } \
            _Pragma("unroll") for (int i = 0; i < 16; ++i) negm[i] = -mhat; \
            const float alpha = __builtin_amdgcn_exp2f(fminf(-dl, 60.f)); lsum *= alpha; \
            _Pragma("unroll") for (int d = 0; d < 4; ++d) _Pragma("unroll") for (int i = 0; i < 16; ++i) o[d][i] *= alpha; } \
        float ps = 0.f, ps2 = 0.f; \
        _Pragma("unroll") for (int i = 0; i < 16; ++i) { p0[i] = __builtin_amdgcn_exp2f(p0[i]); p1[i] = __builtin_amdgcn_exp2f(p1[i]); ps += p0[i]; ps2 += p1[i]; } \
        lsum += ps + ps2; \
        _Pragma("unroll") for (int kk = 0; kk < 2; ++kk) { u32x4 t; t.x = cvtpk(p0[8 * kk], p0[8 * kk + 1]); t.y = cvtpk(p0[8 * kk + 2], p0[8 * kk + 3]); t.z = cvtpk(p0[8 * kk + 4], p0[8 * kk + 5]); t.w = cvtpk(p0[8 * kk + 6], p0[8 * kk + 7]); pb[kk] = __builtin_bit_cast(bf16x8, t); \
            t.x = cvtpk(p1[8 * kk], p1[8 * kk + 1]); t.y = cvtpk(p1[8 * kk + 2], p1[8 * kk + 3]); t.z = cvtpk(p1[8 * kk + 4], p1[8 * kk + 5]); t.w = cvtpk(p1[8 * kk + 6], p1[8 * kk + 7]); pb[2 + kk] = __builtin_bit_cast(bf16x8, t); } } while (0)
#define ATT_PV(vbuf) do { const ldsp vb_ = L + O_V + (vbuf) * VTB + r * 144 + 16 * hi; bf16x8 vf[8]; \
        _Pragma("unroll") for (int q = 0; q < 2; ++q) _Pragma("unroll") for (int d = 0; d < 4; ++d) vf[4 * q + d] = lds_r16(vb_ + d * 32 * 144 + q * 32); \
        __builtin_amdgcn_sched_barrier(0); \
        _Pragma("unroll") for (int q = 0; q < 4; ++q) { _Pragma("unroll") for (int d = 0; d < 4; ++d) o[d] = MFMA32(vf[4 * (q & 1) + d], pb[q], o[d]); \
            if (q + 2 < 4) { _Pragma("unroll") for (int d = 0; d < 4; ++d) vf[4 * (q & 1) + d] = lds_r16(vb_ + d * 32 * 144 + (q + 2) * 32); } \
            __builtin_amdgcn_sched_barrier(0); } } while (0)
    asm volatile("s_waitcnt vmcnt(0)\n\ts_barrier" ::: "memory");
    int st = 0;
    for (int j = 0; j < nt; ++j) {
        const int st2 = st == 0 ? 2 : st - 1;
        if (j + 2 < nt) ATT_DMA(j + 2, st2, st2);
        int jz = j; asm volatile("" : "+s"(jz));
        const float thr_ = jz ? 8.f : -3e38f, flr_ = jz ? 0.f : -3e38f;
        ATT_QK(st); ATT_SM(); ATT_PV(st);
        if (j + 2 < nt) { if (w < 7) asm volatile("s_waitcnt vmcnt(5)\n\ts_barrier" ::: "memory"); else asm volatile("s_waitcnt vmcnt(4)\n\ts_barrier" ::: "memory"); }
        else asm volatile("s_waitcnt vmcnt(0)\n\ts_barrier" ::: "memory");
        st = st == 2 ? 0 : st + 1;
    }
#undef ATT_DMA
#undef ATT_QK
#undef ATT_SM
#undef MX3
#undef ATT_PV
    lsum += __shfl_xor(lsum, 32);
    const size_t row = rowq0 + r;
    const float inv = __builtin_amdgcn_rcpf(lsum);
    bf16x8 ob[8];
#pragma unroll
    for (int d = 0; d < 4; ++d)
#pragma unroll
        for (int kk = 0; kk < 2; ++kk) { u32x4 t; t.x = cvtpk(o[d][8 * kk] * inv, o[d][8 * kk + 1] * inv); t.y = cvtpk(o[d][8 * kk + 2] * inv, o[d][8 * kk + 3] * inv); t.z = cvtpk(o[d][8 * kk + 4] * inv, o[d][8 * kk + 5] * inv); t.w = cvtpk(o[d][8 * kk + 6] * inv, o[d][8 * kk + 7] * inv); ob[2 * d + kk] = __builtin_bit_cast(bf16x8, t); }
    const bf16_t* wuv = F.wt(l, WO_UV) + (size_t)(w * 64 + r) * 128 + 8 * hi;
    f32x16 D0, D1;
#pragma unroll
    for (int i = 0; i < 16; ++i) { D0[i] = 0.f; D1[i] = 0.f; }
#pragma unroll
    for (int s8 = 0; s8 < 8; ++s8) { const bf16x8 a0 = *(const bf16x8*)(wuv + 16 * s8), a1 = *(const bf16x8*)(wuv + 32 * 128 + 16 * s8); D0 = MFMA32(a0, ob[s8], D0); D1 = MFMA32(a1, ob[s8], D1); }
    const float fac = sqrtf(F.ssq(SQ_SSD0 + l)[row] * (1.f / 512.f) + EPS);
    bf16_t* orow = (bf16_t*)(F.ws + WS_AO) + row * AOW + 512 + w * 64 + 4 * hi;
#pragma unroll
    for (int q = 0; q < 4; ++q) { u32x2 t; t.x = cvtpk(D0[4 * q] * fac, D0[4 * q + 1] * fac); t.y = cvtpk(D0[4 * q + 2] * fac, D0[4 * q + 3] * fac); *(u32x2*)(orow + 8 * q) = t;
        t.x = cvtpk(D1[4 * q] * fac, D1[4 * q + 1] * fac); t.y = cvtpk(D1[4 * q + 2] * fac, D1[4 * q + 3] * fac); *(u32x2*)(orow + 32 + 8 * q) = t; }
}

#define XB_TMO      128
#define XB_XCNT(j)  (256  + 64 * (j))
#define XB_XSUB(j)  (1280 + 64 * (j))
#define XB_XGEN(j)  (2304 + 64 * (j))
#define XB_TOP      3328
#define XB_TOPGEN   3392
#define XCD_BAR_WORDS 3456
#define XB_SPIN_CAP (1u << 20)
DI unsigned xb_ld(unsigned* p)              { return __hip_atomic_load(p, __ATOMIC_RELAXED, __HIP_MEMORY_SCOPE_AGENT); }
DI unsigned xb_add(unsigned* p, unsigned v) { return __hip_atomic_fetch_add(p, v, __ATOMIC_RELAXED, __HIP_MEMORY_SCOPE_AGENT); }
DI unsigned xb_xcc_id() { return (unsigned)__builtin_amdgcn_s_getreg((3 << 11) | 20) & 0xFu; }
#define XB_SPIN(cond, bar) do { unsigned _sp = 0; while (cond) { __builtin_amdgcn_s_sleep(1); \
    if ((++_sp & 255u) == 0u) { if (xb_ld(&(bar)[XB_TMO])) break; if (_sp > XB_SPIN_CAP) { atomicAdd(&(bar)[XB_TMO], 1u); break; } } } } while (0)
struct XcdBarrier { unsigned* bar; unsigned x; volatile LAS unsigned* st; };
DI XcdBarrier xcd_barrier_post(unsigned* bar, volatile LAS unsigned* st) {
    XcdBarrier b; b.bar = bar; b.x = xb_xcc_id(); b.st = st;
    if (threadIdx.x == 0) (void)xb_add(&bar[XB_XCNT(b.x)], 1u);
    return b;
}
DI void xcd_barrier_complete(unsigned* bar, unsigned x, unsigned& nloc, unsigned& nx) {
    const unsigned G = gridDim.x * gridDim.y * gridDim.z;
    unsigned sum, cnt, mine, sp = 0u;
    for (;;) {
        sum = 0u; cnt = 0u; mine = 0u;
#pragma unroll
        for (unsigned j = 0; j < 16; ++j) { const unsigned c = xb_ld(&bar[XB_XCNT(j)]); sum += c; cnt += (c > 0u) ? 1u : 0u; mine = (j == x) ? c : mine; }
        if (sum == G) break;
        __builtin_amdgcn_s_sleep(1);
        if ((++sp & 255u) == 0u) { if (xb_ld(&bar[XB_TMO])) break; if (sp > XB_SPIN_CAP) { atomicAdd(&bar[XB_TMO], 1u); break; } }
    }
    nloc = mine > 0u ? mine : 1u; nx = cnt > 0u ? cnt : 1u;
}
DI void xcd_barrier(const XcdBarrier& b) {
    asm volatile("s_waitcnt vmcnt(0)" ::: "memory");
    __syncthreads();
    if (threadIdx.x == 0) {
        unsigned* bar = b.bar;
        __builtin_amdgcn_s_waitcnt(0);
        unsigned nloc = b.st[0], nx = b.st[1];
        if (nloc == 0u) { xcd_barrier_complete(bar, b.x, nloc, nx); b.st[0] = nloc; b.st[1] = nx; }
        const unsigned old = xb_add(&bar[XB_XSUB(b.x)], 1u);
        const unsigned gen = old / nloc;
        if (old + 1u == (gen + 1u) * nloc) {
            __builtin_amdgcn_fence(__ATOMIC_RELEASE, "agent");
            asm volatile("s_waitcnt vmcnt(0)" ::: "memory");
            const unsigned og = xb_add(&bar[XB_TOP], 1u);
            const unsigned tg = og / nx;
            if (og + 1u == (tg + 1u) * nx) xb_add(&bar[XB_TOPGEN], 1u);
            else XB_SPIN(xb_ld(&bar[XB_TOPGEN]) == tg, bar);
            __builtin_amdgcn_fence(__ATOMIC_ACQUIRE, "agent");
            xb_add(&bar[XB_XGEN(b.x)], 1u);
            asm volatile("s_waitcnt vmcnt(0)" ::: "memory");
        } else {
            XB_SPIN(xb_ld(&bar[XB_XGEN(b.x)]) == gen, bar);
            __builtin_amdgcn_fence(__ATOMIC_ACQUIRE, "agent");
            asm volatile("s_waitcnt vmcnt(0)" ::: "memory");
        }
    }
    __syncthreads();
}

__global__ void __launch_bounds__(512, 2) mk_fwd(Args args) {
    extern __shared__ __attribute__((aligned(16))) unsigned char lds_raw[];
    Frame F;
    F.lds = (ldsp)lds_raw; F.tid = threadIdx.x; F.lane = F.tid & 63; F.wave = __builtin_amdgcn_readfirstlane(F.tid >> 6); F.G = gridDim.x; F.bid = blockIdx.x;
    F.in = args.in; F.out = args.out; F.ws = args.ws;
    cg::grid_group grid = cg::this_grid();
    volatile LAS unsigned* MISC = (volatile LAS unsigned*)(F.lds + 131072 + 512);
    if (threadIdx.x < 4) MISC[threadIdx.x] = 0u;
    __syncthreads();
    XcdBarrier xbar = xcd_barrier_post((unsigned*)F.ws, MISC);
    const int lo = args.ph_lo, hi = args.ph_hi;
#define IN(k) (lo <= (k) && (k) < hi)
#define SEAM(k) do { if (IN(k) && IN((k) + 1)) { if (lo < 0) grid.sync(); else xcd_barrier(xbar); } } while (0)
    bf16_t* XB = (bf16_t*)(F.ws + WS_XB); bf16_t* AO = (bf16_t*)(F.ws + WS_AO); bf16_t* PROJ = (bf16_t*)(F.ws + WS_PROJ); bf16_t* Qb = (bf16_t*)(F.ws + WS_Q); bf16_t* Hb = (bf16_t*)(F.ws + WS_H);
    float* XR = F.out;

    if (IN(0)) { p0_prologue(F); }
    SEAM(0);
#ifdef PROBE_SYNC
    for (int i = 0; i < 20; ++i) grid.sync();
#endif
#ifdef PROBE_P0
    if (IN(0)) { p0_prologue(F); } grid.sync();
#endif
    for (int l = 0; l < 2; ++l) {
        const int p = 1 + 7 * l;
        { int t_ = threadIdx.x; asm volatile("" : "+v"(t_)); F.tid = t_; F.lane = t_ & 63; }
        if (IN(p)) {
            pg8::Gemm g{XB, F.wt(l, WO_IN), MT, NPROJ, DM, DM, DM}; pg8::StaticOrder S; S.init(MT, NPROJ, F.G, F.bid);
            EpiInproj E{PROJ, F.ssq(l == 0 ? SQ_X0 : SQ_X1), F.ssq(SQ_Q0 + l), (bf16_t*)(F.ws + WS_HALO)};
            pg8::gemm_phase<EpiInproj, true>(F.lds, g, S, E);
        }
        SEAM(p);
        if (IN(p + 1)) {
            for (int u = (F.bid + F.G / 2) % F.G; u < 1056; u += F.G) conv_unit(F, l, u);
            asm volatile("s_waitcnt vmcnt(0) lgkmcnt(0)" ::: "memory"); __syncthreads();
            pg8::Gemm g{PROJ + C_CQ, F.wt(l, WO_Q), MT, QW, 256, NPROJ, 256}; pg8::StaticOrder S; S.init(MT, QW, F.G, F.bid);
            EpiQ E{Qb, F.ssq(SQ_Q0 + l), (const float*)(F.ws + WS_ROPE)};
            pg8::gemm_phase<EpiQ, true>(F.lds, g, S, E);
        }
        SEAM(p + 1);
        if (IN(p + 2)) {
            for (int u = F.bid; u < 256; u += F.G) ssd_unit(F, l, 0, u >> 3, u & 7);
            for (int u = F.bid; u < 256; u += F.G) ssd_unit(F, l, 1, u >> 3, u & 7);
        }
        SEAM(p + 2);
        if (IN(p + 3)) for (int rep = 0; rep < REP_ATT; ++rep) {
            if (rep) xcd_barrier(xbar);
            const bool xl = F.G == 256; const int nloc = xl ? 32 : F.G, lc = xl ? F.bid >> 3 : F.bid, ntot = xl ? 264 : 2112;
            for (int rd = 0; rd * nloc < ntot; ++rd) { const int pos = (rd & 1) ? nloc - 1 - lc : lc; const int lu = rd * nloc + pos; if (lu >= ntot) continue;
                const int level = xl ? lu >> 3 : lu >> 6, within = xl ? lu & 7 : lu & 63, b = xl ? 4 * (F.bid & 7) + (within >> 1) : within >> 1, hf = within & 1;
                attn_unit(F, l, level == 16 ? 1 : 0, b, level < 16 ? 31 - level : level == 16 ? 0 : 32 - level, hf); }
            asm volatile("s_waitcnt vmcnt(0) lgkmcnt(0)" ::: "memory"); __syncthreads();
        }
        SEAM(p + 3);
        if (IN(p + 4)) {
            pg8::Gemm g{AO, F.wt(l, WO_OUT), MT, DM, AOW, AOW, AOW}; pg8::StaticOrder S; S.init(MT, DM, F.G, F.bid);
            EpiRes E{XB, F.ssq(SQ_SSD0 + l), F.ssq(SQ_FFN0 + l)};
            pg8::gemm_phase<EpiRes, true>(F.lds, g, S, E);
        }
        SEAM(p + 4);
        if (IN(p + 5)) for (int rep = 0; rep < REP_GU; ++rep) {
            if (rep) xcd_barrier(xbar);
            pg8::Gemm g{XB, F.wt(l, WO_GU), MT, GUW, DM, DM, DM}; pg8::StaticOrder S; S.init(MT, GUW, F.G, F.bid);
            EpiGU E{Hb, F.ssq(SQ_FFN0 + l)};
            pg8::gemm_phase<EpiGU, true>(F.lds, g, S, E);
        }
        SEAM(p + 5);
        if (IN(p + 6)) {
            pg8::Gemm g{Hb, F.wt(l, WO_DN), MT, DM, FF, FF, FF}; pg8::StaticOrder S; S.init(MT, DM, F.G, F.bid);
            EpiRes E{XB, nullptr, F.ssq(SQ_X1 + l)};
            pg8::gemm_phase<EpiRes, true>(F.lds, g, S, E);
        }
        SEAM(p + 6);
    }
    if (IN(15)) {
        { int t_ = threadIdx.x; asm volatile("" : "+v"(t_)); F.tid = t_; F.lane = t_ & 63; }
        const float* sq = F.ssq(SQ_X2); const float* gf = F.in[I_NFIN];
        f32x4 gg[4];
#pragma unroll
        for (int j = 0; j < 4; ++j) gg[j] = ((const f32x4*)gf)[F.lane + 64 * j];
        for (int row4 = (F.bid * 8 + F.wave) * 4; row4 < MT; row4 += F.G * 8 * 4) {
            u32x2 xw[4][4]; float rs[4];
#pragma unroll
            for (int q = 0; q < 4; ++q) { const int row = row4 + q; rs[q] = sq[row];
#pragma unroll
                for (int j = 0; j < 4; ++j) xw[q][j] = ((const u32x2*)(XB + (size_t)row * DM))[F.lane + 64 * j]; }
#pragma unroll
            for (int q = 0; q < 4; ++q) { const int row = row4 + q; const float r = rsqrtf(rs[q] * (1.f / 1024.f) + EPS); f32x4* yr = (f32x4*)(XR + (size_t)row * DM);
#pragma unroll
                for (int j = 0; j < 4; ++j) { const f32x4 xv = {bflo(xw[q][j].x), bfhi(xw[q][j].x), bflo(xw[q][j].y), bfhi(xw[q][j].y)}; yr[F.lane + 64 * j] = xv * r * gg[j]; } } }
    }
#undef IN
#undef SEAM
}

extern "C" void kernel_launch(void* const* d_in, const int* in_sizes, int n_in, void* d_out, int out_size, void* d_ws, size_t ws_size, hipStream_t stream) {
    static int grid = 0;
    if (grid == 0) {
        if (n_in != 25 || (size_t)out_size != O_END || ws_size < WS_END) { fprintf(stderr, "kernel_launch: unexpected sizes n_in %d out %d ws %zu\n", n_in, out_size, ws_size); grid = -1; return; }
        int dev = 0, cus = 0, per_cu = 0;
        hipGetDevice(&dev); hipDeviceGetAttribute(&cus, hipDeviceAttributeMultiprocessorCount, dev);
        hipFuncSetAttribute((const void*)mk_fwd, hipFuncAttributeMaxDynamicSharedMemorySize, LDS_BYTES);
        hipOccupancyMaxActiveBlocksPerMultiprocessor(&per_cu, (const void*)mk_fwd, 512, LDS_BYTES);
        if (per_cu < 1) { fprintf(stderr, "kernel_launch: occupancy query says %d blocks/CU\n", per_cu); per_cu = 1; }
        (void)hipGetLastError();
        grid = cus;
        fprintf(stderr, "kernel_launch: grid %d (cus %d, per_cu %d)\n", grid, cus, per_cu);
    }
    if (grid < 0) return;
    if (hipMemsetAsync(d_ws, 0, 16384, stream) != hipSuccess) { fprintf(stderr, "kernel_launch: memset failed\n"); return; }
    Args a{};
    for (int i = 0; i < 25; ++i) a.in[i] = (const float*)d_in[i];
    a.out = (float*)d_out; a.ws = (unsigned char*)d_ws;
#if MK_N_LAUNCHES == 1
    a.ph_lo = 0; a.ph_hi = NPH;
    void* kargs[] = {&a};
    hipError_t e = hipLaunchCooperativeKernel((const void*)mk_fwd, dim3(grid), dim3(512), kargs, LDS_BYTES, stream);
    if (e != hipSuccess) fprintf(stderr, "cooperative launch failed: %s (grid %d)\n", hipGetErrorString(e), grid);
#else
    for (int p = 0; p < NPH; ++p) { a.ph_lo = p; a.ph_hi = p + 1; hipLaunchKernelGGL(mk_fwd, dim3(grid), dim3(512), LDS_BYTES, stream, a); }
#endif
}
```

```cpp
#include <hip/hip_runtime.h>
#include <hip/hip_cooperative_groups.h>
#include <cstdio>
#include <cstdint>
namespace cg = cooperative_groups;

#ifndef MK_N_LAUNCHES
#define MK_N_LAUNCHES 1
#endif

#define DI __device__ __forceinline__
#define LAS __attribute__((address_space(3)))
typedef unsigned short bf16_t;
typedef short bf16x8 __attribute__((ext_vector_type(8)));
typedef float f32x4 __attribute__((ext_vector_type(4)));
typedef float f32x16 __attribute__((ext_vector_type(16)));
typedef unsigned u32x4 __attribute__((ext_vector_type(4)));
typedef unsigned u32x2 __attribute__((ext_vector_type(2)));
typedef float f32x2_t __attribute__((ext_vector_type(2)));
typedef __bf16 bf16x2_t __attribute__((ext_vector_type(2)));
typedef LAS unsigned char* ldsp;

constexpr int MP = 65536, MS = 2048, MT = MP + MS;
constexpr int DM = 1024, NPROJ = 2048, QW = 1280, AOW = 1024, FF = 2816, GUW = 2 * FF;
constexpr int C_Z = 0, C_XBC = 512, C_CQ = 1536, C_CKV = 1792, C_KR = 1920, C_DT = 1952;
constexpr float EPS = 1e-6f;
constexpr float QSCALE = 0.10206207261596577f * 1.4426950408889634f;
constexpr int TKP = 2048, TKS = 1088;

constexpr size_t O_YP = 0, O_YS = O_YP + (size_t)MP * DM, O_CKVP = O_YS + (size_t)MS * DM, O_KRP = O_CKVP + (size_t)2 * 32 * 2048 * 128,
                 O_SSMP = O_KRP + (size_t)2 * 32 * 2048 * 32, O_CONVP = O_SSMP + (size_t)2 * 32 * 8 * 64 * 128, O_CKVS = O_CONVP + (size_t)2 * 32 * 3 * 1024,
                 O_KRS = O_CKVS + (size_t)2 * 32 * 64 * 128, O_SSMS = O_KRS + (size_t)2 * 32 * 64 * 32, O_CONVS = O_SSMS + (size_t)2 * 32 * 8 * 64 * 128,
                 O_END = O_CONVS + (size_t)2 * 32 * 3 * 1024;
constexpr size_t MiB = 1u << 20;
constexpr size_t WS_SSQ = 1 * MiB, WS_ROPE = 4 * MiB, WS_W = 8 * MiB, W_LAYER = 25 * MiB;
constexpr size_t WO_IN = 0, WO_Q = 4 * MiB, WO_UV = 4 * MiB + 640 * 1024, WO_OUT = 5 * MiB, WO_GU = 8 * MiB, WO_DN = 19 * MiB;
constexpr size_t WS_KP = 64 * MiB, WS_VTP = 84 * MiB, WS_KS = 100 * MiB, KS_LAYER = 11 * MiB, WS_VTS = 122 * MiB, VTS_LAYER = 9 * MiB;
constexpr size_t WS_XB = 144 * MiB, WS_AO = 276 * MiB, WS_PROJ = 474 * MiB, WS_Q = 738 * MiB, WS_H = WS_PROJ, WS_HALO = 903 * MiB, WS_END = 910 * MiB;
static_assert((size_t)MT * DM * 2 <= WS_AO - WS_XB && (size_t)MT * AOW * 2 <= WS_PROJ - WS_AO && (size_t)MT * NPROJ * 2 <= WS_Q - WS_PROJ && (size_t)MT * QW * 2 <= WS_HALO - WS_Q && (size_t)MT * FF * 2 <= WS_HALO - WS_H && (size_t)1056 * 3 * 1024 * 2 <= WS_END - WS_HALO, "ws map");
static_assert((size_t)32 * TKS * 160 * 2 <= KS_LAYER && (size_t)32 * 128 * TKS * 2 <= VTS_LAYER && (size_t)32 * TKP * 160 * 2 <= WS_VTP - WS_KP && (size_t)32 * 128 * TKP * 2 <= WS_KS - WS_VTP, "ws map 2");
constexpr int SQ_X0 = 0, SQ_X1 = 1, SQ_X2 = 2, SQ_Q0 = 3, SQ_SSD0 = 5, SQ_FFN0 = 7, SQ_N = 9;
static_assert((size_t)SQ_N * MT * 4 <= WS_ROPE - WS_SSQ, "ssq");

constexpr int LDS_BYTES = 147456;
#ifndef REP_ATT
#define REP_ATT 1
#endif
#ifndef REP_GU
#define REP_GU 1
#endif
constexpr int NPH = 16;

DI unsigned cvtpk(float lo, float hi) { f32x2_t v = {lo, hi}; bf16x2_t b = __builtin_convertvector(v, bf16x2_t); return __builtin_bit_cast(unsigned, b); }
DI bf16_t f2bf(float f) { return (bf16_t)(cvtpk(f, 0.f) & 0xffffu); }
DI float bf2f(bf16_t v) { return __uint_as_float((unsigned)v << 16); }
DI float bflo(unsigned w) { return __uint_as_float(w << 16); }
DI float bfhi(unsigned w) { return __uint_as_float(w & 0xffff0000u); }
DI u32x4 pack8(const float* v) { u32x4 w; w.x = cvtpk(v[0], v[1]); w.y = cvtpk(v[2], v[3]); w.z = cvtpk(v[4], v[5]); w.w = cvtpk(v[6], v[7]); return w; }
DI void unpack8(u32x4 w, float* v) { v[0] = bflo(w.x); v[1] = bfhi(w.x); v[2] = bflo(w.y); v[3] = bfhi(w.y); v[4] = bflo(w.z); v[5] = bfhi(w.z); v[6] = bflo(w.w); v[7] = bfhi(w.w); }
DI bf16x8 lds_r16(ldsp p) { return *(const LAS bf16x8*)p; }
DI void lds_w16(ldsp p, u32x4 v) { *(LAS u32x4*)p = v; }
DI int crow(int r, int hi) { return (r & 3) + 8 * (r >> 2) + 4 * hi; }
DI float wave_sum(float v) {
#pragma unroll
    for (int o = 1; o < 64; o <<= 1) v += __shfl_xor(v, o);
    return v;
}
DI float sigmoidf_(float x) { return __builtin_amdgcn_rcpf(1.f + __expf(-x)); }
#define MFMA32(a, b, c) __builtin_amdgcn_mfma_f32_32x32x16_bf16((a), (b), (c), 0, 0, 0)
#define LDS_WAIT() asm volatile("s_waitcnt lgkmcnt(0)" ::: "memory")

namespace pg8 {
constexpr int BM = 256, BK = 64, HALF = 128, HTB = HALF * BK * 2, STAGE_BYTES = 8 * HTB, NXCD = 8, WGM = 8;
DI int lds_byte(int r, int c) { const int st = (r >> 4) * 2 + (c >> 5), rr = r & 15, cc = c & 31, ob = rr * 64 + cc * 2; return st * 1024 + (ob ^ (((ob >> 9) & 1) << 5)); }
DI void stage_rc(int b, int& R, int& C) { const int st = b / 1024, sb = b % 1024, swz = sb ^ (((sb >> 9) & 1) << 5); R = (st >> 1) * 16 + swz / 64; C = (st & 1) * 32 + (swz % 64) / 2; }
DI int perm32(int rho) { const int n = rho >> 4, i = rho & 15; return 8 * (i >> 2) + 4 * n + (i & 3); }
struct Unit { int pm, pn; };
struct Gemm { const bf16_t* A; const bf16_t* Bt; int M, N, K, lda, ldb; };
struct StaticOrder {
    int nM, nN, nwg, G, c;
    DI void init(int M, int N, int G_, int c_) { nM = M / BM; nN = N / BM; nwg = nM * nN; G = G_; c = c_; }
    DI bool next(int i, Unit& u) const {
        const long L = (long)i * G + c; if (L >= nwg) return false;
        int wgid = (int)L; { const int q = nwg / NXCD, r = nwg % NXCD, xcd = wgid % NXCD, off = wgid / NXCD; wgid = (xcd < r ? xcd * (q + 1) : r * (q + 1) + (xcd - r) * q) + off; }
        const int nig = WGM * nN, gid = wgid / nig, fm = gid * WGM, gsz = (nM - fm) < WGM ? (nM - fm) : WGM;
        u.pm = fm + ((wgid % nig) % gsz); u.pn = (wgid % nig) / gsz; return true;
    }
};
template <class Epi, bool ALIGN_EPI>
DI void gemm_phase(ldsp lds, const Gemm g, const StaticOrder& S, const Epi& E) {
    int tid_ = threadIdx.x; asm volatile("" : "+v"(tid_));
    const int tid = tid_, wid = __builtin_amdgcn_readfirstlane(tid >> 6), lane = tid & 63, wr = wid >> 2, wc = wid & 3, fr = lane & 15, fq = lane >> 4;
    const int K = g.K, nt = K / BK;
    unsigned voffA[2], voffB[2];
#pragma unroll
    for (int i = 0; i < 2; ++i) { int R, C; stage_rc(tid * 16 + i * 8192, R, C); const int Rb = Epi::PERM ? ((R & ~31) + perm32(R & 31)) : R;
        voffA[i] = (unsigned)(R * g.lda + C) * 2u; voffB[i] = (unsigned)(Rb * g.ldb + C) * 2u; }
    const size_t kstep = (size_t)(BK * 2);
    const size_t hstepA = (size_t)HALF * g.lda * 2, hstepB = (size_t)HALF * g.ldb * 2;
    const size_t tstepA = 2 * hstepA, tstepB = 2 * hstepB;
    const unsigned ldsw = (unsigned)wid * 1024u;
    const int aoff = lds_byte(wr * 64 + fr, fq * 8), boff = lds_byte(wc * 32 + fr, fq * 8);
#define PG8_SA(b, h) (((b) * 2 + (h)) * HTB)
#define PG8_SB(b, h) ((4 + (b) * 2 + (h)) * HTB)
#define PG8_STAGE(bufoff, gbase, voff) do { _Pragma("unroll") for (int _i = 0; _i < 2; ++_i) \
        __builtin_amdgcn_global_load_lds((const unsigned*)((const char*)(gbase) + (voff)[_i]), (LAS unsigned*)(lds + (bufoff) + ldsw + _i * 8192), 16, 0, 0); } while (0)
#define PG8_LDA(dst, b, h) do { _Pragma("unroll") for (int m = 0; m < 4; ++m) _Pragma("unroll") for (int k = 0; k < 2; ++k) dst[m][k] = *(const LAS bf16x8*)(lds + PG8_SA(b, h) + aoff + m * 2048 + k * 1024); } while (0)
#define PG8_LDB(dst, b, h) do { _Pragma("unroll") for (int n = 0; n < 2; ++n) _Pragma("unroll") for (int k = 0; k < 2; ++k) dst[n][k] = *(const LAS bf16x8*)(lds + PG8_SB(b, h) + boff + n * 2048 + k * 1024); } while (0)
#define PG8_MMA(ai, bj, At, Bt) do { __builtin_amdgcn_s_setprio(1); _Pragma("unroll") for (int m = 0; m < 4; ++m) _Pragma("unroll") for (int n = 0; n < 2; ++n) _Pragma("unroll") for (int k = 0; k < 2; ++k) \
        acc[ai][bj][m][n] = __builtin_amdgcn_mfma_f32_16x16x32_bf16(Bt[n][k], At[m][k], acc[ai][bj][m][n], 0, 0, 0); __builtin_amdgcn_s_setprio(0); } while (0)
#define PG8_WAIT_V(n) asm volatile("s_waitcnt vmcnt(" #n ")" ::: "memory")
#define PG8_WAIT_L(n) asm volatile("s_waitcnt lgkmcnt(" #n ")" ::: "memory")
#define PG8_BAR __builtin_amdgcn_s_barrier()
#define PG8_SCHED __builtin_amdgcn_sched_barrier(0)
    Unit cur, nxt; int ui = 0;
    if (!S.next(0, cur)) return;
    f32x4 acc[2][2][4][2];
#pragma unroll
    for (int a = 0; a < 2; ++a)
#pragma unroll
        for (int b = 0; b < 2; ++b)
#pragma unroll
            for (int m = 0; m < 4; ++m)
#pragma unroll
                for (int n = 0; n < 2; ++n) acc[a][b][m][n] = (f32x4){0.f, 0.f, 0.f, 0.f};
    bf16x8 At[4][2], B0[2][2], B1[2][2];
    const char* cA = (const char*)g.A + (size_t)cur.pm * tstepA; const char* cB = (const char*)g.Bt + (size_t)cur.pn * tstepB;
    PG8_STAGE(PG8_SB(0, 0), cB, voffB); PG8_STAGE(PG8_SB(0, 1), cB + hstepB, voffB); PG8_STAGE(PG8_SA(0, 0), cA, voffA); PG8_STAGE(PG8_SA(0, 1), cA + hstepA, voffA);
    if (wr == 1) PG8_BAR;
    PG8_WAIT_V(2); PG8_BAR;
    PG8_STAGE(PG8_SB(1, 0), cB + kstep, voffB); PG8_STAGE(PG8_SA(1, 0), cA + kstep, voffA); PG8_STAGE(PG8_SB(1, 1), cB + hstepB + kstep, voffB);
    PG8_WAIT_V(6); PG8_BAR;
    for (;;) {
        const bool has_next = S.next(ui + 1, nxt);
        const char* nA = has_next ? (const char*)g.A + (size_t)nxt.pm * tstepA : cA; const char* nB = has_next ? (const char*)g.Bt + (size_t)nxt.pn * tstepB : cB;
        for (int t = 0; t < nt; t += 2) {
            const bool last = (t == nt - 2);
            const char* a1 = cA + (size_t)(t + 1) * kstep;
            const char* a2 = last ? nA : cA + (size_t)(t + 2) * kstep; const char* b2 = last ? nB : cB + (size_t)(t + 2) * kstep;
            const char* a3 = a2 + kstep; const char* b3 = b2 + kstep;
            PG8_LDB(B0, 0, 0); PG8_LDB(B1, 0, 1); PG8_SCHED; PG8_LDA(At, 0, 0); PG8_STAGE(PG8_SA(1, 1), a1 + hstepA, voffA);
            PG8_WAIT_V(8); PG8_WAIT_L(0); PG8_BAR; PG8_MMA(0, 0, At, B0); PG8_MMA(0, 1, At, B1); PG8_BAR; PG8_SCHED;
            PG8_LDA(At, 0, 1); PG8_STAGE(PG8_SB(0, 0), b2, voffB); PG8_STAGE(PG8_SB(0, 1), b2 + hstepB, voffB); PG8_STAGE(PG8_SA(0, 0), a2, voffA);
            PG8_WAIT_V(8); PG8_WAIT_L(0); PG8_BAR; PG8_MMA(1, 0, At, B0); PG8_MMA(1, 1, At, B1); PG8_BAR; PG8_SCHED;
            PG8_LDB(B0, 1, 0); PG8_LDB(B1, 1, 1); PG8_SCHED; PG8_LDA(At, 1, 0); PG8_STAGE(PG8_SA(0, 1), a2 + hstepA, voffA);
            PG8_WAIT_V(8); PG8_WAIT_L(0); PG8_BAR; PG8_MMA(0, 0, At, B0); PG8_MMA(0, 1, At, B1); PG8_BAR; PG8_SCHED;
            PG8_LDA(At, 1, 1); PG8_STAGE(PG8_SB(1, 0), b3, voffB); PG8_STAGE(PG8_SB(1, 1), b3 + hstepB, voffB); PG8_STAGE(PG8_SA(1, 0), a3, voffA);
            PG8_WAIT_V(8); PG8_WAIT_L(0); PG8_BAR; PG8_MMA(1, 0, At, B0); PG8_MMA(1, 1, At, B1); PG8_BAR; PG8_SCHED;
        }
        if constexpr (ALIGN_EPI) { if (wr == 0) PG8_BAR; }
        E(acc, cur, wr, wc, fr, fq);
        if (!has_next) break;
#pragma unroll
        for (int a = 0; a < 2; ++a)
#pragma unroll
            for (int b = 0; b < 2; ++b)
#pragma unroll
                for (int m = 0; m < 4; ++m)
#pragma unroll
                    for (int n = 0; n < 2; ++n) acc[a][b][m][n] = (f32x4){0.f, 0.f, 0.f, 0.f};
        cur = nxt; cA = nA; cB = nB; ++ui;
        if constexpr (ALIGN_EPI) { if (wr == 1) PG8_BAR; }
    }
    PG8_WAIT_V(0);
    if constexpr (!ALIGN_EPI) { if (wr == 0) PG8_BAR; }
    PG8_BAR;
#undef PG8_SA
#undef PG8_SB
#undef PG8_STAGE
#undef PG8_LDA
#undef PG8_LDB
#undef PG8_MMA
#undef PG8_WAIT_V
#undef PG8_WAIT_L
#undef PG8_BAR
#undef PG8_SCHED
}
}
using pg8::Unit;
typedef const f32x4 (&AccRef)[2][2][4][2];

DI float dot4(f32x4 v) { return (v[0] * v[0] + v[1] * v[1]) + (v[2] * v[2] + v[3] * v[3]); }
DI u32x4 pack44(f32x4 a, f32x4 b) { u32x4 w; w.x = cvtpk(a[0], a[1]); w.y = cvtpk(a[2], a[3]); w.z = cvtpk(b[0], b[1]); w.w = cvtpk(b[2], b[3]); return w; }

struct EpiInproj {
    static constexpr bool PERM = true;
    bf16_t* O; const float* ssqx; float* ssqq; bf16_t* halo;
    DI void operator()(AccRef acc, const Unit& u, int wr, int wc, int fr, int fq) const {
        { int t_ = threadIdx.x; asm volatile("" : "+v"(t_)); fr = t_ & 15; fq = (t_ >> 4) & 3; }
        const int col0 = u.pn * 256 + wc * 32 + 8 * fq;
        float rr[2][4];
#pragma unroll
        for (int ai = 0; ai < 2; ++ai)
#pragma unroll
            for (int m = 0; m < 4; ++m) rr[ai][m] = ssqx[u.pm * 256 + ai * 128 + wr * 64 + m * 16 + fr];
#pragma unroll
        for (int ai = 0; ai < 2; ++ai)
#pragma unroll
            for (int m = 0; m < 4; ++m) {
                const int row = u.pm * 256 + ai * 128 + wr * 64 + m * 16 + fr;
                const float r = __builtin_amdgcn_rsqf(rr[ai][m] * (1.f / 1024.f) + EPS);
                float s = 0.f;
#pragma unroll
                for (int bj = 0; bj < 2; ++bj) { const f32x4 v0 = acc[ai][bj][m][0] * r, v1 = acc[ai][bj][m][1] * r; s += dot4(v0) + dot4(v1);
                    const u32x4 pk = pack44(v0, v1); *(u32x4*)(O + (size_t)row * NPROJ + col0 + bj * 128) = pk;
                    if (u.pn >= 2 && u.pn < 6 && (row & 63) >= 61) *(u32x4*)(halo + ((size_t)(row >> 6) * 3 + (row & 63) - 61) * 1024 + col0 + bj * 128 - C_XBC) = pk; }
                if (u.pn == 6) { s += __shfl_xor(s, 16); s += __shfl_xor(s, 32); if (fq == 0) unsafeAtomicAdd(ssqq + row, s); }
                asm volatile("" ::: "memory");
            }
    }
};
struct EpiQ {
    static constexpr bool PERM = false;
    bf16_t* Q; const float* ssqq; const float* rope;
    DI void operator()(AccRef acc, const Unit& u, int wr, int wc, int fr, int fq) const {
        { int t_ = threadIdx.x; asm volatile("" : "+v"(t_)); fr = t_ & 15; fq = (t_ >> 4) & 3; }
        float rr[2][4];
#pragma unroll
        for (int ai = 0; ai < 2; ++ai)
#pragma unroll
            for (int m = 0; m < 4; ++m) rr[ai][m] = ssqq[u.pm * 256 + ai * 128 + wr * 64 + m * 16 + fr];
#pragma unroll
        for (int ai = 0; ai < 2; ++ai)
#pragma unroll
            for (int m = 0; m < 4; ++m) {
                const int row = u.pm * 256 + ai * 128 + wr * 64 + m * 16 + fr;
                const float r = __builtin_amdgcn_rsqf(rr[ai][m] * (1.f / 256.f) + EPS);
                bf16_t* qr = Q + (size_t)row * QW + u.pn * 256 + wc * 32 + 4 * fq;
                if (u.pn < 4) {
#pragma unroll
                    for (int bj = 0; bj < 2; ++bj)
#pragma unroll
                        for (int n = 0; n < 2; ++n) { const f32x4 v = acc[ai][bj][m][n] * r; u32x2 w; w.x = cvtpk(v[0], v[1]); w.y = cvtpk(v[2], v[3]); *(u32x2*)(qr + bj * 128 + n * 16) = w; }
                } else {
                    const int pos = row < MP ? (row & 2047) : 1024 + ((row - MP) & 63);
                    const f32x4 cs = *(const f32x4*)(rope + pos * 32 + 4 * fq), sn = *(const f32x4*)(rope + pos * 32 + 16 + 4 * fq);
#pragma unroll
                    for (int bj = 0; bj < 2; ++bj) { const f32x4 x1 = acc[ai][bj][m][0] * r, x2 = acc[ai][bj][m][1] * r; const f32x4 o1 = x1 * cs - x2 * sn, o2 = x1 * sn + x2 * cs;
                        u32x2 w; w.x = cvtpk(o1[0], o1[1]); w.y = cvtpk(o1[2], o1[3]); *(u32x2*)(qr + bj * 128) = w; w.x = cvtpk(o2[0], o2[1]); w.y = cvtpk(o2[2], o2[3]); *(u32x2*)(qr + bj * 128 + 16) = w; }
                }
                asm volatile("" ::: "memory");
            }
    }
};
struct EpiRes {
    static constexpr bool PERM = true;
    bf16_t* XB; const float* ssq_scale; float* ssq_next;
    DI void operator()(AccRef acc, const Unit& u, int wr, int wc, int fr, int fq) const {
        { int t_ = threadIdx.x; asm volatile("" : "+v"(t_)); fr = t_ & 15; fq = (t_ >> 4) & 3; }
        const int col0 = u.pn * 256 + wc * 32 + 8 * fq;
        float rr[2][4];
#pragma unroll
        for (int ai = 0; ai < 2; ++ai)
#pragma unroll
            for (int m = 0; m < 4; ++m) rr[ai][m] = ssq_scale ? ssq_scale[u.pm * 256 + ai * 128 + wr * 64 + m * 16 + fr] : 0.f;
#pragma unroll
        for (int ai = 0; ai < 2; ++ai) {
            u32x4 bw[4][2];
#pragma unroll
            for (int m = 0; m < 4; ++m)
#pragma unroll
                for (int bj = 0; bj < 2; ++bj) bw[m][bj] = *(const u32x4*)(XB + (size_t)(u.pm * 256 + ai * 128 + wr * 64 + m * 16 + fr) * DM + col0 + bj * 128);
#pragma unroll
            for (int m = 0; m < 4; ++m) {
                const int row = u.pm * 256 + ai * 128 + wr * 64 + m * 16 + fr;
                const float rs = ssq_scale ? __builtin_amdgcn_rsqf(rr[ai][m] * (1.f / 512.f) + EPS) : 1.f;
                float s = 0.f;
#pragma unroll
                for (int bj = 0; bj < 2; ++bj) { bf16_t* xp = XB + (size_t)row * DM + col0 + bj * 128;
                    const u32x4 w4 = bw[m][bj];
                    const f32x4 b0 = {bflo(w4.x), bfhi(w4.x), bflo(w4.y), bfhi(w4.y)}, b1 = {bflo(w4.z), bfhi(w4.z), bflo(w4.w), bfhi(w4.w)};
                    const f32x4 v0 = b0 + acc[ai][bj][m][0] * rs, v1 = b1 + acc[ai][bj][m][1] * rs; s += dot4(v0) + dot4(v1);
                    *(u32x4*)xp = pack44(v0, v1); }
                s += __shfl_xor(s, 16); s += __shfl_xor(s, 32); if (fq == 0) unsafeAtomicAdd(ssq_next + row, s);
            }
            asm volatile("" ::: "memory");
        }
    }
};
struct EpiGU {
    static constexpr bool PERM = true;
    bf16_t* H; const float* ssq;
    DI void operator()(AccRef acc, const Unit& u, int wr, int wc, int fr, int fq) const {
        { int t_ = threadIdx.x; asm volatile("" : "+v"(t_)); fr = t_ & 15; fq = (t_ >> 4) & 3; }
        const int col0 = u.pn * 128 + wc * 32 + 8 * fq;
        float rr[2][4];
#pragma unroll
        for (int ai = 0; ai < 2; ++ai)
#pragma unroll
            for (int m = 0; m < 4; ++m) rr[ai][m] = ssq[u.pm * 256 + ai * 128 + wr * 64 + m * 16 + fr];
#pragma unroll
        for (int ai = 0; ai < 2; ++ai)
#pragma unroll
            for (int m = 0; m < 4; ++m) {
                const int row = u.pm * 256 + ai * 128 + wr * 64 + m * 16 + fr;
                const float r = __builtin_amdgcn_rsqf(rr[ai][m] * (1.f / 1024.f) + EPS);
                f32x4 h[2];
#pragma unroll
                for (int n = 0; n < 2; ++n) { const f32x4 gt = acc[ai][0][m][n] * r, up = acc[ai][1][m][n] * r;
#pragma unroll
                    for (int j = 0; j < 4; ++j) h[n][j] = gt[j] * sigmoidf_(gt[j]) * up[j]; }
                *(u32x4*)(H + (size_t)row * FF + col0) = pack44(h[0], h[1]);
                asm volatile("" ::: "memory");
            }
    }
};

struct Args { const float* in[25]; float* out; unsigned char* ws; int ph_lo, ph_hi; };
struct Frame {
    ldsp lds; int tid, lane, wave, G, bid;
    const float* const* in; float* out; unsigned char* ws;
    DI float* ssq(int i) const { return (float*)(ws + WS_SSQ) + (size_t)i * MT; }
    DI bf16_t* wt(int l, size_t off) const { return (bf16_t*)(ws + WS_W + (size_t)l * W_LAYER + off); }
};
enum { I_XP = 0, I_XS, I_CCKV, I_CKR, I_SSM, I_CONV, I_WIN, I_WUQ, I_WUK, I_WUV, I_WOUT, I_NMIX, I_QN, I_KVN, I_SSDN, I_CW, I_CB, I_DTB, I_ALOG, I_DSKIP, I_NFFN, I_WG, I_WU, I_WD, I_NFIN };

DI void transpose_item(const float* W, int Nsrc, int sc, const float* gain, float gscale, bf16_t* WT, int ldk, int n0, int k0, LAS float* scr, int lane) {
    float tv[32];
#pragma unroll
    for (int i = 0; i < 32; ++i) { const int kk = 2 * i + (lane >> 5); tv[i] = sc >= 0 ? W[(size_t)(k0 + kk) * Nsrc + sc] : 0.f; }
#pragma unroll
    for (int i = 0; i < 32; ++i) { const int kk = 2 * i + (lane >> 5); scr[kk * 33 + (lane & 31)] = tv[i] * (gain ? gain[k0 + kk] : 1.f) * gscale; }
    LDS_WAIT(); asm volatile("" ::: "memory");
    const int c = lane & 7;
#pragma unroll
    for (int j = 0; j < 4; ++j) { const int n = (lane >> 3) + 8 * j; const LAS float* s = scr + (8 * c) * 33 + n;
        u32x4 o; o.x = cvtpk(s[0 * 33], s[1 * 33]); o.y = cvtpk(s[2 * 33], s[3 * 33]); o.z = cvtpk(s[4 * 33], s[5 * 33]); o.w = cvtpk(s[6 * 33], s[7 * 33]);
        *(u32x4*)(WT + (size_t)(n0 + n) * ldk + k0 + 8 * c) = o; }
    LDS_WAIT(); asm volatile("" ::: "memory");
}
DI int src_col_in(int n) { return n < 1536 ? n : n < 1792 ? 1544 + (n - 1536) : n < 1920 ? 1800 + (n - 1792) : n < 1952 ? 1928 + (n - 1920) : n < 1960 ? 1536 + (n - 1952) : -1; }

DI void kv_write_tile(const Frame& F, bf16_t* Kdst, bf16_t* VTdst, int ldvt) {
    int tid = threadIdx.x; asm volatile("" : "+v"(tid)); ldsp T = F.lds;
#pragma unroll
    for (int rr = 0; rr < 3; ++rr) { const int i = tid + rr * 512; if (i < 1280) { const int row = i / 20, pc = i % 20;
        *(u32x4*)(Kdst + (size_t)row * 160 + 8 * pc) = *(const LAS u32x4*)(T + row * 336 + 16 * pc); } }
    const int d = tid >> 2, g = tid & 3;
    const LAS bf16_t* col = (const LAS bf16_t*)T + d;
    unsigned w[8];
#pragma unroll
    for (int hh = 0; hh < 2; ++hh)
#pragma unroll
        for (int a = 0; a < 2; ++a)
#pragma unroll
            for (int i2 = 0; i2 < 2; ++i2) { const int k0 = 16 * g + 8 * a + 4 * hh + 2 * i2;
                w[hh * 4 + a * 2 + i2] = (unsigned)col[(size_t)k0 * 168] | ((unsigned)col[(size_t)(k0 + 1) * 168] << 16); }
    bf16_t* vp = VTdst + (size_t)d * ldvt + 16 * g;
    *(u32x4*)vp = (u32x4){w[0], w[1], w[2], w[3]}; *(u32x4*)(vp + 8) = (u32x4){w[4], w[5], w[6], w[7]};
}

DI void p0_prologue(const Frame& F) {
    const int gw = F.bid * 8 + F.wave, NGW = F.G * 8, gt = F.bid * 512 + F.tid, NT = F.G * 512;
    { float* z = F.ssq(1); for (size_t i = gt; i < (size_t)(SQ_N - 1) * MT; i += NT) z[i] = 0.f; }
    for (int i = gt; i < 2048 * 16; i += NT) { const int pos = i >> 4, j = i & 15;
        const double inv = exp(-9.210340371976184 * (double)j / 16.0), ang = (double)pos * inv;
        const double kq = rint(ang * 0.15915494309189535), x = ang - kq * 6.283185307179586, x2 = x * x;
        double ts = x, sn = x, tc = 1.0, cs = 1.0;
        for (int n = 1; n <= 14; ++n) { tc *= -x2 / (double)((2 * n - 1) * (2 * n)); cs += tc; ts *= -x2 / (double)((2 * n) * (2 * n + 1)); sn += ts; }
        float* rt = (float*)(F.ws + WS_ROPE); rt[pos * 32 + j] = (float)cs; rt[pos * 32 + 16 + j] = (float)sn; }
    LAS float* scr = (LAS float*)(F.lds + F.wave * 16384);
    constexpr int I_IN = 16 * 64, I_GU = 16 * 176, I_DN = 44 * 32, I_OS = 16 * 32, I_QR = 4 * 8, I_L = I_IN + I_GU + I_DN + I_OS + I_QR;
    const int l31 = F.lane & 31;
    for (int it = gw; it < 2 * I_L; it += NGW) {
        const int l = it / I_L; int r = it % I_L;
        if (r < I_IN) { const int kb = r / 64, nb = r % 64; transpose_item(F.in[I_WIN] + (size_t)l * 1024 * 1960, 1960, src_col_in(nb * 32 + l31), F.in[I_NMIX] + l * 1024, 1.f, F.wt(l, WO_IN), 1024, nb * 32, kb * 64, scr, F.lane); continue; } r -= I_IN;
        if (r < I_GU) { const int kb = r / 176, nb = r % 176, n0 = nb * 32, j = n0 >> 8, rr = n0 & 255;
            transpose_item(F.in[rr < 128 ? I_WG : I_WU] + (size_t)l * 1024 * FF, FF, 128 * j + (rr & 127) + l31, F.in[I_NFFN] + l * 1024, 1.f, F.wt(l, WO_GU), 1024, n0, kb * 64, scr, F.lane); continue; } r -= I_GU;
        if (r < I_DN) { const int kb = r / 32, nb = r % 32; transpose_item(F.in[I_WD] + (size_t)l * FF * 1024, 1024, nb * 32 + l31, nullptr, 1.f, F.wt(l, WO_DN), FF, nb * 32, kb * 64, scr, F.lane); continue; } r -= I_DN;
        if (r < I_OS) { const int kb = r / 32, nb = r % 32; transpose_item(F.in[I_WOUT] + (size_t)l * 1024 * 1024, 1024, nb * 32 + l31, kb < 8 ? F.in[I_SSDN] + l * 512 : nullptr, 1.f, F.wt(l, WO_OUT), AOW, nb * 32, kb * 64, scr, F.lane); continue; } r -= I_OS;
        { const int kb = r / 8, h = r % 8; transpose_item(F.in[I_WUQ] + (size_t)l * 256 * 768, 768, h * 96 + 64 + l31, F.in[I_QN] + l * 256, QSCALE, F.wt(l, WO_Q), 256, 1024 + h * 32, kb * 64, scr, F.lane); }
    }
    for (int idx = gt; idx < 2 * 1024 * 256; idx += NT) { const int k = idx & 255, n = (idx >> 8) & 1023, l = idx >> 18, h = n >> 7, lq = n & 127;
        const float* uq = F.in[I_WUQ] + (size_t)l * 256 * 768 + (size_t)k * 768 + h * 96; const float* uk = F.in[I_WUK] + (size_t)l * 128 * 512 + lq * 512 + h * 64;
        float s = 0.f;
#pragma unroll
        for (int d4 = 0; d4 < 16; ++d4) { const f32x4 a = ((const f32x4*)uq)[d4], bq = ((const f32x4*)uk)[d4]; s += (a[0] * bq[0] + a[1] * bq[1]) + (a[2] * bq[2] + a[3] * bq[3]); }
        F.wt(l, WO_Q)[(size_t)n * 256 + k] = f2bf(s * F.in[I_QN][l * 256 + k] * QSCALE); }
    for (int idx = gt; idx < 2 * 8 * 64 * 128; idx += NT) { const int pos = idx & 127, dv = (idx >> 7) & 63, h = (idx >> 13) & 7, l = idx >> 16;
        const int G = pos >> 4, hh = (pos >> 3) & 1, a = (pos >> 2) & 1, i = pos & 3, d = 16 * G + 8 * a + 4 * hh + i;
        F.wt(l, WO_UV)[(size_t)(h * 64 + dv) * 128 + pos] = f2bf(F.in[I_WUV][(size_t)l * 128 * 512 + (size_t)d * 512 + h * 64 + dv]); }
    { float* sq = F.ssq(SQ_X0); bf16_t* XB = (bf16_t*)(F.ws + WS_XB);
      for (int row4 = gw * 4; row4 < MT; row4 += NGW * 4) {
        f32x4 v[4][4];
#pragma unroll
        for (int q = 0; q < 4; ++q) { const int row = row4 + q; const float* xr = row < MP ? F.in[I_XP] + (size_t)row * DM : F.in[I_XS] + (size_t)(row - MP) * DM;
#pragma unroll
            for (int j = 0; j < 4; ++j) v[q][j] = ((const f32x4*)xr)[F.lane + 64 * j]; }
#pragma unroll
        for (int q = 0; q < 4; ++q) { const int row = row4 + q; float s = 0.f;
#pragma unroll
            for (int j = 0; j < 4; ++j) { s += dot4(v[q][j]); u32x2 w; w.x = cvtpk(v[q][j][0], v[q][j][1]); w.y = cvtpk(v[q][j][2], v[q][j][3]); ((u32x2*)(XB + (size_t)row * DM))[F.lane + 64 * j] = w; }
            s = wave_sum(s);
            if (F.lane == 0) sq[row] = s; } } }
    __syncthreads();
    for (int u = F.bid; u < 2 * 32 * 16; u += F.G) { const int l = u >> 9, b = (u >> 4) & 31, pb = u & 15;
        const int pos = F.tid >> 3, part = F.tid & 7; const size_t tok = ((size_t)(l * 32 + b) * 1024 + pb * 64 + pos);
        const f32x4* cs = (const f32x4*)(F.in[I_CCKV] + tok * 128 + part * 16); float v[16];
#pragma unroll
        for (int j = 0; j < 4; ++j) { const f32x4 t = cs[j]; v[4 * j] = t[0]; v[4 * j + 1] = t[1]; v[4 * j + 2] = t[2]; v[4 * j + 3] = t[3]; }
        lds_w16(F.lds + pos * 336 + part * 32, pack8(v)); lds_w16(F.lds + pos * 336 + part * 32 + 16, pack8(v + 8));
        const f32x4 kr = *(const f32x4*)(F.in[I_CKR] + tok * 32 + part * 4); u32x2 w; w.x = cvtpk(kr[0], kr[1]); w.y = cvtpk(kr[2], kr[3]);
        *(LAS u32x2*)(F.lds + pos * 336 + 256 + part * 8) = w;
        __syncthreads();
        kv_write_tile(F, (bf16_t*)(F.ws + WS_KS + l * KS_LAYER) + ((size_t)b * TKS + pb * 64) * 160, (bf16_t*)(F.ws + WS_VTS + l * VTS_LAYER) + (size_t)b * 128 * TKS + pb * 64, TKS);
        __syncthreads();
    }
}

DI void kvprep_unit(const Frame& F, int l, int u) {
    const bool smp = u >= 1024; const int b = smp ? u - 1024 : u >> 5, c = smp ? 0 : u & 31, T = smp ? 64 : 2048;
    const size_t row0 = smp ? (size_t)MP + b * 64 : (size_t)b * 2048 + c * 64;
    const bf16_t* PROJ = (const bf16_t*)(F.ws + WS_PROJ);
    int tid_ = threadIdx.x; asm volatile("" : "+v"(tid_));
    const int tk = tid_ >> 3, part = tid_ & 7, t = c * 64 + tk, pos = smp ? 1024 + t : t;
    const bf16_t* pr = PROJ + (row0 + tk) * NPROJ;
    float v[16]; { const u32x4 a = *(const u32x4*)(pr + C_CKV + part * 16), bb = *(const u32x4*)(pr + C_CKV + part * 16 + 8); unpack8(a, v); unpack8(bb, v + 8); }
    float s = 0.f;
#pragma unroll
    for (int i = 0; i < 16; ++i) s += v[i] * v[i];
    s += __shfl_xor(s, 1); s += __shfl_xor(s, 2); s += __shfl_xor(s, 4);
    const float rs = rsqrtf(s * (1.f / 128.f) + EPS); const float* gk = F.in[I_KVN] + l * 128 + part * 16;
#pragma unroll
    for (int i = 0; i < 16; ++i) v[i] = v[i] * rs * gk[i];
    float* ock = F.out + (smp ? O_CKVS + ((size_t)(l * 32 + b) * 64 + t) * 128 : O_CKVP + ((size_t)(l * 32 + b) * 2048 + t) * 128) + part * 16;
#pragma unroll
    for (int j = 0; j < 4; ++j) ((f32x4*)ock)[j] = (f32x4){v[4 * j], v[4 * j + 1], v[4 * j + 2], v[4 * j + 3]};
    lds_w16(F.lds + tk * 336 + part * 32, pack8(v)); lds_w16(F.lds + tk * 336 + part * 32 + 16, pack8(v + 8));
    { const unsigned w1 = *(const unsigned*)(pr + C_KR + 2 * part), w2 = *(const unsigned*)(pr + C_KR + 16 + 2 * part);
      const float* rt = (const float*)(F.ws + WS_ROPE) + pos * 32 + 2 * part;
      const float x1a = bflo(w1), x1b = bfhi(w1), x2a = bflo(w2), x2b = bfhi(w2), ca = rt[0], cb = rt[1], sa = rt[16], sb = rt[17];
      const float o1a = x1a * ca - x2a * sa, o1b = x1b * cb - x2b * sb, o2a = x1a * sa + x2a * ca, o2b = x1b * sb + x2b * cb;
      float* okr = F.out + (smp ? O_KRS + ((size_t)(l * 32 + b) * 64 + t) * 32 : O_KRP + ((size_t)(l * 32 + b) * 2048 + t) * 32);
      *(f32x2_t*)(okr + 2 * part) = (f32x2_t){o1a, o1b}; *(f32x2_t*)(okr + 16 + 2 * part) = (f32x2_t){o2a, o2b};
      *(LAS unsigned*)(F.lds + tk * 336 + 256 + 4 * part) = cvtpk(o1a, o1b); *(LAS unsigned*)(F.lds + tk * 336 + 256 + 32 + 4 * part) = cvtpk(o2a, o2b); }
    __syncthreads();
    if (smp) kv_write_tile(F, (bf16_t*)(F.ws + WS_KS + l * KS_LAYER) + ((size_t)b * TKS + 1024) * 160, (bf16_t*)(F.ws + WS_VTS + l * VTS_LAYER) + (size_t)b * 128 * TKS + 1024, TKS);
    else kv_write_tile(F, (bf16_t*)(F.ws + WS_KP) + ((size_t)b * TKP + c * 64) * 160, (bf16_t*)(F.ws + WS_VTP) + (size_t)b * 128 * TKP + c * 64, TKP);
    __syncthreads();
}

DI void conv_unit(const Frame& F, int l, int u) {
    int tid_ = threadIdx.x; asm volatile("" : "+v"(tid_));
    const int cg = tid_ & 127, rs = tid_ >> 7, ch = 8 * cg;
    const bool smp = u >= 1024; const int b = smp ? u - 1024 : u >> 5, c = smp ? 0 : u & 31;
    bf16_t* PROJ = (bf16_t*)(F.ws + WS_PROJ); const bf16_t* HALO = (const bf16_t*)(F.ws + WS_HALO);
    const size_t row0 = (size_t)u * 64;
    const int tk = tid_ >> 3, part = tid_ & 7, t = c * 64 + tk, pos = smp ? 1024 + t : t;
    const bf16_t* pr = PROJ + (row0 + tk) * NPROJ;
    const u32x4 kva = *(const u32x4*)(pr + C_CKV + part * 16), kvb = *(const u32x4*)(pr + C_CKV + part * 16 + 8);
    const unsigned kw1 = *(const unsigned*)(pr + C_KR + 2 * part), kw2 = *(const unsigned*)(pr + C_KR + 16 + 2 * part);
    u32x4 uu[19];
#pragma unroll
    for (int i = 0; i < 19; ++i) { const int lr = 16 * rs - 3 + i;
        if (lr >= 0) uu[i] = *(const u32x4*)(PROJ + (row0 + lr) * NPROJ + C_XBC + ch);
        else if (c != 0) uu[i] = *(const u32x4*)(HALO + ((size_t)(u - 1) * 3 + (lr + 3)) * 1024 + ch);
        else if (!smp) uu[i] = (u32x4){0u, 0u, 0u, 0u};
        else { const float* sc = F.in[I_CONV] + ((size_t)(l * 32 + b) * 3 + (lr + 3)) * 1024 + ch; float t8[8];
#pragma unroll
            for (int e = 0; e < 8; ++e) t8[e] = sc[e];
            uu[i] = pack8(t8); } }
    if (smp || c == 31) { if (tid_ < 384) { const int k = tid_ >> 7; float t8[8]; unpack8(*(const u32x4*)(HALO + ((size_t)u * 3 + k) * 1024 + ch), t8);
        float* oc = F.out + (smp ? O_CONVS : O_CONVP) + ((size_t)(l * 32 + b) * 3 + k) * 1024 + ch;
        *(f32x4*)oc = (f32x4){t8[0], t8[1], t8[2], t8[3]}; *(f32x4*)(oc + 4) = (f32x4){t8[4], t8[5], t8[6], t8[7]}; } }
    asm volatile("s_waitcnt vmcnt(0)" ::: "memory"); __syncthreads();
    { float v[16]; unpack8(kva, v); unpack8(kvb, v + 8);
      float s = 0.f;
#pragma unroll
      for (int i = 0; i < 16; ++i) s += v[i] * v[i];
      s += __shfl_xor(s, 1); s += __shfl_xor(s, 2); s += __shfl_xor(s, 4);
      const float rsn = rsqrtf(s * (1.f / 128.f) + EPS); const float* gk = F.in[I_KVN] + l * 128 + part * 16;
#pragma unroll
      for (int i = 0; i < 16; ++i) v[i] = v[i] * rsn * gk[i];
      float* ock = F.out + (smp ? O_CKVS + ((size_t)(l * 32 + b) * 64 + t) * 128 : O_CKVP + ((size_t)(l * 32 + b) * 2048 + t) * 128) + part * 16;
#pragma unroll
      for (int j = 0; j < 4; ++j) ((f32x4*)ock)[j] = (f32x4){v[4 * j], v[4 * j + 1], v[4 * j + 2], v[4 * j + 3]};
      lds_w16(F.lds + tk * 336 + part * 32, pack8(v)); lds_w16(F.lds + tk * 336 + part * 32 + 16, pack8(v + 8));
      const float* rt = (const float*)(F.ws + WS_ROPE) + pos * 32 + 2 * part;
      const float x1a = bflo(kw1), x1b = bfhi(kw1), x2a = bflo(kw2), x2b = bfhi(kw2), ca = rt[0], cb2 = rt[1], sa = rt[16], sb = rt[17];
      const float o1a = x1a * ca - x2a * sa, o1b = x1b * cb2 - x2b * sb, o2a = x1a * sa + x2a * ca, o2b = x1b * sb + x2b * cb2;
      float* okr = F.out + (smp ? O_KRS + ((size_t)(l * 32 + b) * 64 + t) * 32 : O_KRP + ((size_t)(l * 32 + b) * 2048 + t) * 32);
      *(f32x2_t*)(okr + 2 * part) = (f32x2_t){o1a, o1b}; *(f32x2_t*)(okr + 16 + 2 * part) = (f32x2_t){o2a, o2b};
      *(LAS unsigned*)(F.lds + tk * 336 + 256 + 4 * part) = cvtpk(o1a, o1b); *(LAS unsigned*)(F.lds + tk * 336 + 256 + 32 + 4 * part) = cvtpk(o2a, o2b); }
    const float* cw = F.in[I_CW] + (size_t)l * 4 * 1024 + ch; const float* cb = F.in[I_CB] + l * 1024 + ch;
#pragma unroll
    for (int half = 0; half < 2; ++half) {
        unsigned rowpk[8][4];
#pragma unroll
        for (int e2 = 0; e2 < 4; ++e2) {
            float oo[2][8];
#pragma unroll
            for (int q = 0; q < 2; ++q) { const int e = 2 * e2 + q; const float w0 = cw[e], w1 = cw[1024 + e], w2 = cw[2048 + e], w3 = cw[3072 + e], bs = cb[e];
#pragma unroll
                for (int i = 0; i < 8; ++i) { const int ii = 8 * half + i;
                    const float a0 = q ? bfhi(uu[ii][e2]) : bflo(uu[ii][e2]), a1 = q ? bfhi(uu[ii + 1][e2]) : bflo(uu[ii + 1][e2]), a2 = q ? bfhi(uu[ii + 2][e2]) : bflo(uu[ii + 2][e2]), a3 = q ? bfhi(uu[ii + 3][e2]) : bflo(uu[ii + 3][e2]);
                    const float v = bs + w0 * a0 + w1 * a1 + w2 * a2 + w3 * a3; oo[q][i] = v * sigmoidf_(v); } }
#pragma unroll
            for (int i = 0; i < 8; ++i) rowpk[i][e2] = cvtpk(oo[0][i], oo[1][i]);
        }
#pragma unroll
        for (int i = 0; i < 8; ++i) *(u32x4*)(PROJ + (row0 + 16 * rs + 8 * half + i) * NPROJ + C_XBC + ch) = (u32x4){rowpk[i][0], rowpk[i][1], rowpk[i][2], rowpk[i][3]};
        if (half == 0) {
            __syncthreads();
            if (smp) kv_write_tile(F, (bf16_t*)(F.ws + WS_KS + l * KS_LAYER) + ((size_t)b * TKS + 1024) * 160, (bf16_t*)(F.ws + WS_VTS + l * VTS_LAYER) + (size_t)b * 128 * TKS + 1024, TKS);
            else kv_write_tile(F, (bf16_t*)(F.ws + WS_KP) + ((size_t)b * TKP + c * 64) * 160, (bf16_t*)(F.ws + WS_VTP) + (size_t)b * 128 * TKP + c * 64, TKP);
        }
    }
    asm volatile("s_waitcnt vmcnt(0)" ::: "memory"); __syncthreads();
}

DI void ssd_unit(const Frame& F, int l, int kind, int b, int hd, bool do_ssq = true) {
    int tid_ = threadIdx.x; asm volatile("" : "+v"(tid_));
    const int tid = tid_, lane = tid & 63, w = F.wave, r = lane & 31, hi = lane >> 5, g = hd >> 2;
    const int nch = kind == 0 ? 32 : 1;
    const size_t rowbase = kind == 0 ? (size_t)b * 2048 : (size_t)MP + b * 64;
    const bf16_t* PROJ = (const bf16_t*)(F.ws + WS_PROJ); bf16_t* AO = (bf16_t*)(F.ws + WS_AO);
    ldsp L = F.lds;
    constexpr int O_CS = 0, O_BS = 17408, O_BWT = 34816, O_XT = 53248, O_XS = 62464, O_WS = 71680, O_HS = 80896, O_YS = 98304, O_DT = 115712, O_CUM = 116224, O_XS2 = 116736;
    LAS float* dtS = (LAS float*)(L + O_DT); LAS float* cumS = (LAS float*)(L + O_CUM); LAS float* Ys = (LAS float*)(L + O_YS);
    const float Dsk = F.in[I_DSKIP][l * 8 + hd], dtb = F.in[I_DTB][l * 8 + hd], Aneg = -__expf(F.in[I_ALOG][l * 8 + hd]);
    const int pbh = w >> 2, nbh = w & 3;
    f32x16 hacc;
    float* hout = F.out + (kind == 0 ? O_SSMP : O_SSMS) + (size_t)((l * 32 + b) * 8 + hd) * 8192;
    if (kind == 0) {
#pragma unroll
        for (int i = 0; i < 16; ++i) hacc[i] = 0.f;
    } else { const float* h0 = F.in[I_SSM] + (size_t)((l * 32 + b) * 8 + hd) * 8192;
#pragma unroll
        for (int i = 0; i < 16; ++i) hacc[i] = h0[(32 * pbh + crow(i, hi)) * 128 + 32 * nbh + r]; }
#pragma unroll
    for (int i = 0; i < 16; ++i) *(LAS bf16_t*)(L + O_HS + (32 * pbh + crow(i, hi)) * 272 + (32 * nbh + r) * 2) = f2bf(hacc[i]);
    const int lbA = (w & 3) >> 1, sbA = w & 1;
    u32x4 uu[8]; float dtr_n = 0.f;
#define SSD_LOAD_UU(cc) do { const size_t row0_ = rowbase + 64 * (cc); const int cgl = tid >> 3, rsl = tid & 7; \
        const int chl = cgl < 8 ? hd * 64 + 8 * cgl : cgl < 24 ? 512 + g * 128 + 8 * (cgl - 8) : 768 + g * 128 + 8 * (cgl - 24); \
        if (tid < 320) { _Pragma("unroll") for (int i = 0; i < 8; ++i) uu[i] = *(const u32x4*)(PROJ + (row0_ + 8 * rsl + i) * NPROJ + C_XBC + chl); } } while (0)
#define SSD_SCAN(cc) do { const float dtr = dtr_n + dtb; const float dt = dtr > 20.f ? dtr : log1pf(__expf(dtr)); float a = dt * Aneg; \
        _Pragma("unroll") for (int off = 1; off < 64; off <<= 1) { const float t = __shfl_up(a, off); if (lane >= off) a += t; } \
        dtS[((cc) & 1) * 64 + lane] = dt; cumS[((cc) & 1) * 64 + lane] = a; } while (0)
#define SSD_EPI(row0e, xsoff) do { const int el = tid >> 3, pg = tid & 7; const size_t row = (row0e) + el; \
        const f32x4 y0 = *(const LAS f32x4*)(Ys + el * 68 + 8 * pg), y1 = *(const LAS f32x4*)(Ys + el * 68 + 8 * pg + 4); \
        float xv[8], zv[8], ov[8]; \
        unpack8(*(const LAS u32x4*)(L + (xsoff) + el * 144 + pg * 16), xv); unpack8(zk, zv); \
        float s = 0.f; \
        _Pragma("unroll") for (int e = 0; e < 8; ++e) { const float y = (e < 4 ? y0[e & 3] : y1[e & 3]) + Dsk * xv[e]; ov[e] = y * zv[e] * sigmoidf_(zv[e]); s += ov[e] * ov[e]; } \
        *(u32x4*)(AO + row * AOW + hd * 64 + 8 * pg) = pack8(ov); \
        s += __shfl_xor(s, 1); s += __shfl_xor(s, 2); s += __shfl_xor(s, 4); \
        if (pg == 0 && do_ssq) unsafeAtomicAdd(F.ssq(SQ_SSD0 + l) + row, s); } while (0)
    SSD_LOAD_UU(0);
    if (w == 7) { dtr_n = bf2f(PROJ[(rowbase + lane) * NPROJ + C_DT + hd]); SSD_SCAN(0); if (nch > 1) dtr_n = bf2f(PROJ[(rowbase + 64 + lane) * NPROJ + C_DT + hd]); }
    u32x4 zk = (u32x4){0u, 0u, 0u, 0u};
    __syncthreads();
    for (int c = 0; c < nch; ++c) {
        const size_t row0 = rowbase + 64 * c;
        int tl_ = threadIdx.x; asm volatile("" : "+v"(tl_));
        const int tid = tl_, lane = tid & 63, r = lane & 31, hi = lane >> 5;
        const int cg_ = tid >> 3, rs_ = tid & 7;
        const LAS float* dtC = dtS + (c & 1) * 64; const LAS float* cumC = cumS + (c & 1) * 64;
        const int xsC = (c & 1) ? O_XS2 : O_XS;
        if (c > 0) {
#pragma unroll
            for (int i = 0; i < 16; ++i) *(LAS bf16_t*)(L + O_HS + (32 * pbh + crow(i, hi)) * 272 + (32 * nbh + r) * 2) = f2bf(hacc[i]);
            SSD_EPI(row0 - 64, (c & 1) ? O_XS : O_XS2);
        }
        zk = *(const u32x4*)(PROJ + (row0 + (tid >> 3)) * NPROJ + C_Z + hd * 64 + 8 * (tid & 7));
        if (w == 7 && c + 1 < nch) { SSD_SCAN(c + 1); if (c + 2 < nch) dtr_n = bf2f(PROJ[(row0 + 128 + lane) * NPROJ + C_DT + hd]); }
        if (tid < 320) {
            const int l0 = 8 * rs_;
            const bool isB = cg_ >= 8 && cg_ < 24;
            float we[8];
            { const float last = cumC[63];
#pragma unroll
              for (int i = 0; i < 8; ++i) we[i] = isB ? __expf(last - cumC[l0 + i]) * dtC[l0 + i] : 1.f; }
            const ldsp tdst = cg_ < 8 ? L + O_XT + (8 * cg_) * 144 + l0 * 2 : L + O_BWT + (8 * (cg_ - 8)) * 144 + l0 * 2;
            const ldsp rdst = cg_ < 8 ? L + xsC + l0 * 144 + cg_ * 16 : isB ? L + O_BS + l0 * 272 + (cg_ - 8) * 16 : L + O_CS + l0 * 272 + (cg_ - 24) * 16;
            const int rstride = cg_ < 8 ? 144 : 272;
#pragma unroll
            for (int i = 0; i < 8; ++i) lds_w16(rdst + i * rstride, uu[i]);
            if (cg_ < 24) {
#pragma unroll
                for (int e2 = 0; e2 < 4; ++e2)
#pragma unroll
                    for (int q = 0; q < 2; ++q) { float t8[8];
#pragma unroll
                        for (int i = 0; i < 8; ++i) t8[i] = (q ? bfhi(uu[i][e2]) : bflo(uu[i][e2])) * we[i];
                        lds_w16(tdst + (2 * e2 + q) * 144, pack8(t8)); }
            }
        }
        if (c + 1 < nch) SSD_LOAD_UU(c + 1);
        __syncthreads();
        f32x16 accy;
#pragma unroll
        for (int i = 0; i < 16; ++i) accy[i] = 0.f;
        if (w < 4) {
            if (sbA <= lbA) {
#pragma unroll
                for (int ks = 0; ks < 8; ++ks) { const bf16x8 a = lds_r16(L + O_CS + (32 * lbA + r) * 272 + (16 * ks + 8 * hi) * 2), bb = lds_r16(L + O_BS + (32 * sbA + r) * 272 + (16 * ks + 8 * hi) * 2); accy = MFMA32(a, bb, accy); }
            }
            const int s = 32 * sbA + r; const float cs = cumC[s], ds = dtC[s];
#pragma unroll
            for (int i = 0; i < 16; ++i) { const int ll = 32 * lbA + crow(i, hi); const float val = s <= ll ? __expf(cumC[ll] - cs) * accy[i] * ds : 0.f;
                *(LAS bf16_t*)(L + O_WS + ll * 144 + s * 2) = f2bf(val); }
        } else {
#pragma unroll
            for (int ks = 0; ks < 8; ++ks) { const bf16x8 a = lds_r16(L + O_CS + (32 * lbA + r) * 272 + (16 * ks + 8 * hi) * 2), bb = lds_r16(L + O_HS + (32 * sbA + r) * 272 + (16 * ks + 8 * hi) * 2); accy = MFMA32(a, bb, accy); }
#pragma unroll
            for (int i = 0; i < 16; ++i) accy[i] *= __expf(cumC[32 * lbA + crow(i, hi)]);
        }
        __syncthreads();
        if (w >= 4) {
#pragma unroll
            for (int ks = 0; ks < 4; ++ks) { const bf16x8 a = lds_r16(L + O_WS + (32 * lbA + r) * 144 + (16 * ks + 8 * hi) * 2), bb = lds_r16(L + O_XT + (32 * sbA + r) * 144 + (16 * ks + 8 * hi) * 2); accy = MFMA32(a, bb, accy); }
#pragma unroll
            for (int i = 0; i < 16; ++i) Ys[(32 * lbA + crow(i, hi)) * 68 + 32 * sbA + r] = accy[i];
        }
        { const float el = __expf(cumC[63]);
#pragma unroll
          for (int i = 0; i < 16; ++i) hacc[i] *= el;
#pragma unroll
          for (int ks = 0; ks < 4; ++ks) { const bf16x8 a = lds_r16(L + O_XT + (32 * pbh + r) * 144 + (16 * ks + 8 * hi) * 2), bb = lds_r16(L + O_BWT + (32 * nbh + r) * 144 + (16 * ks + 8 * hi) * 2); hacc = MFMA32(a, bb, hacc); } }
        __syncthreads();
    }
    SSD_EPI(rowbase + 64 * (nch - 1), ((nch - 1) & 1) ? O_XS2 : O_XS);
    __syncthreads();
#undef SSD_EPI
#undef SSD_LOAD_UU
#undef SSD_SCAN
#pragma unroll
    for (int i = 0; i < 16; ++i) hout[(32 * pbh + crow(i, hi)) * 128 + 32 * nbh + r] = hacc[i];
}

DI void attn_unit(const Frame& F, int l, int kind, int b, int c, int hf) {
    int tid_ = threadIdx.x; asm volatile("" : "+v"(tid_));
    const int tid = tid_, lane = tid & 63, w = F.wave, r = lane & 31, hi = lane >> 5;
    size_t rowq0; int nt, ldvt; const bf16_t* Kb; const bf16_t* VTb;
    if (kind == 0) { rowq0 = (size_t)b * 2048 + 64 * c + 32 * hf; nt = c + 1; ldvt = TKP; Kb = (const bf16_t*)(F.ws + WS_KP) + (size_t)b * TKP * 160; VTb = (const bf16_t*)(F.ws + WS_VTP) + (size_t)b * 128 * TKP; }
    else { rowq0 = (size_t)MP + b * 64 + 32 * hf; nt = 17; ldvt = TKS; Kb = (const bf16_t*)(F.ws + WS_KS + l * KS_LAYER) + (size_t)b * TKS * 160; VTb = (const bf16_t*)(F.ws + WS_VTS + l * VTS_LAYER) + (size_t)b * 128 * TKS; }
    ldsp L = F.lds;
    constexpr int KTB = 21504, VTB = 18432, O_K = 0, O_V = 3 * KTB;
    const bf16_t* qrow = (const bf16_t*)(F.ws + WS_Q) + (rowq0 + r) * QW;
    bf16x8 qf[10];
#pragma unroll
    for (int ks = 0; ks < 8; ++ks) qf[ks] = *(const bf16x8*)(qrow + w * 128 + 16 * ks + 8 * hi);
#pragma unroll
    for (int ks = 0; ks < 2; ++ks) qf[8 + ks] = *(const bf16x8*)(qrow + 1024 + w * 32 + 16 * ks + 8 * hi);
    unsigned goff[5];
#pragma unroll
    for (int i = 0; i < 5; ++i) { const int ci = w + 8 * i;
        if (ci < 21) { const int o = ci * 1024 + 16 * lane, row = o / 336; int cb = o % 336; if (cb >= 320) cb = 0; goff[i] = (unsigned)(row * 160 + (cb >> 1)); }
        else { const int o = (ci - 21) * 1024 + 16 * lane, d = o / 144; int cb = o % 144; if (cb >= 128) cb = 0; goff[i] = (unsigned)(d * ldvt + (cb >> 1)); } }
#define ATT_DMA(j, kbuf, vbuf) do { _Pragma("unroll") for (int i = 0; i < 5; ++i) { const int ci = w + 8 * i; \
        if (ci < 21) __builtin_amdgcn_global_load_lds((const unsigned*)(Kb + (size_t)(j) * 64 * 160 + goff[i]), (LAS unsigned*)(L + O_K + (kbuf) * KTB + ci * 1024), 16, 0, 0); \
        else if (ci < 39) __builtin_amdgcn_global_load_lds((const unsigned*)(VTb + (size_t)(j) * 64 + goff[i]), (LAS unsigned*)(L + O_V + (vbuf) * VTB + (ci - 21) * 1024), 16, 0, 0); } } while (0)
    ATT_DMA(0, 0, 0);
    if (nt > 1) ATT_DMA(1, 1, 1);
    f32x16 o[4];
#pragma unroll
    for (int d = 0; d < 4; ++d)
#pragma unroll
        for (int i = 0; i < 16; ++i) o[d][i] = 0.f;
    float mhat = 0.f, lsum = 0.f; f32x16 negm;
#pragma unroll
    for (int i = 0; i < 16; ++i) negm[i] = 0.f;
    f32x16 p0, p1; bf16x8 pb[4];
#define ATT_QK(kbuf) do { const ldsp kb_ = L + O_K + (kbuf) * KTB + r * 336 + 16 * hi; bf16x8 kf[6]; \
        _Pragma("unroll") for (int ks = 0; ks < 3; ++ks) { kf[2 * ks] = lds_r16(kb_ + 32 * ks); kf[2 * ks + 1] = lds_r16(kb_ + 32 * 336 + 32 * ks); } \
        __builtin_amdgcn_sched_barrier(0); \
        _Pragma("unroll") for (int ks = 0; ks < 10; ++ks) { const int sl = ks % 3; \
            if (ks == 0) { p0 = MFMA32(kf[0], qf[0], negm); p1 = MFMA32(kf[1], qf[0], negm); } \
            else { p0 = MFMA32(kf[2 * sl], qf[ks], p0); p1 = MFMA32(kf[2 * sl + 1], qf[ks], p1); } \
            if (ks + 3 < 10) { kf[2 * sl] = lds_r16(kb_ + 32 * (ks + 3)); kf[2 * sl + 1] = lds_r16(kb_ + 32 * 336 + 32 * (ks + 3)); } \
            __builtin_amdgcn_sched_barrier(0); } } while (0)
#define MX3(a, b, c) __builtin_fmaxf(__builtin_fmaxf((a), (b)), (c))
#define ATT_SM() do { float mx = MX3(p0[0], p0[1], p1[0]), mx2 = MX3(p1[1], p0[2], p1[2]); \
        _Pragma("unroll") for (int i = 3; i < 15; i += 2) { mx = MX3(mx, p0[i], p1[i]); mx2 = MX3(mx2, p0[i + 1], p1[i + 1]); } \
        mx = MX3(mx, mx2, p0[15]); mx = fmaxf(mx, p1[15]); \
        mx = fmaxf(mx, __shfl_xor(mx, 32)); \
          \
        if (__builtin_amdgcn_ballot_w64(mx > thr_) != 0ull) { const float dl = fmaxf(mx, flr_); mhat += dl; \
            _Pragma("unroll") for (int i = 0; i < 16; ++i) { p0[i] -= dl; p1[i] -= dl; } \
            _Pragma("unroll") for (int i = 0; i < 16; ++i) negm[i] = -mhat; \
            const float alpha = __builtin_amdgcn_exp2f(fminf(-dl, 60.f)); lsum *= alpha; \
            _Pragma("unroll") for (int d = 0; d < 4; ++d) _Pragma("unroll") for (int i = 0; i < 16; ++i) o[d][i] *= alpha; } \
        float ps = 0.f, ps2 = 0.f; \
        _Pragma("unroll") for (int i = 0; i < 16; ++i) { p0[i] = __builtin_amdgcn_exp2f(p0[i]); p1[i] = __builtin_amdgcn_exp2f(p1[i]); ps += p0[i]; ps2 += p1[i]; } \
        lsum += ps + ps2; \
        _Pragma("unroll") for (int kk = 0; kk < 2; ++kk) { u32x4 t; t.x = cvtpk(p0[8 * kk], p0[8 * kk + 1]); t.y = cvtpk(p0[8 * kk + 2], p0[8 * kk + 3]); t.z = cvtpk(p0[8 * kk + 4], p0[8 * kk + 5]); t.w = cvtpk(p0[8 * kk + 6], p0[8 * kk + 7]); pb[kk] = __builtin_bit_cast(bf16x8, t); \
            t.x = cvtpk(p1[8 * kk], p1[8 * kk + 1]); t.y = cvtpk(p1[8 * kk + 2], p1[8 * kk + 3]); t.z = cvtpk(p1[8 * kk + 4], p1[8 * kk + 5]); t.w = cvtpk(p1[8 * kk + 6], p1[8 * kk + 7]); pb[2 + kk] = __builtin_bit_cast(bf16x8, t); } } while (0)
#define ATT_PV(vbuf) do { const ldsp vb_ = L + O_V + (vbuf) * VTB + r * 144 + 16 * hi; bf16x8 vf[8]; \
        _Pragma("unroll") for (int q = 0; q < 2; ++q) _Pragma("unroll") for (int d = 0; d < 4; ++d) vf[4 * q + d] = lds_r16(vb_ + d * 32 * 144 + q * 32); \
        __builtin_amdgcn_sched_barrier(0); \
        _Pragma("unroll") for (int q = 0; q < 4; ++q) { _Pragma("unroll") for (int d = 0; d < 4; ++d) o[d] = MFMA32(vf[4 * (q & 1) + d], pb[q], o[d]); \
            if (q + 2 < 4) { _Pragma("unroll") for (int d = 0; d < 4; ++d) vf[4 * (q & 1) + d] = lds_r16(vb_ + d * 32 * 144 + (q + 2) * 32); } \
            __builtin_amdgcn_sched_barrier(0); } } while (0)
    asm volatile("s_waitcnt vmcnt(0)\n\ts_barrier" ::: "memory");
    int st = 0;
    for (int j = 0; j < nt; ++j) {
        const int st2 = st == 0 ? 2 : st - 1;
        if (j + 2 < nt) ATT_DMA(j + 2, st2, st2);
        int jz = j; asm volatile("" : "+s"(jz));
        const float thr_ = jz ? 8.f : -3e38f, flr_ = jz ? 0.f : -3e38f;
        ATT_QK(st); ATT_SM(); ATT_PV(st);
        if (j + 2 < nt) { if (w < 7) asm volatile("s_waitcnt vmcnt(5)\n\ts_barrier" ::: "memory"); else asm volatile("s_waitcnt vmcnt(4)\n\ts_barrier" ::: "memory"); }
        else asm volatile("s_waitcnt vmcnt(0)\n\ts_barrier" ::: "memory");
        st = st == 2 ? 0 : st + 1;
    }
#undef ATT_DMA
#undef ATT_QK
#undef ATT_SM
#undef MX3
#undef ATT_PV
    lsum += __shfl_xor(lsum, 32);
    const size_t row = rowq0 + r;
    const float inv = __builtin_amdgcn_rcpf(lsum);
    bf16x8 ob[8];
#pragma unroll
    for (int d = 0; d < 4; ++d)
#pragma unroll
        for (int kk = 0; kk < 2; ++kk) { u32x4 t; t.x = cvtpk(o[d][8 * kk] * inv, o[d][8 * kk + 1] * inv); t.y = cvtpk(o[d][8 * kk + 2] * inv, o[d][8 * kk + 3] * inv); t.z = cvtpk(o[d][8 * kk + 4] * inv, o[d][8 * kk + 5] * inv); t.w = cvtpk(o[d][8 * kk + 6] * inv, o[d][8 * kk + 7] * inv); ob[2 * d + kk] = __builtin_bit_cast(bf16x8, t); }
    const bf16_t* wuv = F.wt(l, WO_UV) + (size_t)(w * 64 + r) * 128 + 8 * hi;
    f32x16 D0, D1;
#pragma unroll
    for (int i = 0; i < 16; ++i) { D0[i] = 0.f; D1[i] = 0.f; }
#pragma unroll
    for (int s8 = 0; s8 < 8; ++s8) { const bf16x8 a0 = *(const bf16x8*)(wuv + 16 * s8), a1 = *(const bf16x8*)(wuv + 32 * 128 + 16 * s8); D0 = MFMA32(a0, ob[s8], D0); D1 = MFMA32(a1, ob[s8], D1); }
    const float fac = sqrtf(F.ssq(SQ_SSD0 + l)[row] * (1.f / 512.f) + EPS);
    bf16_t* orow = (bf16_t*)(F.ws + WS_AO) + row * AOW + 512 + w * 64 + 4 * hi;
#pragma unroll
    for (int q = 0; q < 4; ++q) { u32x2 t; t.x = cvtpk(D0[4 * q] * fac, D0[4 * q + 1] * fac); t.y = cvtpk(D0[4 * q + 2] * fac, D0[4 * q + 3] * fac); *(u32x2*)(orow + 8 * q) = t;
        t.x = cvtpk(D1[4 * q] * fac, D1[4 * q + 1] * fac); t.y = cvtpk(D1[4 * q + 2] * fac, D1[4 * q + 3] * fac); *(u32x2*)(orow + 32 + 8 * q) = t; }
}

#define XB_TMO      128
#define XB_XCNT(j)  (256  + 64 * (j))
#define XB_XSUB(j)  (1280 + 64 * (j))
#define XB_XGEN(j)  (2304 + 64 * (j))
#define XB_TOP      3328
#define XB_TOPGEN   3392
#define XCD_BAR_WORDS 3456
#define XB_SPIN_CAP (1u << 20)
DI unsigned xb_ld(unsigned* p)              { return __hip_atomic_load(p, __ATOMIC_RELAXED, __HIP_MEMORY_SCOPE_AGENT); }
DI unsigned xb_add(unsigned* p, unsigned v) { return __hip_atomic_fetch_add(p, v, __ATOMIC_RELAXED, __HIP_MEMORY_SCOPE_AGENT); }
DI unsigned xb_xcc_id() { return (unsigned)__builtin_amdgcn_s_getreg((3 << 11) | 20) & 0xFu; }
#define XB_SPIN(cond, bar) do { unsigned _sp = 0; while (cond) { __builtin_amdgcn_s_sleep(1); \
    if ((++_sp & 255u) == 0u) { if (xb_ld(&(bar)[XB_TMO])) break; if (_sp > XB_SPIN_CAP) { atomicAdd(&(bar)[XB_TMO], 1u); break; } } } } while (0)
struct XcdBarrier { unsigned* bar; unsigned x; volatile LAS unsigned* st; };
DI XcdBarrier xcd_barrier_post(unsigned* bar, volatile LAS unsigned* st) {
    XcdBarrier b; b.bar = bar; b.x = xb_xcc_id(); b.st = st;
    if (threadIdx.x == 0) (void)xb_add(&bar[XB_XCNT(b.x)], 1u);
    return b;
}
DI void xcd_barrier_complete(unsigned* bar, unsigned x, unsigned& nloc, unsigned& nx) {
    const unsigned G = gridDim.x * gridDim.y * gridDim.z;
    unsigned sum, cnt, mine, sp = 0u;
    for (;;) {
        sum = 0u; cnt = 0u; mine = 0u;
#pragma unroll
        for (unsigned j = 0; j < 16; ++j) { const unsigned c = xb_ld(&bar[XB_XCNT(j)]); sum += c; cnt += (c > 0u) ? 1u : 0u; mine = (j == x) ? c : mine; }
        if (sum == G) break;
        __builtin_amdgcn_s_sleep(1);
        if ((++sp & 255u) == 0u) { if (xb_ld(&bar[XB_TMO])) break; if (sp > XB_SPIN_CAP) { atomicAdd(&bar[XB_TMO], 1u); break; } }
    }
    nloc = mine > 0u ? mine : 1u; nx = cnt > 0u ? cnt : 1u;
}
DI void xcd_barrier(const XcdBarrier& b) {
    asm volatile("s_waitcnt vmcnt(0)" ::: "memory");
    __syncthreads();
    if (threadIdx.x == 0) {
        unsigned* bar = b.bar;
        __builtin_amdgcn_s_waitcnt(0);
        unsigned nloc = b.st[0], nx = b.st[1];
        if (nloc == 0u) { xcd_barrier_complete(bar, b.x, nloc, nx); b.st[0] = nloc; b.st[1] = nx; }
        const unsigned old = xb_add(&bar[XB_XSUB(b.x)], 1u);
        const unsigned gen = old / nloc;
        if (old + 1u == (gen + 1u) * nloc) {
            __builtin_amdgcn_fence(__ATOMIC_RELEASE, "agent");
            asm volatile("s_waitcnt vmcnt(0)" ::: "memory");
            const unsigned og = xb_add(&bar[XB_TOP], 1u);
            const unsigned tg = og / nx;
            if (og + 1u == (tg + 1u) * nx) xb_add(&bar[XB_TOPGEN], 1u);
            else XB_SPIN(xb_ld(&bar[XB_TOPGEN]) == tg, bar);
            __builtin_amdgcn_fence(__ATOMIC_ACQUIRE, "agent");
            xb_add(&bar[XB_XGEN(b.x)], 1u);
            asm volatile("s_waitcnt vmcnt(0)" ::: "memory");
        } else {
            XB_SPIN(xb_ld(&bar[XB_XGEN(b.x)]) == gen, bar);
            __builtin_amdgcn_fence(__ATOMIC_ACQUIRE, "agent");
            asm volatile("s_waitcnt vmcnt(0)" ::: "memory");
        }
    }
    __syncthreads();
}

__global__ void __launch_bounds__(512, 2) mk_fwd(Args args) {
    extern __shared__ __attribute__((aligned(16))) unsigned char lds_raw[];
    Frame F;
    F.lds = (ldsp)lds_raw; F.tid = threadIdx.x; F.lane = F.tid & 63; F.wave = __builtin_amdgcn_readfirstlane(F.tid >> 6); F.G = gridDim.x; F.bid = blockIdx.x;
    F.in = args.in; F.out = args.out; F.ws = args.ws;
    cg::grid_group grid = cg::this_grid();
    volatile LAS unsigned* MISC = (volatile LAS unsigned*)(F.lds + 131072 + 512);
    if (threadIdx.x < 4) MISC[threadIdx.x] = 0u;
    __syncthreads();
    XcdBarrier xbar = xcd_barrier_post((unsigned*)F.ws, MISC);
    const int lo = args.ph_lo, hi = args.ph_hi;
#define IN(k) (lo <= (k) && (k) < hi)
#define SEAM(k) do { if (IN(k) && IN((k) + 1)) { if (lo < 0) grid.sync(); else xcd_barrier(xbar); } } while (0)
    bf16_t* XB = (bf16_t*)(F.ws + WS_XB); bf16_t* AO = (bf16_t*)(F.ws + WS_AO); bf16_t* PROJ = (bf16_t*)(F.ws + WS_PROJ); bf16_t* Qb = (bf16_t*)(F.ws + WS_Q); bf16_t* Hb = (bf16_t*)(F.ws + WS_H);
    float* XR = F.out;

    if (IN(0)) { p0_prologue(F); }
    SEAM(0);
#ifdef PROBE_SYNC
    for (int i = 0; i < 20; ++i) grid.sync();
#endif
#ifdef PROBE_P0
    if (IN(0)) { p0_prologue(F); } grid.sync();
#endif
    for (int l = 0; l < 2; ++l) {
        const int p = 1 + 7 * l;
        { int t_ = threadIdx.x; asm volatile("" : "+v"(t_)); F.tid = t_; F.lane = t_ & 63; }
        if (IN(p)) {
            pg8::Gemm g{XB, F.wt(l, WO_IN), MT, NPROJ, DM, DM, DM}; pg8::StaticOrder S; S.init(MT, NPROJ, F.G, F.bid);
            EpiInproj E{PROJ, F.ssq(l == 0 ? SQ_X0 : SQ_X1), F.ssq(SQ_Q0 + l), (bf16_t*)(F.ws + WS_HALO)};
            pg8::gemm_phase<EpiInproj, true>(F.lds, g, S, E);
        }
        SEAM(p);
        if (IN(p + 1)) {
            for (int u = (F.bid + F.G / 2) % F.G; u < 1056; u += F.G) conv_unit(F, l, u);
            asm volatile("s_waitcnt vmcnt(0) lgkmcnt(0)" ::: "memory"); __syncthreads();
            pg8::Gemm g{PROJ + C_CQ, F.wt(l, WO_Q), MT, QW, 256, NPROJ, 256}; pg8::StaticOrder S; S.init(MT, QW, F.G, F.bid);
            EpiQ E{Qb, F.ssq(SQ_Q0 + l), (const float*)(F.ws + WS_ROPE)};
            pg8::gemm_phase<EpiQ, true>(F.lds, g, S, E);
        }
        SEAM(p + 1);
        if (IN(p + 2)) {
            for (int u0 = F.bid; u0 < 256; u0 += F.G) { const int u = F.G == 256 ? ((u0 & 7) * 4 + (u0 >> 6)) * 8 + ((u0 >> 3) & 7) : u0; ssd_unit(F, l, 0, u >> 3, u & 7); }
            for (int u0 = F.bid; u0 < 256; u0 += F.G) { const int u = F.G == 256 ? ((u0 & 7) * 4 + (u0 >> 6)) * 8 + ((u0 >> 3) & 7) : u0; ssd_unit(F, l, 1, u >> 3, u & 7); }
        }
        SEAM(p + 2);
        if (IN(p + 3)) for (int rep = 0; rep < REP_ATT; ++rep) {
            if (rep) xcd_barrier(xbar);
            const bool xl = F.G == 256; const int nloc = xl ? 32 : F.G, lc = xl ? F.bid >> 3 : F.bid, ntot = xl ? 264 : 2112;
            for (int rd = 0; rd * nloc < ntot; ++rd) { const int pos = (rd & 1) ? nloc - 1 - lc : lc; const int lu = rd * nloc + pos; if (lu >= ntot) continue;
                const int level = xl ? lu >> 3 : lu >> 6, within = xl ? lu & 7 : lu & 63, b = xl ? 4 * (F.bid & 7) + (within >> 1) : within >> 1, hf = within & 1;
                attn_unit(F, l, level == 16 ? 1 : 0, b, level < 16 ? 31 - level : level == 16 ? 0 : 32 - level, hf); }
            asm volatile("s_waitcnt vmcnt(0) lgkmcnt(0)" ::: "memory"); __syncthreads();
        }
        SEAM(p + 3);
        if (IN(p + 4)) {
            pg8::Gemm g{AO, F.wt(l, WO_OUT), MT, DM, AOW, AOW, AOW}; pg8::StaticOrder S; S.init(MT, DM, F.G, F.bid);
            EpiRes E{XB, F.ssq(SQ_SSD0 + l), F.ssq(SQ_FFN0 + l)};
            pg8::gemm_phase<EpiRes, true>(F.lds, g, S, E);
        }
        SEAM(p + 4);
        if (IN(p + 5)) for (int rep = 0; rep < REP_GU; ++rep) {
            if (rep) xcd_barrier(xbar);
            pg8::Gemm g{XB, F.wt(l, WO_GU), MT, GUW, DM, DM, DM}; pg8::StaticOrder S; S.init(MT, GUW, F.G, F.bid);
            EpiGU E{Hb, F.ssq(SQ_FFN0 + l)};
            pg8::gemm_phase<EpiGU, true>(F.lds, g, S, E);
        }
        SEAM(p + 5);
        if (IN(p + 6)) {
            pg8::Gemm g{Hb, F.wt(l, WO_DN), MT, DM, FF, FF, FF}; pg8::StaticOrder S; S.init(MT, DM, F.G, F.bid);
            EpiRes E{XB, nullptr, F.ssq(SQ_X1 + l)};
            pg8::gemm_phase<EpiRes, true>(F.lds, g, S, E);
        }
        SEAM(p + 6);
    }
    if (IN(15)) {
        { int t_ = threadIdx.x; asm volatile("" : "+v"(t_)); F.tid = t_; F.lane = t_ & 63; }
        const float* sq = F.ssq(SQ_X2); const float* gf = F.in[I_NFIN];
        f32x4 gg[4];
#pragma unroll
        for (int j = 0; j < 4; ++j) gg[j] = ((const f32x4*)gf)[F.lane + 64 * j];
        for (int row4 = (F.bid * 8 + F.wave) * 4; row4 < MT; row4 += F.G * 8 * 4) {
            u32x2 xw[4][4]; float rs[4];
#pragma unroll
            for (int q = 0; q < 4; ++q) { const int row = row4 + q; rs[q] = sq[row];
#pragma unroll
                for (int j = 0; j < 4; ++j) xw[q][j] = ((const u32x2*)(XB + (size_t)row * DM))[F.lane + 64 * j]; }
#pragma unroll
            for (int q = 0; q < 4; ++q) { const int row = row4 + q; const float r = rsqrtf(rs[q] * (1.f / 1024.f) + EPS); f32x4* yr = (f32x4*)(XR + (size_t)row * DM);
#pragma unroll
                for (int j = 0; j < 4; ++j) { const f32x4 xv = {bflo(xw[q][j].x), bfhi(xw[q][j].x), bflo(xw[q][j].y), bfhi(xw[q][j].y)}; yr[F.lane + 64 * j] = xv * r * gg[j]; } } }
    }
#undef IN
#undef SEAM
}

extern "C" void kernel_launch(void* const* d_in, const int* in_sizes, int n_in, void* d_out, int out_size, void* d_ws, size_t ws_size, hipStream_t stream) {
    static int grid = 0;
    if (grid == 0) {
        if (n_in != 25 || (size_t)out_size != O_END || ws_size < WS_END) { fprintf(stderr, "kernel_launch: unexpected sizes n_in %d out %d ws %zu\n", n_in, out_size, ws_size); grid = -1; return; }
        int dev = 0, cus = 0, per_cu = 0;
        hipGetDevice(&dev); hipDeviceGetAttribute(&cus, hipDeviceAttributeMultiprocessorCount, dev);
        hipFuncSetAttribute((const void*)mk_fwd, hipFuncAttributeMaxDynamicSharedMemorySize, LDS_BYTES);
        hipOccupancyMaxActiveBlocksPerMultiprocessor(&per_cu, (const void*)mk_fwd, 512, LDS_BYTES);
        if (per_cu < 1) { fprintf(stderr, "kernel_launch: occupancy query says %d blocks/CU\n", per_cu); per_cu = 1; }
        (void)hipGetLastError();
        grid = cus;
        fprintf(stderr, "kernel_launch: grid %d (cus %d, per_cu %d)\n", grid, cus, per_cu);
    }
    if (grid < 0) return;
    if (hipMemsetAsync(d_ws, 0, 16384, stream) != hipSuccess) { fprintf(stderr, "kernel_launch: memset failed\n"); return; }
    Args a{};
    for (int i = 0; i < 25; ++i) a.in[i] = (const float*)d_in[i];
    a.out = (float*)d_out; a.ws = (unsigned char*)d_ws;
#if MK_N_LAUNCHES == 1
    a.ph_lo = 0; a.ph_hi = NPH;
    void* kargs[] = {&a};
    hipError_t e = hipLaunchCooperativeKernel((const void*)mk_fwd, dim3(grid), dim3(512), kargs, LDS_BYTES, stream);
    if (e != hipSuccess) fprintf(stderr, "cooperative launch failed: %s (grid %d)\n", hipGetErrorString(e), grid);
#else
    for (int p = 0; p < NPH; ++p) { a.ph_lo = p; a.ph_hi = p + 1; hipLaunchKernelGGL(mk_fwd, dim3(grid), dim3(512), LDS_BYTES, stream, a); }
#endif
}
```

```cpp
#include <hip/hip_runtime.h>
#include <hip/hip_cooperative_groups.h>
#include <cstdio>
#include <cstdint>
namespace cg = cooperative_groups;

#ifndef MK_N_LAUNCHES
#define MK_N_LAUNCHES 1
#endif

#define DI __device__ __forceinline__
#define LAS __attribute__((address_space(3)))
typedef unsigned short bf16_t;
typedef short bf16x8 __attribute__((ext_vector_type(8)));
typedef float f32x4 __attribute__((ext_vector_type(4)));
typedef float f32x16 __attribute__((ext_vector_type(16)));
typedef unsigned u32x4 __attribute__((ext_vector_type(4)));
typedef unsigned u32x2 __attribute__((ext_vector_type(2)));
typedef float f32x2_t __attribute__((ext_vector_type(2)));
typedef __bf16 bf16x2_t __attribute__((ext_vector_type(2)));
typedef LAS unsigned char* ldsp;

constexpr int MP = 65536, MS = 2048, MT = MP + MS;
constexpr int DM = 1024, NPROJ = 2048, QW = 1280, AOW = 1024, FF = 2816, GUW = 2 * FF;
constexpr int C_Z = 0, C_XBC = 512, C_CQ = 1536, C_CKV = 1792, C_KR = 1920, C_DT = 1952;
constexpr float EPS = 1e-6f;
constexpr float QSCALE = 0.10206207261596577f * 1.4426950408889634f;
constexpr int TKP = 2048, TKS = 1088;

constexpr size_t O_YP = 0, O_YS = O_YP + (size_t)MP * DM, O_CKVP = O_YS + (size_t)MS * DM, O_KRP = O_CKVP + (size_t)2 * 32 * 2048 * 128,
                 O_SSMP = O_KRP + (size_t)2 * 32 * 2048 * 32, O_CONVP = O_SSMP + (size_t)2 * 32 * 8 * 64 * 128, O_CKVS = O_CONVP + (size_t)2 * 32 * 3 * 1024,
                 O_KRS = O_CKVS + (size_t)2 * 32 * 64 * 128, O_SSMS = O_KRS + (size_t)2 * 32 * 64 * 32, O_CONVS = O_SSMS + (size_t)2 * 32 * 8 * 64 * 128,
                 O_END = O_CONVS + (size_t)2 * 32 * 3 * 1024;
constexpr size_t MiB = 1u << 20;
constexpr size_t WS_SSQ = 1 * MiB, WS_ROPE = 4 * MiB, WS_W = 8 * MiB, W_LAYER = 25 * MiB;
constexpr size_t WO_IN = 0, WO_Q = 4 * MiB, WO_UV = 4 * MiB + 640 * 1024, WO_OUT = 5 * MiB, WO_GU = 8 * MiB, WO_DN = 19 * MiB;
constexpr size_t WS_KP = 64 * MiB, WS_VTP = 84 * MiB, WS_KS = 100 * MiB, KS_LAYER = 11 * MiB, WS_VTS = 122 * MiB, VTS_LAYER = 9 * MiB;
constexpr size_t WS_XB = 144 * MiB, WS_AO = 276 * MiB, WS_PROJ = 474 * MiB, WS_Q = 738 * MiB, WS_H = WS_PROJ, WS_HALO = 903 * MiB, WS_END = 910 * MiB;
static_assert((size_t)MT * DM * 2 <= WS_AO - WS_XB && (size_t)MT * AOW * 2 <= WS_PROJ - WS_AO && (size_t)MT * NPROJ * 2 <= WS_Q - WS_PROJ && (size_t)MT * QW * 2 <= WS_HALO - WS_Q && (size_t)MT * FF * 2 <= WS_HALO - WS_H && (size_t)1056 * 3 * 1024 * 2 <= WS_END - WS_HALO, "ws map");
static_assert((size_t)32 * TKS * 160 * 2 <= KS_LAYER && (size_t)32 * 128 * TKS * 2 <= VTS_LAYER && (size_t)32 * TKP * 160 * 2 <= WS_VTP - WS_KP && (size_t)32 * 128 * TKP * 2 <= WS_KS - WS_VTP, "ws map 2");
constexpr int SQ_X0 = 0, SQ_X1 = 1, SQ_X2 = 2, SQ_Q0 = 3, SQ_SSD0 = 5, SQ_FFN0 = 7, SQ_N = 9;
static_assert((size_t)SQ_N * MT * 4 <= WS_ROPE - WS_SSQ, "ssq");

constexpr int LDS_BYTES = 147456;
#ifndef REP_ATT
#define REP_ATT 1
#endif
#ifndef REP_GU
#define REP_GU 1
#endif
constexpr int NPH = 16;

DI unsigned cvtpk(float lo, float hi) { f32x2_t v = {lo, hi}; bf16x2_t b = __builtin_convertvector(v, bf16x2_t); return __builtin_bit_cast(unsigned, b); }
DI bf16_t f2bf(float f) { return (bf16_t)(cvtpk(f, 0.f) & 0xffffu); }
DI float bf2f(bf16_t v) { return __uint_as_float((unsigned)v << 16); }
DI float bflo(unsigned w) { return __uint_as_float(w << 16); }
DI float bfhi(unsigned w) { return __uint_as_float(w & 0xffff0000u); }
DI u32x4 pack8(const float* v) { u32x4 w; w.x = cvtpk(v[0], v[1]); w.y = cvtpk(v[2], v[3]); w.z = cvtpk(v[4], v[5]); w.w = cvtpk(v[6], v[7]); return w; }
DI void unpack8(u32x4 w, float* v) { v[0] = bflo(w.x); v[1] = bfhi(w.x); v[2] = bflo(w.y); v[3] = bfhi(w.y); v[4] = bflo(w.z); v[5] = bfhi(w.z); v[6] = bflo(w.w); v[7] = bfhi(w.w); }
DI bf16x8 lds_r16(ldsp p) { return *(const LAS bf16x8*)p; }
DI void lds_w16(ldsp p, u32x4 v) { *(LAS u32x4*)p = v; }
DI int crow(int r, int hi) { return (r & 3) + 8 * (r >> 2) + 4 * hi; }
DI float wave_sum(float v) {
#pragma unroll
    for (int o = 1; o < 64; o <<= 1) v += __shfl_xor(v, o);
    return v;
}
DI float sigmoidf_(float x) { return __builtin_amdgcn_rcpf(1.f + __expf(-x)); }
#define MFMA32(a, b, c) __builtin_amdgcn_mfma_f32_32x32x16_bf16((a), (b), (c), 0, 0, 0)
#define LDS_WAIT() asm volatile("s_waitcnt lgkmcnt(0)" ::: "memory")

namespace pg8 {
constexpr int BM = 256, BK = 64, HALF = 128, HTB = HALF * BK * 2, STAGE_BYTES = 8 * HTB, NXCD = 8, WGM = 8;
DI int lds_byte(int r, int c) { const int st = (r >> 4) * 2 + (c >> 5), rr = r & 15, cc = c & 31, ob = rr * 64 + cc * 2; return st * 1024 + (ob ^ (((ob >> 9) & 1) << 5)); }
DI void stage_rc(int b, int& R, int& C) { const int st = b / 1024, sb = b % 1024, swz = sb ^ (((sb >> 9) & 1) << 5); R = (st >> 1) * 16 + swz / 64; C = (st & 1) * 32 + (swz % 64) / 2; }
DI int perm32(int rho) { const int n = rho >> 4, i = rho & 15; return 8 * (i >> 2) + 4 * n + (i & 3); }
struct Unit { int pm, pn; };
struct Gemm { const bf16_t* A; const bf16_t* Bt; int M, N, K, lda, ldb; };
struct StaticOrder {
    int nM, nN, nwg, G, c;
    DI void init(int M, int N, int G_, int c_) { nM = M / BM; nN = N / BM; nwg = nM * nN; G = G_; c = c_; }
    DI bool next(int i, Unit& u) const {
        const long L = (long)i * G + c; if (L >= nwg) return false;
        int wgid = (int)L; { const int q = nwg / NXCD, r = nwg % NXCD, xcd = wgid % NXCD, off = wgid / NXCD; wgid = (xcd < r ? xcd * (q + 1) : r * (q + 1) + (xcd - r) * q) + off; }
        const int nig = WGM * nN, gid = wgid / nig, fm = gid * WGM, gsz = (nM - fm) < WGM ? (nM - fm) : WGM;
        u.pm = fm + ((wgid % nig) % gsz); u.pn = (wgid % nig) / gsz; return true;
    }
};
template <class Epi, bool ALIGN_EPI>
DI void gemm_phase(ldsp lds, const Gemm g, const StaticOrder& S, const Epi& E) {
    int tid_ = threadIdx.x; asm volatile("" : "+v"(tid_));
    const int tid = tid_, wid = __builtin_amdgcn_readfirstlane(tid >> 6), lane = tid & 63, wr = wid >> 2, wc = wid & 3, fr = lane & 15, fq = lane >> 4;
    const int K = g.K, nt = K / BK;
    unsigned voffA[2], voffB[2];
#pragma unroll
    for (int i = 0; i < 2; ++i) { int R, C; stage_rc(tid * 16 + i * 8192, R, C); const int Rb = Epi::PERM ? ((R & ~31) + perm32(R & 31)) : R;
        voffA[i] = (unsigned)(R * g.lda + C) * 2u; voffB[i] = (unsigned)(Rb * g.ldb + C) * 2u; }
    const size_t kstep = (size_t)(BK * 2);
    const size_t hstepA = (size_t)HALF * g.lda * 2, hstepB = (size_t)HALF * g.ldb * 2;
    const size_t tstepA = 2 * hstepA, tstepB = 2 * hstepB;
    const unsigned ldsw = (unsigned)wid * 1024u;
    const int aoff = lds_byte(wr * 64 + fr, fq * 8), boff = lds_byte(wc * 32 + fr, fq * 8);
#define PG8_SA(b, h) (((b) * 2 + (h)) * HTB)
#define PG8_SB(b, h) ((4 + (b) * 2 + (h)) * HTB)
#define PG8_STAGE(bufoff, gbase, voff) do { _Pragma("unroll") for (int _i = 0; _i < 2; ++_i) \
        __builtin_amdgcn_global_load_lds((const unsigned*)((const char*)(gbase) + (voff)[_i]), (LAS unsigned*)(lds + (bufoff) + ldsw + _i * 8192), 16, 0, 0); } while (0)
#define PG8_LDA(dst, b, h) do { _Pragma("unroll") for (int m = 0; m < 4; ++m) _Pragma("unroll") for (int k = 0; k < 2; ++k) dst[m][k] = *(const LAS bf16x8*)(lds + PG8_SA(b, h) + aoff + m * 2048 + k * 1024); } while (0)
#define PG8_LDB(dst, b, h) do { _Pragma("unroll") for (int n = 0; n < 2; ++n) _Pragma("unroll") for (int k = 0; k < 2; ++k) dst[n][k] = *(const LAS bf16x8*)(lds + PG8_SB(b, h) + boff + n * 2048 + k * 1024); } while (0)
#define PG8_MMA(ai, bj, At, Bt) do { __builtin_amdgcn_s_setprio(1); _Pragma("unroll") for (int m = 0; m < 4; ++m) _Pragma("unroll") for (int n = 0; n < 2; ++n) _Pragma("unroll") for (int k = 0; k < 2; ++k) \
        acc[ai][bj][m][n] = __builtin_amdgcn_mfma_f32_16x16x32_bf16(Bt[n][k], At[m][k], acc[ai][bj][m][n], 0, 0, 0); __builtin_amdgcn_s_setprio(0); } while (0)
#define PG8_WAIT_V(n) asm volatile("s_waitcnt vmcnt(" #n ")" ::: "memory")
#define PG8_WAIT_L(n) asm volatile("s_waitcnt lgkmcnt(" #n ")" ::: "memory")
#define PG8_BAR __builtin_amdgcn_s_barrier()
#define PG8_SCHED __builtin_amdgcn_sched_barrier(0)
    Unit cur, nxt; int ui = 0;
    if (!S.next(0, cur)) return;
    f32x4 acc[2][2][4][2];
#pragma unroll
    for (int a = 0; a < 2; ++a)
#pragma unroll
        for (int b = 0; b < 2; ++b)
#pragma unroll
            for (int m = 0; m < 4; ++m)
#pragma unroll
                for (int n = 0; n < 2; ++n) acc[a][b][m][n] = (f32x4){0.f, 0.f, 0.f, 0.f};
    bf16x8 At[4][2], B0[2][2], B1[2][2];
    const char* cA = (const char*)g.A + (size_t)cur.pm * tstepA; const char* cB = (const char*)g.Bt + (size_t)cur.pn * tstepB;
    PG8_STAGE(PG8_SB(0, 0), cB, voffB); PG8_STAGE(PG8_SB(0, 1), cB + hstepB, voffB); PG8_STAGE(PG8_SA(0, 0), cA, voffA); PG8_STAGE(PG8_SA(0, 1), cA + hstepA, voffA);
    if (wr == 1) PG8_BAR;
    PG8_WAIT_V(2); PG8_BAR;
    PG8_STAGE(PG8_SB(1, 0), cB + kstep, voffB); PG8_STAGE(PG8_SA(1, 0), cA + kstep, voffA); PG8_STAGE(PG8_SB(1, 1), cB + hstepB + kstep, voffB);
    PG8_WAIT_V(6); PG8_BAR;
    for (;;) {
        const bool has_next = S.next(ui + 1, nxt);
        const char* nA = has_next ? (const char*)g.A + (size_t)nxt.pm * tstepA : cA; const char* nB = has_next ? (const char*)g.Bt + (size_t)nxt.pn * tstepB : cB;
        for (int t = 0; t < nt; t += 2) {
            const bool last = (t == nt - 2);
            const char* a1 = cA + (size_t)(t + 1) * kstep;
            const char* a2 = last ? nA : cA + (size_t)(t + 2) * kstep; const char* b2 = last ? nB : cB + (size_t)(t + 2) * kstep;
            const char* a3 = a2 + kstep; const char* b3 = b2 + kstep;
            PG8_LDB(B0, 0, 0); PG8_LDB(B1, 0, 1); PG8_SCHED; PG8_LDA(At, 0, 0); PG8_STAGE(PG8_SA(1, 1), a1 + hstepA, voffA);
            PG8_WAIT_V(8); PG8_WAIT_L(0); PG8_BAR; PG8_MMA(0, 0, At, B0); PG8_MMA(0, 1, At, B1); PG8_BAR; PG8_SCHED;
            PG8_LDA(At, 0, 1); PG8_STAGE(PG8_SB(0, 0), b2, voffB); PG8_STAGE(PG8_SB(0, 1), b2 + hstepB, voffB); PG8_STAGE(PG8_SA(0, 0), a2, voffA);
            PG8_WAIT_V(8); PG8_WAIT_L(0); PG8_BAR; PG8_MMA(1, 0, At, B0); PG8_MMA(1, 1, At, B1); PG8_BAR; PG8_SCHED;
            PG8_LDB(B0, 1, 0); PG8_LDB(B1, 1, 1); PG8_SCHED; PG8_LDA(At, 1, 0); PG8_STAGE(PG8_SA(0, 1), a2 + hstepA, voffA);
            PG8_WAIT_V(8); PG8_WAIT_L(0); PG8_BAR; PG8_MMA(0, 0, At, B0); PG8_MMA(0, 1, At, B1); PG8_BAR; PG8_SCHED;
            PG8_LDA(At, 1, 1); PG8_STAGE(PG8_SB(1, 0), b3, voffB); PG8_STAGE(PG8_SB(1, 1), b3 + hstepB, voffB); PG8_STAGE(PG8_SA(1, 0), a3, voffA);
            PG8_WAIT_V(8); PG8_WAIT_L(0); PG8_BAR; PG8_MMA(1, 0, At, B0); PG8_MMA(1, 1, At, B1); PG8_BAR; PG8_SCHED;
        }
        if constexpr (ALIGN_EPI) { if (wr == 0) PG8_BAR; }
        E(acc, cur, wr, wc, fr, fq);
        if (!has_next) break;
#pragma unroll
        for (int a = 0; a < 2; ++a)
#pragma unroll
            for (int b = 0; b < 2; ++b)
#pragma unroll
                for (int m = 0; m < 4; ++m)
#pragma unroll
                    for (int n = 0; n < 2; ++n) acc[a][b][m][n] = (f32x4){0.f, 0.f, 0.f, 0.f};
        cur = nxt; cA = nA; cB = nB; ++ui;
        if constexpr (ALIGN_EPI) { if (wr == 1) PG8_BAR; }
    }
    PG8_WAIT_V(0);
    if constexpr (!ALIGN_EPI) { if (wr == 0) PG8_BAR; }
    PG8_BAR;
#undef PG8_SA
#undef PG8_SB
#undef PG8_STAGE
#undef PG8_LDA
#undef PG8_LDB
#undef PG8_MMA
#undef PG8_WAIT_V
#undef PG8_WAIT_L
#undef PG8_BAR
#undef PG8_SCHED
}
}
using pg8::Unit;
typedef const f32x4 (&AccRef)[2][2][4][2];

DI float dot4(f32x4 v) { return (v[0] * v[0] + v[1] * v[1]) + (v[2] * v[2] + v[3] * v[3]); }
DI u32x4 pack44(f32x4 a, f32x4 b) { u32x4 w; w.x = cvtpk(a[0], a[1]); w.y = cvtpk(a[2], a[3]); w.z = cvtpk(b[0], b[1]); w.w = cvtpk(b[2], b[3]); return w; }

struct EpiInproj {
    static constexpr bool PERM = true;
    bf16_t* O; const float* ssqx; float* ssqq; bf16_t* halo;
    DI void operator()(AccRef acc, const Unit& u, int wr, int wc, int fr, int fq) const {
        { int t_ = threadIdx.x; asm volatile("" : "+v"(t_)); fr = t_ & 15; fq = (t_ >> 4) & 3; }
        const int col0 = u.pn * 256 + wc * 32 + 8 * fq;
        float rr[2][4];
#pragma unroll
        for (int ai = 0; ai < 2; ++ai)
#pragma unroll
            for (int m = 0; m < 4; ++m) rr[ai][m] = ssqx[u.pm * 256 + ai * 128 + wr * 64 + m * 16 + fr];
#pragma unroll
        for (int ai = 0; ai < 2; ++ai)
#pragma unroll
            for (int m = 0; m < 4; ++m) {
                const int row = u.pm * 256 + ai * 128 + wr * 64 + m * 16 + fr;
                const float r = __builtin_amdgcn_rsqf(rr[ai][m] * (1.f / 1024.f) + EPS);
                float s = 0.f;
#pragma unroll
                for (int bj = 0; bj < 2; ++bj) { const f32x4 v0 = acc[ai][bj][m][0] * r, v1 = acc[ai][bj][m][1] * r; s += dot4(v0) + dot4(v1);
                    const u32x4 pk = pack44(v0, v1); *(u32x4*)(O + (size_t)row * NPROJ + col0 + bj * 128) = pk;
                    if (u.pn >= 2 && u.pn < 6 && (row & 63) >= 61) *(u32x4*)(halo + ((size_t)(row >> 6) * 3 + (row & 63) - 61) * 1024 + col0 + bj * 128 - C_XBC) = pk; }
                if (u.pn == 6) { s += __shfl_xor(s, 16); s += __shfl_xor(s, 32); if (fq == 0) unsafeAtomicAdd(ssqq + row, s); }
                asm volatile("" ::: "memory");
            }
    }
};
struct EpiQ {
    static constexpr bool PERM = false;
    bf16_t* Q; const float* ssqq; const float* rope;
    DI void operator()(AccRef acc, const Unit& u, int wr, int wc, int fr, int fq) const {
        { int t_ = threadIdx.x; asm volatile("" : "+v"(t_)); fr = t_ & 15; fq = (t_ >> 4) & 3; }
        float rr[2][4];
#pragma unroll
        for (int ai = 0; ai < 2; ++ai)
#pragma unroll
            for (int m = 0; m < 4; ++m) rr[ai][m] = ssqq[u.pm * 256 + ai * 128 + wr * 64 + m * 16 + fr];
#pragma unroll
        for (int ai = 0; ai < 2; ++ai)
#pragma unroll
            for (int m = 0; m < 4; ++m) {
                const int row = u.pm * 256 + ai * 128 + wr * 64 + m * 16 + fr;
                const float r = __builtin_amdgcn_rsqf(rr[ai][m] * (1.f / 256.f) + EPS);
                bf16_t* qr = Q + (size_t)row * QW + u.pn * 256 + wc * 32 + 4 * fq;
                if (u.pn < 4) {
#pragma unroll
                    for (int bj = 0; bj < 2; ++bj)
#pragma unroll
                        for (int n = 0; n < 2; ++n) { const f32x4 v = acc[ai][bj][m][n] * r; u32x2 w; w.x = cvtpk(v[0], v[1]); w.y = cvtpk(v[2], v[3]); *(u32x2*)(qr + bj * 128 + n * 16) = w; }
                } else {
                    const int pos = row < MP ? (row & 2047) : 1024 + ((row - MP) & 63);
                    const f32x4 cs = *(const f32x4*)(rope + pos * 32 + 4 * fq), sn = *(const f32x4*)(rope + pos * 32 + 16 + 4 * fq);
#pragma unroll
                    for (int bj = 0; bj < 2; ++bj) { const f32x4 x1 = acc[ai][bj][m][0] * r, x2 = acc[ai][bj][m][1] * r; const f32x4 o1 = x1 * cs - x2 * sn, o2 = x1 * sn + x2 * cs;
                        u32x2 w; w.x = cvtpk(o1[0], o1[1]); w.y = cvtpk(o1[2], o1[3]); *(u32x2*)(qr + bj * 128) = w; w.x = cvtpk(o2[0], o2[1]); w.y = cvtpk(o2[2], o2[3]); *(u32x2*)(qr + bj * 128 + 16) = w; }
                }
                asm volatile("" ::: "memory");
            }
    }
};
struct EpiRes {
    static constexpr bool PERM = true;
    bf16_t* XB; const float* ssq_scale; float* ssq_next;
    DI void operator()(AccRef acc, const Unit& u, int wr, int wc, int fr, int fq) const {
        { int t_ = threadIdx.x; asm volatile("" : "+v"(t_)); fr = t_ & 15; fq = (t_ >> 4) & 3; }
        const int col0 = u.pn * 256 + wc * 32 + 8 * fq;
        float rr[2][4];
#pragma unroll
        for (int ai = 0; ai < 2; ++ai)
#pragma unroll
            for (int m = 0; m < 4; ++m) rr[ai][m] = ssq_scale ? ssq_scale[u.pm * 256 + ai * 128 + wr * 64 + m * 16 + fr] : 0.f;
#pragma unroll
        for (int ai = 0; ai < 2; ++ai) {
            u32x4 bw[4][2];
#pragma unroll
            for (int m = 0; m < 4; ++m)
#pragma unroll
                for (int bj = 0; bj < 2; ++bj) bw[m][bj] = *(const u32x4*)(XB + (size_t)(u.pm * 256 + ai * 128 + wr * 64 + m * 16 + fr) * DM + col0 + bj * 128);
#pragma unroll
            for (int m = 0; m < 4; ++m) {
                const int row = u.pm * 256 + ai * 128 + wr * 64 + m * 16 + fr;
                const float rs = ssq_scale ? __builtin_amdgcn_rsqf(rr[ai][m] * (1.f / 512.f) + EPS) : 1.f;
                float s = 0.f;
#pragma unroll
                for (int bj = 0; bj < 2; ++bj) { bf16_t* xp = XB + (size_t)row * DM + col0 + bj * 128;
                    const u32x4 w4 = bw[m][bj];
                    const f32x4 b0 = {bflo(w4.x), bfhi(w4.x), bflo(w4.y), bfhi(w4.y)}, b1 = {bflo(w4.z), bfhi(w4.z), bflo(w4.w), bfhi(w4.w)};
                    const f32x4 v0 = b0 + acc[ai][bj][m][0] * rs, v1 = b1 + acc[ai][bj][m][1] * rs; s += dot4(v0) + dot4(v1);
                    *(u32x4*)xp = pack44(v0, v1); }
                s += __shfl_xor(s, 16); s += __shfl_xor(s, 32); if (fq == 0) unsafeAtomicAdd(ssq_next + row, s);
            }
            asm volatile("" ::: "memory");
        }
    }
};
struct EpiGU {
    static constexpr bool PERM = true;
    bf16_t* H; const float* ssq;
    DI void operator()(AccRef acc, const Unit& u, int wr, int wc, int fr, int fq) const {
        { int t_ = threadIdx.x; asm volatile("" : "+v"(t_)); fr = t_ & 15; fq = (t_ >> 4) & 3; }
        const int col0 = u.pn * 128 + wc * 32 + 8 * fq;
        float rr[2][4];
#pragma unroll
        for (int ai = 0; ai < 2; ++ai)
#pragma unroll
            for (int m = 0; m < 4; ++m) rr[ai][m] = ssq[u.pm * 256 + ai * 128 + wr * 64 + m * 16 + fr];
#pragma unroll
        for (int ai = 0; ai < 2; ++ai)
#pragma unroll
            for (int m = 0; m < 4; ++m) {
                const int row = u.pm * 256 + ai * 128 + wr * 64 + m * 16 + fr;
                const float r = __builtin_amdgcn_rsqf(rr[ai][m] * (1.f / 1024.f) + EPS);
                f32x4 h[2];
#pragma unroll
                for (int n = 0; n < 2; ++n) { const f32x4 gt = acc[ai][0][m][n] * r, up = acc[ai][1][m][n] * r;
#pragma unroll
                    for (int j = 0; j < 4; ++j) h[n][j] = gt[j] * sigmoidf_(gt[j]) * up[j]; }
                *(u32x4*)(H + (size_t)row * FF + col0) = pack44(h[0], h[1]);
                asm volatile("" ::: "memory");
            }
    }
};

struct Args { const float* in[25]; float* out; unsigned char* ws; int ph_lo, ph_hi; };
struct Frame {
    ldsp lds; int tid, lane, wave, G, bid;
    const float* const* in; float* out; unsigned char* ws;
    DI float* ssq(int i) const { return (float*)(ws + WS_SSQ) + (size_t)i * MT; }
    DI bf16_t* wt(int l, size_t off) const { return (bf16_t*)(ws + WS_W + (size_t)l * W_LAYER + off); }
};
enum { I_XP = 0, I_XS, I_CCKV, I_CKR, I_SSM, I_CONV, I_WIN, I_WUQ, I_WUK, I_WUV, I_WOUT, I_NMIX, I_QN, I_KVN, I_SSDN, I_CW, I_CB, I_DTB, I_ALOG, I_DSKIP, I_NFFN, I_WG, I_WU, I_WD, I_NFIN };

DI void transpose_item(const float* W, int Nsrc, int sc, const float* gain, float gscale, bf16_t* WT, int ldk, int n0, int k0, LAS float* scr, int lane) {
    float tv[32];
#pragma unroll
    for (int i = 0; i < 32; ++i) { const int kk = 2 * i + (lane >> 5); tv[i] = sc >= 0 ? W[(size_t)(k0 + kk) * Nsrc + sc] : 0.f; }
#pragma unroll
    for (int i = 0; i < 32; ++i) { const int kk = 2 * i + (lane >> 5); scr[kk * 33 + (lane & 31)] = tv[i] * (gain ? gain[k0 + kk] : 1.f) * gscale; }
    LDS_WAIT(); asm volatile("" ::: "memory");
    const int c = lane & 7;
#pragma unroll
    for (int j = 0; j < 4; ++j) { const int n = (lane >> 3) + 8 * j; const LAS float* s = scr + (8 * c) * 33 + n;
        u32x4 o; o.x = cvtpk(s[0 * 33], s[1 * 33]); o.y = cvtpk(s[2 * 33], s[3 * 33]); o.z = cvtpk(s[4 * 33], s[5 * 33]); o.w = cvtpk(s[6 * 33], s[7 * 33]);
        *(u32x4*)(WT + (size_t)(n0 + n) * ldk + k0 + 8 * c) = o; }
    LDS_WAIT(); asm volatile("" ::: "memory");
}
DI int src_col_in(int n) { return n < 1536 ? n : n < 1792 ? 1544 + (n - 1536) : n < 1920 ? 1800 + (n - 1792) : n < 1952 ? 1928 + (n - 1920) : n < 1960 ? 1536 + (n - 1952) : -1; }

DI void kv_write_tile(const Frame& F, bf16_t* Kdst, bf16_t* VTdst, int ldvt) {
    int tid = threadIdx.x; asm volatile("" : "+v"(tid)); ldsp T = F.lds;
#pragma unroll
    for (int rr = 0; rr < 3; ++rr) { const int i = tid + rr * 512; if (i < 1280) { const int row = i / 20, pc = i % 20;
        *(u32x4*)(Kdst + (size_t)row * 160 + 8 * pc) = *(const LAS u32x4*)(T + row * 336 + 16 * pc); } }
    const int d = tid >> 2, g = tid & 3;
    const LAS bf16_t* col = (const LAS bf16_t*)T + d;
    unsigned w[8];
#pragma unroll
    for (int hh = 0; hh < 2; ++hh)
#pragma unroll
        for (int a = 0; a < 2; ++a)
#pragma unroll
            for (int i2 = 0; i2 < 2; ++i2) { const int k0 = 16 * g + 8 * a + 4 * hh + 2 * i2;
                w[hh * 4 + a * 2 + i2] = (unsigned)col[(size_t)k0 * 168] | ((unsigned)col[(size_t)(k0 + 1) * 168] << 16); }
    bf16_t* vp = VTdst + (size_t)d * ldvt + 16 * g;
    *(u32x4*)vp = (u32x4){w[0], w[1], w[2], w[3]}; *(u32x4*)(vp + 8) = (u32x4){w[4], w[5], w[6], w[7]};
}

DI void p0_prologue(const Frame& F) {
    const int gw = F.bid * 8 + F.wave, NGW = F.G * 8, gt = F.bid * 512 + F.tid, NT = F.G * 512;
    { float* z = F.ssq(1); for (size_t i = gt; i < (size_t)(SQ_N - 1) * MT; i += NT) z[i] = 0.f; }
    for (int i = gt; i < 2048 * 16; i += NT) { const int pos = i >> 4, j = i & 15;
        const double inv = exp(-9.210340371976184 * (double)j / 16.0), ang = (double)pos * inv;
        const double kq = rint(ang * 0.15915494309189535), x = ang - kq * 6.283185307179586, x2 = x * x;
        double ts = x, sn = x, tc = 1.0, cs = 1.0;
        for (int n = 1; n <= 14; ++n) { tc *= -x2 / (double)((2 * n - 1) * (2 * n)); cs += tc; ts *= -x2 / (double)((2 * n) * (2 * n + 1)); sn += ts; }
        float* rt = (float*)(F.ws + WS_ROPE); rt[pos * 32 + j] = (float)cs; rt[pos * 32 + 16 + j] = (float)sn; }
    LAS float* scr = (LAS float*)(F.lds + F.wave * 16384);
    constexpr int I_IN = 16 * 64, I_GU = 16 * 176, I_DN = 44 * 32, I_OS = 16 * 32, I_QR = 4 * 8, I_L = I_IN + I_GU + I_DN + I_OS + I_QR;
    const int l31 = F.lane & 31;
    for (int it = gw; it < 2 * I_L; it += NGW) {
        const int l = it / I_L; int r = it % I_L;
        if (r < I_IN) { const int kb = r / 64, nb = r % 64; transpose_item(F.in[I_WIN] + (size_t)l * 1024 * 1960, 1960, src_col_in(nb * 32 + l31), F.in[I_NMIX] + l * 1024, 1.f, F.wt(l, WO_IN), 1024, nb * 32, kb * 64, scr, F.lane); continue; } r -= I_IN;
        if (r < I_GU) { const int kb = r / 176, nb = r % 176, n0 = nb * 32, j = n0 >> 8, rr = n0 & 255;
            transpose_item(F.in[rr < 128 ? I_WG : I_WU] + (size_t)l * 1024 * FF, FF, 128 * j + (rr & 127) + l31, F.in[I_NFFN] + l * 1024, 1.f, F.wt(l, WO_GU), 1024, n0, kb * 64, scr, F.lane); continue; } r -= I_GU;
        if (r < I_DN) { const int kb = r / 32, nb = r % 32; transpose_item(F.in[I_WD] + (size_t)l * FF * 1024, 1024, nb * 32 + l31, nullptr, 1.f, F.wt(l, WO_DN), FF, nb * 32, kb * 64, scr, F.lane); continue; } r -= I_DN;
        if (r < I_OS) { const int kb = r / 32, nb = r % 32; transpose_item(F.in[I_WOUT] + (size_t)l * 1024 * 1024, 1024, nb * 32 + l31, kb < 8 ? F.in[I_SSDN] + l * 512 : nullptr, 1.f, F.wt(l, WO_OUT), AOW, nb * 32, kb * 64, scr, F.lane); continue; } r -= I_OS;
        { const int kb = r / 8, h = r % 8; transpose_item(F.in[I_WUQ] + (size_t)l * 256 * 768, 768, h * 96 + 64 + l31, F.in[I_QN] + l * 256, QSCALE, F.wt(l, WO_Q), 256, 1024 + h * 32, kb * 64, scr, F.lane); }
    }
    for (int idx = gt; idx < 2 * 1024 * 256; idx += NT) { const int k = idx & 255, n = (idx >> 8) & 1023, l = idx >> 18, h = n >> 7, lq = n & 127;
        const float* uq = F.in[I_WUQ] + (size_t)l * 256 * 768 + (size_t)k * 768 + h * 96; const float* uk = F.in[I_WUK] + (size_t)l * 128 * 512 + lq * 512 + h * 64;
        float s = 0.f;
#pragma unroll
        for (int d4 = 0; d4 < 16; ++d4) { const f32x4 a = ((const f32x4*)uq)[d4], bq = ((const f32x4*)uk)[d4]; s += (a[0] * bq[0] + a[1] * bq[1]) + (a[2] * bq[2] + a[3] * bq[3]); }
        F.wt(l, WO_Q)[(size_t)n * 256 + k] = f2bf(s * F.in[I_QN][l * 256 + k] * QSCALE); }
    for (int idx = gt; idx < 2 * 8 * 64 * 128; idx += NT) { const int pos = idx & 127, dv = (idx >> 7) & 63, h = (idx >> 13) & 7, l = idx >> 16;
        const int G = pos >> 4, hh = (pos >> 3) & 1, a = (pos >> 2) & 1, i = pos & 3, d = 16 * G + 8 * a + 4 * hh + i;
        F.wt(l, WO_UV)[(size_t)(h * 64 + dv) * 128 + pos] = f2bf(F.in[I_WUV][(size_t)l * 128 * 512 + (size_t)d * 512 + h * 64 + dv]); }
    { float* sq = F.ssq(SQ_X0); bf16_t* XB = (bf16_t*)(F.ws + WS_XB);
      for (int row4 = gw * 4; row4 < MT; row4 += NGW * 4) {
        f32x4 v[4][4];
#pragma unroll
        for (int q = 0; q < 4; ++q) { const int row = row4 + q; const float* xr = row < MP ? F.in[I_XP] + (size_t)row * DM : F.in[I_XS] + (size_t)(row - MP) * DM;
#pragma unroll
            for (int j = 0; j < 4; ++j) v[q][j] = __builtin_nontemporal_load((const f32x4*)xr + F.lane + 64 * j); }
#pragma unroll
        for (int q = 0; q < 4; ++q) { const int row = row4 + q; float s = 0.f;
#pragma unroll
            for (int j = 0; j < 4; ++j) { s += dot4(v[q][j]); u32x2 w; w.x = cvtpk(v[q][j][0], v[q][j][1]); w.y = cvtpk(v[q][j][2], v[q][j][3]); ((u32x2*)(XB + (size_t)row * DM))[F.lane + 64 * j] = w; }
            s = wave_sum(s);
            if (F.lane == 0) sq[row] = s; } } }
    __syncthreads();
    for (int u = F.bid; u < 2 * 32 * 16; u += F.G) { const int l = u >> 9, b = (u >> 4) & 31, pb = u & 15;
        const int pos = F.tid >> 3, part = F.tid & 7; const size_t tok = ((size_t)(l * 32 + b) * 1024 + pb * 64 + pos);
        const f32x4* cs = (const f32x4*)(F.in[I_CCKV] + tok * 128 + part * 16); float v[16];
#pragma unroll
        for (int j = 0; j < 4; ++j) { const f32x4 t = cs[j]; v[4 * j] = t[0]; v[4 * j + 1] = t[1]; v[4 * j + 2] = t[2]; v[4 * j + 3] = t[3]; }
        lds_w16(F.lds + pos * 336 + part * 32, pack8(v)); lds_w16(F.lds + pos * 336 + part * 32 + 16, pack8(v + 8));
        const f32x4 kr = *(const f32x4*)(F.in[I_CKR] + tok * 32 + part * 4); u32x2 w; w.x = cvtpk(kr[0], kr[1]); w.y = cvtpk(kr[2], kr[3]);
        *(LAS u32x2*)(F.lds + pos * 336 + 256 + part * 8) = w;
        __syncthreads();
        kv_write_tile(F, (bf16_t*)(F.ws + WS_KS + l * KS_LAYER) + ((size_t)b * TKS + pb * 64) * 160, (bf16_t*)(F.ws + WS_VTS + l * VTS_LAYER) + (size_t)b * 128 * TKS + pb * 64, TKS);
        __syncthreads();
    }
}

DI void kvprep_unit(const Frame& F, int l, int u) {
    const bool smp = u >= 1024; const int b = smp ? u - 1024 : u >> 5, c = smp ? 0 : u & 31, T = smp ? 64 : 2048;
    const size_t row0 = smp ? (size_t)MP + b * 64 : (size_t)b * 2048 + c * 64;
    const bf16_t* PROJ = (const bf16_t*)(F.ws + WS_PROJ);
    int tid_ = threadIdx.x; asm volatile("" : "+v"(tid_));
    const int tk = tid_ >> 3, part = tid_ & 7, t = c * 64 + tk, pos = smp ? 1024 + t : t;
    const bf16_t* pr = PROJ + (row0 + tk) * NPROJ;
    float v[16]; { const u32x4 a = *(const u32x4*)(pr + C_CKV + part * 16), bb = *(const u32x4*)(pr + C_CKV + part * 16 + 8); unpack8(a, v); unpack8(bb, v + 8); }
    float s = 0.f;
#pragma unroll
    for (int i = 0; i < 16; ++i) s += v[i] * v[i];
    s += __shfl_xor(s, 1); s += __shfl_xor(s, 2); s += __shfl_xor(s, 4);
    const float rs = rsqrtf(s * (1.f / 128.f) + EPS); const float* gk = F.in[I_KVN] + l * 128 + part * 16;
#pragma unroll
    for (int i = 0; i < 16; ++i) v[i] = v[i] * rs * gk[i];
    float* ock = F.out + (smp ? O_CKVS + ((size_t)(l * 32 + b) * 64 + t) * 128 : O_CKVP + ((size_t)(l * 32 + b) * 2048 + t) * 128) + part * 16;
#pragma unroll
    for (int j = 0; j < 4; ++j) ((f32x4*)ock)[j] = (f32x4){v[4 * j], v[4 * j + 1], v[4 * j + 2], v[4 * j + 3]};
    lds_w16(F.lds + tk * 336 + part * 32, pack8(v)); lds_w16(F.lds + tk * 336 + part * 32 + 16, pack8(v + 8));
    { const unsigned w1 = *(const unsigned*)(pr + C_KR + 2 * part), w2 = *(const unsigned*)(pr + C_KR + 16 + 2 * part);
      const float* rt = (const float*)(F.ws + WS_ROPE) + pos * 32 + 2 * part;
      const float x1a = bflo(w1), x1b = bfhi(w1), x2a = bflo(w2), x2b = bfhi(w2), ca = rt[0], cb = rt[1], sa = rt[16], sb = rt[17];
      const float o1a = x1a * ca - x2a * sa, o1b = x1b * cb - x2b * sb, o2a = x1a * sa + x2a * ca, o2b = x1b * sb + x2b * cb;
      float* okr = F.out + (smp ? O_KRS + ((size_t)(l * 32 + b) * 64 + t) * 32 : O_KRP + ((size_t)(l * 32 + b) * 2048 + t) * 32);
      *(f32x2_t*)(okr + 2 * part) = (f32x2_t){o1a, o1b}; *(f32x2_t*)(okr + 16 + 2 * part) = (f32x2_t){o2a, o2b};
      *(LAS unsigned*)(F.lds + tk * 336 + 256 + 4 * part) = cvtpk(o1a, o1b); *(LAS unsigned*)(F.lds + tk * 336 + 256 + 32 + 4 * part) = cvtpk(o2a, o2b); }
    __syncthreads();
    if (smp) kv_write_tile(F, (bf16_t*)(F.ws + WS_KS + l * KS_LAYER) + ((size_t)b * TKS + 1024) * 160, (bf16_t*)(F.ws + WS_VTS + l * VTS_LAYER) + (size_t)b * 128 * TKS + 1024, TKS);
    else kv_write_tile(F, (bf16_t*)(F.ws + WS_KP) + ((size_t)b * TKP + c * 64) * 160, (bf16_t*)(F.ws + WS_VTP) + (size_t)b * 128 * TKP + c * 64, TKP);
    __syncthreads();
}

DI void conv_unit(const Frame& F, int l, int u) {
    int tid_ = threadIdx.x; asm volatile("" : "+v"(tid_));
    const int cg = tid_ & 127, rs = tid_ >> 7, ch = 8 * cg;
    const bool smp = u >= 1024; const int b = smp ? u - 1024 : u >> 5, c = smp ? 0 : u & 31;
    bf16_t* PROJ = (bf16_t*)(F.ws + WS_PROJ); const bf16_t* HALO = (const bf16_t*)(F.ws + WS_HALO);
    const size_t row0 = (size_t)u * 64;
    const int tk = tid_ >> 3, part = tid_ & 7, t = c * 64 + tk, pos = smp ? 1024 + t : t;
    const bf16_t* pr = PROJ + (row0 + tk) * NPROJ;
    const u32x4 kva = *(const u32x4*)(pr + C_CKV + part * 16), kvb = *(const u32x4*)(pr + C_CKV + part * 16 + 8);
    const unsigned kw1 = *(const unsigned*)(pr + C_KR + 2 * part), kw2 = *(const unsigned*)(pr + C_KR + 16 + 2 * part);
    u32x4 uu[19];
#pragma unroll
    for (int i = 0; i < 19; ++i) { const int lr = 16 * rs - 3 + i;
        if (lr >= 0) uu[i] = *(const u32x4*)(PROJ + (row0 + lr) * NPROJ + C_XBC + ch);
        else if (c != 0) uu[i] = *(const u32x4*)(HALO + ((size_t)(u - 1) * 3 + (lr + 3)) * 1024 + ch);
        else if (!smp) uu[i] = (u32x4){0u, 0u, 0u, 0u};
        else { const float* sc = F.in[I_CONV] + ((size_t)(l * 32 + b) * 3 + (lr + 3)) * 1024 + ch; float t8[8];
#pragma unroll
            for (int e = 0; e < 8; ++e) t8[e] = sc[e];
            uu[i] = pack8(t8); } }
    if (smp || c == 31) { if (tid_ < 384) { const int k = tid_ >> 7; float t8[8]; unpack8(*(const u32x4*)(HALO + ((size_t)u * 3 + k) * 1024 + ch), t8);
        float* oc = F.out + (smp ? O_CONVS : O_CONVP) + ((size_t)(l * 32 + b) * 3 + k) * 1024 + ch;
        *(f32x4*)oc = (f32x4){t8[0], t8[1], t8[2], t8[3]}; *(f32x4*)(oc + 4) = (f32x4){t8[4], t8[5], t8[6], t8[7]}; } }
    asm volatile("s_waitcnt vmcnt(0)" ::: "memory"); __syncthreads();
    { float v[16]; unpack8(kva, v); unpack8(kvb, v + 8);
      float s = 0.f;
#pragma unroll
      for (int i = 0; i < 16; ++i) s += v[i] * v[i];
      s += __shfl_xor(s, 1); s += __shfl_xor(s, 2); s += __shfl_xor(s, 4);
      const float rsn = rsqrtf(s * (1.f / 128.f) + EPS); const float* gk = F.in[I_KVN] + l * 128 + part * 16;
#pragma unroll
      for (int i = 0; i < 16; ++i) v[i] = v[i] * rsn * gk[i];
      float* ock = F.out + (smp ? O_CKVS + ((size_t)(l * 32 + b) * 64 + t) * 128 : O_CKVP + ((size_t)(l * 32 + b) * 2048 + t) * 128) + part * 16;
#pragma unroll
      for (int j = 0; j < 4; ++j) ((f32x4*)ock)[j] = (f32x4){v[4 * j], v[4 * j + 1], v[4 * j + 2], v[4 * j + 3]};
      lds_w16(F.lds + tk * 336 + part * 32, pack8(v)); lds_w16(F.lds + tk * 336 + part * 32 + 16, pack8(v + 8));
      const float* rt = (const float*)(F.ws + WS_ROPE) + pos * 32 + 2 * part;
      const float x1a = bflo(kw1), x1b = bfhi(kw1), x2a = bflo(kw2), x2b = bfhi(kw2), ca = rt[0], cb2 = rt[1], sa = rt[16], sb = rt[17];
      const float o1a = x1a * ca - x2a * sa, o1b = x1b * cb2 - x2b * sb, o2a = x1a * sa + x2a * ca, o2b = x1b * sb + x2b * cb2;
      float* okr = F.out + (smp ? O_KRS + ((size_t)(l * 32 + b) * 64 + t) * 32 : O_KRP + ((size_t)(l * 32 + b) * 2048 + t) * 32);
      *(f32x2_t*)(okr + 2 * part) = (f32x2_t){o1a, o1b}; *(f32x2_t*)(okr + 16 + 2 * part) = (f32x2_t){o2a, o2b};
      *(LAS unsigned*)(F.lds + tk * 336 + 256 + 4 * part) = cvtpk(o1a, o1b); *(LAS unsigned*)(F.lds + tk * 336 + 256 + 32 + 4 * part) = cvtpk(o2a, o2b); }
    const float* cw = F.in[I_CW] + (size_t)l * 4 * 1024 + ch; const float* cb = F.in[I_CB] + l * 1024 + ch;
#pragma unroll
    for (int half = 0; half < 2; ++half) {
        unsigned rowpk[8][4];
#pragma unroll
        for (int e2 = 0; e2 < 4; ++e2) {
            float oo[2][8];
#pragma unroll
            for (int q = 0; q < 2; ++q) { const int e = 2 * e2 + q; const float w0 = cw[e], w1 = cw[1024 + e], w2 = cw[2048 + e], w3 = cw[3072 + e], bs = cb[e];
#pragma unroll
                for (int i = 0; i < 8; ++i) { const int ii = 8 * half + i;
                    const float a0 = q ? bfhi(uu[ii][e2]) : bflo(uu[ii][e2]), a1 = q ? bfhi(uu[ii + 1][e2]) : bflo(uu[ii + 1][e2]), a2 = q ? bfhi(uu[ii + 2][e2]) : bflo(uu[ii + 2][e2]), a3 = q ? bfhi(uu[ii + 3][e2]) : bflo(uu[ii + 3][e2]);
                    const float v = bs + w0 * a0 + w1 * a1 + w2 * a2 + w3 * a3; oo[q][i] = v * sigmoidf_(v); } }
#pragma unroll
            for (int i = 0; i < 8; ++i) rowpk[i][e2] = cvtpk(oo[0][i], oo[1][i]);
        }
#pragma unroll
        for (int i = 0; i < 8; ++i) *(u32x4*)(PROJ + (row0 + 16 * rs + 8 * half + i) * NPROJ + C_XBC + ch) = (u32x4){rowpk[i][0], rowpk[i][1], rowpk[i][2], rowpk[i][3]};
        if (half == 0) {
            __syncthreads();
            if (smp) kv_write_tile(F, (bf16_t*)(F.ws + WS_KS + l * KS_LAYER) + ((size_t)b * TKS + 1024) * 160, (bf16_t*)(F.ws + WS_VTS + l * VTS_LAYER) + (size_t)b * 128 * TKS + 1024, TKS);
            else kv_write_tile(F, (bf16_t*)(F.ws + WS_KP) + ((size_t)b * TKP + c * 64) * 160, (bf16_t*)(F.ws + WS_VTP) + (size_t)b * 128 * TKP + c * 64, TKP);
        }
    }
    asm volatile("s_waitcnt vmcnt(0)" ::: "memory"); __syncthreads();
}

DI void ssd_unit(const Frame& F, int l, int kind, int b, int hd, bool do_ssq = true) {
    int tid_ = threadIdx.x; asm volatile("" : "+v"(tid_));
    const int tid = tid_, lane = tid & 63, w = F.wave, r = lane & 31, hi = lane >> 5, g = hd >> 2;
    const int nch = kind == 0 ? 32 : 1;
    const size_t rowbase = kind == 0 ? (size_t)b * 2048 : (size_t)MP + b * 64;
    const bf16_t* PROJ = (const bf16_t*)(F.ws + WS_PROJ); bf16_t* AO = (bf16_t*)(F.ws + WS_AO);
    ldsp L = F.lds;
    constexpr int O_CS = 0, O_BS = 17408, O_BWT = 34816, O_XT = 53248, O_XS = 62464, O_WS = 71680, O_HS = 80896, O_YS = 98304, O_DT = 115712, O_CUM = 116224, O_XS2 = 116736;
    LAS float* dtS = (LAS float*)(L + O_DT); LAS float* cumS = (LAS float*)(L + O_CUM); LAS float* Ys = (LAS float*)(L + O_YS);
    const float Dsk = F.in[I_DSKIP][l * 8 + hd], dtb = F.in[I_DTB][l * 8 + hd], Aneg = -__expf(F.in[I_ALOG][l * 8 + hd]);
    const int pbh = w >> 2, nbh = w & 3;
    f32x16 hacc;
    float* hout = F.out + (kind == 0 ? O_SSMP : O_SSMS) + (size_t)((l * 32 + b) * 8 + hd) * 8192;
    if (kind == 0) {
#pragma unroll
        for (int i = 0; i < 16; ++i) hacc[i] = 0.f;
    } else { const float* h0 = F.in[I_SSM] + (size_t)((l * 32 + b) * 8 + hd) * 8192;
#pragma unroll
        for (int i = 0; i < 16; ++i) hacc[i] = h0[(32 * pbh + crow(i, hi)) * 128 + 32 * nbh + r]; }
#pragma unroll
    for (int i = 0; i < 16; ++i) *(LAS bf16_t*)(L + O_HS + (32 * pbh + crow(i, hi)) * 272 + (32 * nbh + r) * 2) = f2bf(hacc[i]);
    const int lbA = (w & 3) >> 1, sbA = w & 1;
    u32x4 uu[8]; float dtr_n = 0.f;
#define SSD_LOAD_UU(cc) do { const size_t row0_ = rowbase + 64 * (cc); const int cgl = tid >> 3, rsl = tid & 7; \
        const int chl = cgl < 8 ? hd * 64 + 8 * cgl : cgl < 24 ? 512 + g * 128 + 8 * (cgl - 8) : 768 + g * 128 + 8 * (cgl - 24); \
        if (tid < 320) { _Pragma("unroll") for (int i = 0; i < 8; ++i) uu[i] = *(const u32x4*)(PROJ + (row0_ + 8 * rsl + i) * NPROJ + C_XBC + chl); } } while (0)
#define SSD_SCAN(cc) do { const float dtr = dtr_n + dtb; const float dt = dtr > 20.f ? dtr : log1pf(__expf(dtr)); float a = dt * Aneg; \
        _Pragma("unroll") for (int off = 1; off < 64; off <<= 1) { const float t = __shfl_up(a, off); if (lane >= off) a += t; } \
        dtS[((cc) & 1) * 64 + lane] = dt; cumS[((cc) & 1) * 64 + lane] = a; } while (0)
#define SSD_EPI(row0e, xsoff) do { const int el = tid >> 3, pg = tid & 7; const size_t row = (row0e) + el; \
        const f32x4 y0 = *(const LAS f32x4*)(Ys + el * 68 + 8 * pg), y1 = *(const LAS f32x4*)(Ys + el * 68 + 8 * pg + 4); \
        float xv[8], zv[8], ov[8]; \
        unpack8(*(const LAS u32x4*)(L + (xsoff) + el * 144 + pg * 16), xv); unpack8(zk, zv); \
        float s = 0.f; \
        _Pragma("unroll") for (int e = 0; e < 8; ++e) { const float y = (e < 4 ? y0[e & 3] : y1[e & 3]) + Dsk * xv[e]; ov[e] = y * zv[e] * sigmoidf_(zv[e]); s += ov[e] * ov[e]; } \
        *(u32x4*)(AO + row * AOW + hd * 64 + 8 * pg) = pack8(ov); \
        s += __shfl_xor(s, 1); s += __shfl_xor(s, 2); s += __shfl_xor(s, 4); \
        if (pg == 0 && do_ssq) unsafeAtomicAdd(F.ssq(SQ_SSD0 + l) + row, s); } while (0)
    SSD_LOAD_UU(0);
    if (w == 7) { dtr_n = bf2f(PROJ[(rowbase + lane) * NPROJ + C_DT + hd]); SSD_SCAN(0); if (nch > 1) dtr_n = bf2f(PROJ[(rowbase + 64 + lane) * NPROJ + C_DT + hd]); }
    u32x4 zk = (u32x4){0u, 0u, 0u, 0u};
    __syncthreads();
    for (int c = 0; c < nch; ++c) {
        const size_t row0 = rowbase + 64 * c;
        int tl_ = threadIdx.x; asm volatile("" : "+v"(tl_));
        const int tid = tl_, lane = tid & 63, r = lane & 31, hi = lane >> 5;
        const int cg_ = tid >> 3, rs_ = tid & 7;
        const LAS float* dtC = dtS + (c & 1) * 64; const LAS float* cumC = cumS + (c & 1) * 64;
        const int xsC = (c & 1) ? O_XS2 : O_XS;
        if (c > 0) {
#pragma unroll
            for (int i = 0; i < 16; ++i) *(LAS bf16_t*)(L + O_HS + (32 * pbh + crow(i, hi)) * 272 + (32 * nbh + r) * 2) = f2bf(hacc[i]);
            SSD_EPI(row0 - 64, (c & 1) ? O_XS : O_XS2);
        }
        zk = *(const u32x4*)(PROJ + (row0 + (tid >> 3)) * NPROJ + C_Z + hd * 64 + 8 * (tid & 7));
        if (w == 7 && c + 1 < nch) { SSD_SCAN(c + 1); if (c + 2 < nch) dtr_n = bf2f(PROJ[(row0 + 128 + lane) * NPROJ + C_DT + hd]); }
        if (tid < 320) {
            const int l0 = 8 * rs_;
            const bool isB = cg_ >= 8 && cg_ < 24;
            float we[8];
            { const float last = cumC[63];
#pragma unroll
              for (int i = 0; i < 8; ++i) we[i] = isB ? __expf(last - cumC[l0 + i]) * dtC[l0 + i] : 1.f; }
            const ldsp tdst = cg_ < 8 ? L + O_XT + (8 * cg_) * 144 + l0 * 2 : L + O_BWT + (8 * (cg_ - 8)) * 144 + l0 * 2;
            const ldsp rdst = cg_ < 8 ? L + xsC + l0 * 144 + cg_ * 16 : isB ? L + O_BS + l0 * 272 + (cg_ - 8) * 16 : L + O_CS + l0 * 272 + (cg_ - 24) * 16;
            const int rstride = cg_ < 8 ? 144 : 272;
#pragma unroll
            for (int i = 0; i < 8; ++i) lds_w16(rdst + i * rstride, uu[i]);
            if (cg_ < 24) {
#pragma unroll
                for (int e2 = 0; e2 < 4; ++e2)
#pragma unroll
                    for (int q = 0; q < 2; ++q) { float t8[8];
#pragma unroll
                        for (int i = 0; i < 8; ++i) t8[i] = (q ? bfhi(uu[i][e2]) : bflo(uu[i][e2])) * we[i];
                        lds_w16(tdst + (2 * e2 + q) * 144, pack8(t8)); }
            }
        }
        if (c + 1 < nch) SSD_LOAD_UU(c + 1);
        __syncthreads();
        f32x16 accy;
#pragma unroll
        for (int i = 0; i < 16; ++i) accy[i] = 0.f;
        if (w < 4) {
            if (sbA <= lbA) {
#pragma unroll
                for (int ks = 0; ks < 8; ++ks) { const bf16x8 a = lds_r16(L + O_CS + (32 * lbA + r) * 272 + (16 * ks + 8 * hi) * 2), bb = lds_r16(L + O_BS + (32 * sbA + r) * 272 + (16 * ks + 8 * hi) * 2); accy = MFMA32(a, bb, accy); }
            }
            const int s = 32 * sbA + r; const float cs = cumC[s], ds = dtC[s];
#pragma unroll
            for (int i = 0; i < 16; ++i) { const int ll = 32 * lbA + crow(i, hi); const float val = s <= ll ? __expf(cumC[ll] - cs) * accy[i] * ds : 0.f;
                *(LAS bf16_t*)(L + O_WS + ll * 144 + s * 2) = f2bf(val); }
        } else {
#pragma unroll
            for (int ks = 0; ks < 8; ++ks) { const bf16x8 a = lds_r16(L + O_CS + (32 * lbA + r) * 272 + (16 * ks + 8 * hi) * 2), bb = lds_r16(L + O_HS + (32 * sbA + r) * 272 + (16 * ks + 8 * hi) * 2); accy = MFMA32(a, bb, accy); }
#pragma unroll
            for (int i = 0; i < 16; ++i) accy[i] *= __expf(cumC[32 * lbA + crow(i, hi)]);
        }
        __syncthreads();
        if (w >= 4) {
#pragma unroll
            for (int ks = 0; ks < 4; ++ks) { const bf16x8 a = lds_r16(L + O_WS + (32 * lbA + r) * 144 + (16 * ks + 8 * hi) * 2), bb = lds_r16(L + O_XT + (32 * sbA + r) * 144 + (16 * ks + 8 * hi) * 2); accy = MFMA32(a, bb, accy); }
#pragma unroll
            for (int i = 0; i < 16; ++i) Ys[(32 * lbA + crow(i, hi)) * 68 + 32 * sbA + r] = accy[i];
        }
        { const float el = __expf(cumC[63]);
#pragma unroll
          for (int i = 0; i < 16; ++i) hacc[i] *= el;
#pragma unroll
          for (int ks = 0; ks < 4; ++ks) { const bf16x8 a = lds_r16(L + O_XT + (32 * pbh + r) * 144 + (16 * ks + 8 * hi) * 2), bb = lds_r16(L + O_BWT + (32 * nbh + r) * 144 + (16 * ks + 8 * hi) * 2); hacc = MFMA32(a, bb, hacc); } }
        __syncthreads();
    }
    SSD_EPI(rowbase + 64 * (nch - 1), ((nch - 1) & 1) ? O_XS2 : O_XS);
    __syncthreads();
#undef SSD_EPI
#undef SSD_LOAD_UU
#undef SSD_SCAN
#pragma unroll
    for (int i = 0; i < 16; ++i) hout[(32 * pbh + crow(i, hi)) * 128 + 32 * nbh + r] = hacc[i];
}

DI void attn_unit(const Frame& F, int l, int kind, int b, int c, int hf) {
    int tid_ = threadIdx.x; asm volatile("" : "+v"(tid_));
    const int tid = tid_, lane = tid & 63, w = F.wave, r = lane & 31, hi = lane >> 5;
    size_t rowq0; int nt, ldvt; const bf16_t* Kb; const bf16_t* VTb;
    if (kind == 0) { rowq0 = (size_t)b * 2048 + 64 * c + 32 * hf; nt = c + 1; ldvt = TKP; Kb = (const bf16_t*)(F.ws + WS_KP) + (size_t)b * TKP * 160; VTb = (const bf16_t*)(F.ws + WS_VTP) + (size_t)b * 128 * TKP; }
    else { rowq0 = (size_t)MP + b * 64 + 32 * hf; nt = 17; ldvt = TKS; Kb = (const bf16_t*)(F.ws + WS_KS + l * KS_LAYER) + (size_t)b * TKS * 160; VTb = (const bf16_t*)(F.ws + WS_VTS + l * VTS_LAYER) + (size_t)b * 128 * TKS; }
    ldsp L = F.lds;
    constexpr int KTB = 21504, VTB = 18432, O_K = 0, O_V = 3 * KTB;
    const bf16_t* qrow = (const bf16_t*)(F.ws + WS_Q) + (rowq0 + r) * QW;
    bf16x8 qf[10];
#pragma unroll
    for (int ks = 0; ks < 8; ++ks) qf[ks] = *(const bf16x8*)(qrow + w * 128 + 16 * ks + 8 * hi);
#pragma unroll
    for (int ks = 0; ks < 2; ++ks) qf[8 + ks] = *(const bf16x8*)(qrow + 1024 + w * 32 + 16 * ks + 8 * hi);
    unsigned goff[5];
#pragma unroll
    for (int i = 0; i < 5; ++i) { const int ci = w + 8 * i;
        if (ci < 21) { const int o = ci * 1024 + 16 * lane, row = o / 336; int cb = o % 336; if (cb >= 320) cb = 0; goff[i] = (unsigned)(row * 160 + (cb >> 1)); }
        else { const int o = (ci - 21) * 1024 + 16 * lane, d = o / 144; int cb = o % 144; if (cb >= 128) cb = 0; goff[i] = (unsigned)(d * ldvt + (cb >> 1)); } }
#define ATT_DMA(j, kbuf, vbuf) do { _Pragma("unroll") for (int i = 0; i < 5; ++i) { const int ci = w + 8 * i; \
        if (ci < 21) __builtin_amdgcn_global_load_lds((const unsigned*)(Kb + (size_t)(j) * 64 * 160 + goff[i]), (LAS unsigned*)(L + O_K + (kbuf) * KTB + ci * 1024), 16, 0, 0); \
        else if (ci < 39) __builtin_amdgcn_global_load_lds((const unsigned*)(VTb + (size_t)(j) * 64 + goff[i]), (LAS unsigned*)(L + O_V + (vbuf) * VTB + (ci - 21) * 1024), 16, 0, 0); } } while (0)
    ATT_DMA(0, 0, 0);
    if (nt > 1) ATT_DMA(1, 1, 1);
    f32x16 o[4];
#pragma unroll
    for (int d = 0; d < 4; ++d)
#pragma unroll
        for (int i = 0; i < 16; ++i) o[d][i] = 0.f;
    float mhat = 0.f, lsum = 0.f; f32x16 negm;
#pragma unroll
    for (int i = 0; i < 16; ++i) negm[i] = 0.f;
    f32x16 p0, p1; bf16x8 pb[4];
#define ATT_QK(kbuf) do { const ldsp kb_ = L + O_K + (kbuf) * KTB + r * 336 + 16 * hi; bf16x8 kf[6]; \
        _Pragma("unroll") for (int ks = 0; ks < 3; ++ks) { kf[2 * ks] = lds_r16(kb_ + 32 * ks); kf[2 * ks + 1] = lds_r16(kb_ + 32 * 336 + 32 * ks); } \
        __builtin_amdgcn_sched_barrier(0); \
        _Pragma("unroll") for (int ks = 0; ks < 10; ++ks) { const int sl = ks % 3; \
            if (ks == 0) { p0 = MFMA32(kf[0], qf[0], negm); p1 = MFMA32(kf[1], qf[0], negm); } \
            else { p0 = MFMA32(kf[2 * sl], qf[ks], p0); p1 = MFMA32(kf[2 * sl + 1], qf[ks], p1); } \
            if (ks + 3 < 10) { kf[2 * sl] = lds_r16(kb_ + 32 * (ks + 3)); kf[2 * sl + 1] = lds_r16(kb_ + 32 * 336 + 32 * (ks + 3)); } \
            __builtin_amdgcn_sched_barrier(0); } } while (0)
#define MX3(a, b, c) __builtin_fmaxf(__builtin_fmaxf((a), (b)), (c))
#define ATT_SM() do { float mx = MX3(p0[0], p0[1], p1[0]), mx2 = MX3(p1[1], p0[2], p1[2]); \
        _Pragma("unroll") for (int i = 3; i < 15; i += 2) { mx = MX3(mx, p0[i], p1[i]); mx2 = MX3(mx2, p0[i + 1], p1[i + 1]); } \
        mx = MX3(mx, mx2, p0[15]); mx = fmaxf(mx, p1[15]); \
        mx = fmaxf(mx, __shfl_xor(mx, 32)); \
          \
        if (__builtin_amdgcn_ballot_w64(mx > thr_) != 0ull) { const float dl = fmaxf(mx, flr_); mhat += dl; \
            _Pragma("unroll") for (int i = 0; i < 16; ++i) { p0[i] -= dl; p1[i] -= dl; } \
            _Pragma("unroll") for (int i = 0; i < 16; ++i) negm[i] = -mhat; \
            const float alpha = __builtin_amdgcn_exp2f(fminf(-dl, 60.f)); lsum *= alpha; \
            _Pragma("unroll") for (int d = 0; d < 4; ++d) _Pragma("unroll") for (int i = 0; i < 16; ++i) o[d][i] *= alpha; } \
        float ps = 0.f, ps2 = 0.f; \
        _Pragma("unroll") for (int i = 0; i < 16; ++i) { p0[i] = __builtin_amdgcn_exp2f(p0[i]); p1[i] = __builtin_amdgcn_exp2f(p1[i]); ps += p0[i]; ps2 += p1[i]; } \
        lsum += ps + ps2; \
        _Pragma("unroll") for (int kk = 0; kk < 2; ++kk) { u32x4 t; t.x = cvtpk(p0[8 * kk], p0[8 * kk + 1]); t.y = cvtpk(p0[8 * kk + 2], p0[8 * kk + 3]); t.z = cvtpk(p0[8 * kk + 4], p0[8 * kk + 5]); t.w = cvtpk(p0[8 * kk + 6], p0[8 * kk + 7]); pb[kk] = __builtin_bit_cast(bf16x8, t); \
            t.x = cvtpk(p1[8 * kk], p1[8 * kk + 1]); t.y = cvtpk(p1[8 * kk + 2], p1[8 * kk + 3]); t.z = cvtpk(p1[8 * kk + 4], p1[8 * kk + 5]); t.w = cvtpk(p1[8 * kk + 6], p1[8 * kk + 7]); pb[2 + kk] = __builtin_bit_cast(bf16x8, t); } } while (0)
#define ATT_PV(vbuf) do { const ldsp vb_ = L + O_V + (vbuf) * VTB + r * 144 + 16 * hi; bf16x8 vf[8]; \
        _Pragma("unroll") for (int q = 0; q < 2; ++q) _Pragma("unroll") for (int d = 0; d < 4; ++d) vf[4 * q + d] = lds_r16(vb_ + d * 32 * 144 + q * 32); \
        __builtin_amdgcn_sched_barrier(0); \
        _Pragma("unroll") for (int q = 0; q < 4; ++q) { _Pragma("unroll") for (int d = 0; d < 4; ++d) o[d] = MFMA32(vf[4 * (q & 1) + d], pb[q], o[d]); \
            if (q + 2 < 4) { _Pragma("unroll") for (int d = 0; d < 4; ++d) vf[4 * (q & 1) + d] = lds_r16(vb_ + d * 32 * 144 + (q + 2) * 32); } \
            __builtin_amdgcn_sched_barrier(0); } } while (0)
    asm volatile("s_waitcnt vmcnt(0)\n\ts_barrier" ::: "memory");
    int st = 0;
    for (int j = 0; j < nt; ++j) {
        const int st2 = st == 0 ? 2 : st - 1;
        if (j + 2 < nt) ATT_DMA(j + 2, st2, st2);
        int jz = j; asm volatile("" : "+s"(jz));
        const float thr_ = jz ? 8.f : -3e38f, flr_ = jz ? 0.f : -3e38f;
        ATT_QK(st); ATT_SM(); ATT_PV(st);
        if (j + 2 < nt) { if (w < 7) asm volatile("s_waitcnt vmcnt(5)\n\ts_barrier" ::: "memory"); else asm volatile("s_waitcnt vmcnt(4)\n\ts_barrier" ::: "memory"); }
        else asm volatile("s_waitcnt vmcnt(0)\n\ts_barrier" ::: "memory");
        st = st == 2 ? 0 : st + 1;
    }
#undef ATT_DMA
#undef ATT_QK
#undef ATT_SM
#undef MX3
#undef ATT_PV
    lsum += __shfl_xor(lsum, 32);
    const size_t row = rowq0 + r;
    const float inv = __builtin_amdgcn_rcpf(lsum);
    bf16x8 ob[8];
#pragma unroll
    for (int d = 0; d < 4; ++d)
#pragma unroll
        for (int kk = 0; kk < 2; ++kk) { u32x4 t; t.x = cvtpk(o[d][8 * kk] * inv, o[d][8 * kk + 1] * inv); t.y = cvtpk(o[d][8 * kk + 2] * inv, o[d][8 * kk + 3] * inv); t.z = cvtpk(o[d][8 * kk + 4] * inv, o[d][8 * kk + 5] * inv); t.w = cvtpk(o[d][8 * kk + 6] * inv, o[d][8 * kk + 7] * inv); ob[2 * d + kk] = __builtin_bit_cast(bf16x8, t); }
    const bf16_t* wuv = F.wt(l, WO_UV) + (size_t)(w * 64 + r) * 128 + 8 * hi;
    f32x16 D0, D1;
#pragma unroll
    for (int i = 0; i < 16; ++i) { D0[i] = 0.f; D1[i] = 0.f; }
#pragma unroll
    for (int s8 = 0; s8 < 8; ++s8) { const bf16x8 a0 = *(const bf16x8*)(wuv + 16 * s8), a1 = *(const bf16x8*)(wuv + 32 * 128 + 16 * s8); D0 = MFMA32(a0, ob[s8], D0); D1 = MFMA32(a1, ob[s8], D1); }
    const float fac = sqrtf(F.ssq(SQ_SSD0 + l)[row] * (1.f / 512.f) + EPS);
    bf16_t* orow = (bf16_t*)(F.ws + WS_AO) + row * AOW + 512 + w * 64 + 4 * hi;
#pragma unroll
    for (int q = 0; q < 4; ++q) { u32x2 t; t.x = cvtpk(D0[4 * q] * fac, D0[4 * q + 1] * fac); t.y = cvtpk(D0[4 * q + 2] * fac, D0[4 * q + 3] * fac); *(u32x2*)(orow + 8 * q) = t;
        t.x = cvtpk(D1[4 * q] * fac, D1[4 * q + 1] * fac); t.y = cvtpk(D1[4 * q + 2] * fac, D1[4 * q + 3] * fac); *(u32x2*)(orow + 32 + 8 * q) = t; }
}

#define XB_TMO      128
#define XB_XCNT(j)  (256  + 64 * (j))
#define XB_XSUB(j)  (1280 + 64 * (j))
#define XB_XGEN(j)  (2304 + 64 * (j))
#define XB_TOP      3328
#define XB_TOPGEN   3392
#define XCD_BAR_WORDS 3456
#define XB_SPIN_CAP (1u << 20)
DI unsigned xb_ld(unsigned* p)              { return __hip_atomic_load(p, __ATOMIC_RELAXED, __HIP_MEMORY_SCOPE_AGENT); }
DI unsigned xb_add(unsigned* p, unsigned v) { return __hip_atomic_fetch_add(p, v, __ATOMIC_RELAXED, __HIP_MEMORY_SCOPE_AGENT); }
DI unsigned xb_xcc_id() { return (unsigned)__builtin_amdgcn_s_getreg((3 << 11) | 20) & 0xFu; }
#define XB_SPIN(cond, bar) do { unsigned _sp = 0; while (cond) { __builtin_amdgcn_s_sleep(1); \
    if ((++_sp & 255u) == 0u) { if (xb_ld(&(bar)[XB_TMO])) break; if (_sp > XB_SPIN_CAP) { atomicAdd(&(bar)[XB_TMO], 1u); break; } } } } while (0)
struct XcdBarrier { unsigned* bar; unsigned x; volatile LAS unsigned* st; };
DI XcdBarrier xcd_barrier_post(unsigned* bar, volatile LAS unsigned* st) {
    XcdBarrier b; b.bar = bar; b.x = xb_xcc_id(); b.st = st;
    if (threadIdx.x == 0) (void)xb_add(&bar[XB_XCNT(b.x)], 1u);
    return b;
}
DI void xcd_barrier_complete(unsigned* bar, unsigned x, unsigned& nloc, unsigned& nx) {
    const unsigned G = gridDim.x * gridDim.y * gridDim.z;
    unsigned sum, cnt, mine, sp = 0u;
    for (;;) {
        sum = 0u; cnt = 0u; mine = 0u;
#pragma unroll
        for (unsigned j = 0; j < 16; ++j) { const unsigned c = xb_ld(&bar[XB_XCNT(j)]); sum += c; cnt += (c > 0u) ? 1u : 0u; mine = (j == x) ? c : mine; }
        if (sum == G) break;
        __builtin_amdgcn_s_sleep(1);
        if ((++sp & 255u) == 0u) { if (xb_ld(&bar[XB_TMO])) break; if (sp > XB_SPIN_CAP) { atomicAdd(&bar[XB_TMO], 1u); break; } }
    }
    nloc = mine > 0u ? mine : 1u; nx = cnt > 0u ? cnt : 1u;
}
DI void xcd_barrier(const XcdBarrier& b) {
    asm volatile("s_waitcnt vmcnt(0)" ::: "memory");
    __syncthreads();
    if (threadIdx.x == 0) {
        unsigned* bar = b.bar;
        __builtin_amdgcn_s_waitcnt(0);
        unsigned nloc = b.st[0], nx = b.st[1];
        if (nloc == 0u) { xcd_barrier_complete(bar, b.x, nloc, nx); b.st[0] = nloc; b.st[1] = nx; }
        const unsigned old = xb_add(&bar[XB_XSUB(b.x)], 1u);
        const unsigned gen = old / nloc;
        if (old + 1u == (gen + 1u) * nloc) {
            __builtin_amdgcn_fence(__ATOMIC_RELEASE, "agent");
            asm volatile("s_waitcnt vmcnt(0)" ::: "memory");
            const unsigned og = xb_add(&bar[XB_TOP], 1u);
            const unsigned tg = og / nx;
            if (og + 1u == (tg + 1u) * nx) xb_add(&bar[XB_TOPGEN], 1u);
            else XB_SPIN(xb_ld(&bar[XB_TOPGEN]) == tg, bar);
            __builtin_amdgcn_fence(__ATOMIC_ACQUIRE, "agent");
            xb_add(&bar[XB_XGEN(b.x)], 1u);
            asm volatile("s_waitcnt vmcnt(0)" ::: "memory");
        } else {
            XB_SPIN(xb_ld(&bar[XB_XGEN(b.x)]) == gen, bar);
            __builtin_amdgcn_fence(__ATOMIC_ACQUIRE, "agent");
            asm volatile("s_waitcnt vmcnt(0)" ::: "memory");
        }
    }
    __syncthreads();
}

__global__ void __launch_bounds__(512, 2) mk_fwd(Args args) {
    extern __shared__ __attribute__((aligned(16))) unsigned char lds_raw[];
    Frame F;
    F.lds = (ldsp)lds_raw; F.tid = threadIdx.x; F.lane = F.tid & 63; F.wave = __builtin_amdgcn_readfirstlane(F.tid >> 6); F.G = gridDim.x; F.bid = blockIdx.x;
    F.in = args.in; F.out = args.out; F.ws = args.ws;
    cg::grid_group grid = cg::this_grid();
    volatile LAS unsigned* MISC = (volatile LAS unsigned*)(F.lds + 131072 + 512);
    if (threadIdx.x < 4) MISC[threadIdx.x] = 0u;
    __syncthreads();
    XcdBarrier xbar = xcd_barrier_post((unsigned*)F.ws, MISC);
    const int lo = args.ph_lo, hi = args.ph_hi;
#define IN(k) (lo <= (k) && (k) < hi)
#define SEAM(k) do { if (IN(k) && IN((k) + 1)) { if (lo < 0) grid.sync(); else xcd_barrier(xbar); } } while (0)
    bf16_t* XB = (bf16_t*)(F.ws + WS_XB); bf16_t* AO = (bf16_t*)(F.ws + WS_AO); bf16_t* PROJ = (bf16_t*)(F.ws + WS_PROJ); bf16_t* Qb = (bf16_t*)(F.ws + WS_Q); bf16_t* Hb = (bf16_t*)(F.ws + WS_H);
    float* XR = F.out;

    if (IN(0)) { p0_prologue(F); }
    SEAM(0);
#ifdef PROBE_SYNC
    for (int i = 0; i < 20; ++i) grid.sync();
#endif
#ifdef PROBE_P0
    if (IN(0)) { p0_prologue(F); } grid.sync();
#endif
    for (int l = 0; l < 2; ++l) {
        const int p = 1 + 7 * l;
        { int t_ = threadIdx.x; asm volatile("" : "+v"(t_)); F.tid = t_; F.lane = t_ & 63; }
        if (IN(p)) {
            pg8::Gemm g{XB, F.wt(l, WO_IN), MT, NPROJ, DM, DM, DM}; pg8::StaticOrder S; S.init(MT, NPROJ, F.G, F.bid);
            EpiInproj E{PROJ, F.ssq(l == 0 ? SQ_X0 : SQ_X1), F.ssq(SQ_Q0 + l), (bf16_t*)(F.ws + WS_HALO)};
            pg8::gemm_phase<EpiInproj, true>(F.lds, g, S, E);
        }
        SEAM(p);
        if (IN(p + 1)) {
            for (int u = (F.bid + F.G / 2) % F.G; u < 1056; u += F.G) conv_unit(F, l, u);
            asm volatile("s_waitcnt vmcnt(0) lgkmcnt(0)" ::: "memory"); __syncthreads();
            pg8::Gemm g{PROJ + C_CQ, F.wt(l, WO_Q), MT, QW, 256, NPROJ, 256}; pg8::StaticOrder S; S.init(MT, QW, F.G, F.bid);
            EpiQ E{Qb, F.ssq(SQ_Q0 + l), (const float*)(F.ws + WS_ROPE)};
            pg8::gemm_phase<EpiQ, true>(F.lds, g, S, E);
        }
        SEAM(p + 1);
        if (IN(p + 2)) {
            for (int u0 = F.bid; u0 < 256; u0 += F.G) { const int u = F.G == 256 ? ((u0 & 7) * 4 + (u0 >> 6)) * 8 + ((u0 >> 3) & 7) : u0; ssd_unit(F, l, 0, u >> 3, u & 7); }
            for (int u0 = F.bid; u0 < 256; u0 += F.G) { const int u = F.G == 256 ? ((u0 & 7) * 4 + (u0 >> 6)) * 8 + ((u0 >> 3) & 7) : u0; ssd_unit(F, l, 1, u >> 3, u & 7); }
        }
        SEAM(p + 2);
        if (IN(p + 3)) for (int rep = 0; rep < REP_ATT; ++rep) {
            if (rep) xcd_barrier(xbar);
            const bool xl = F.G == 256; const int nloc = xl ? 32 : F.G, lc = xl ? F.bid >> 3 : F.bid, ntot = xl ? 264 : 2112;
            for (int rd = 0; rd * nloc < ntot; ++rd) { const int pos = (rd & 1) ? nloc - 1 - lc : lc; const int lu = rd * nloc + pos; if (lu >= ntot) continue;
                const int level = xl ? lu >> 3 : lu >> 6, within = xl ? lu & 7 : lu & 63, b = xl ? 4 * (F.bid & 7) + (within >> 1) : within >> 1, hf = within & 1;
                attn_unit(F, l, level == 16 ? 1 : 0, b, level < 16 ? 31 - level : level == 16 ? 0 : 32 - level, hf); }
            asm volatile("s_waitcnt vmcnt(0) lgkmcnt(0)" ::: "memory"); __syncthreads();
        }
        SEAM(p + 3);
        if (IN(p + 4)) {
            pg8::Gemm g{AO, F.wt(l, WO_OUT), MT, DM, AOW, AOW, AOW}; pg8::StaticOrder S; S.init(MT, DM, F.G, F.bid);
            EpiRes E{XB, F.ssq(SQ_SSD0 + l), F.ssq(SQ_FFN0 + l)};
            pg8::gemm_phase<EpiRes, true>(F.lds, g, S, E);
        }
        SEAM(p + 4);
        if (IN(p + 5)) for (int rep = 0; rep < REP_GU; ++rep) {
            if (rep) xcd_barrier(xbar);
            pg8::Gemm g{XB, F.wt(l, WO_GU), MT, GUW, DM, DM, DM}; pg8::StaticOrder S; S.init(MT, GUW, F.G, F.bid);
            EpiGU E{Hb, F.ssq(SQ_FFN0 + l)};
            pg8::gemm_phase<EpiGU, true>(F.lds, g, S, E);
        }
        SEAM(p + 5);
        if (IN(p + 6)) {
            pg8::Gemm g{Hb, F.wt(l, WO_DN), MT, DM, FF, FF, FF}; pg8::StaticOrder S; S.init(MT, DM, F.G, F.bid);
            EpiRes E{XB, nullptr, F.ssq(SQ_X1 + l)};
            pg8::gemm_phase<EpiRes, true>(F.lds, g, S, E);
        }
        SEAM(p + 6);
    }
    if (IN(15)) {
        { int t_ = threadIdx.x; asm volatile("" : "+v"(t_)); F.tid = t_; F.lane = t_ & 63; }
        const float* sq = F.ssq(SQ_X2); const float* gf = F.in[I_NFIN];
        f32x4 gg[4];
#pragma unroll
        for (int j = 0; j < 4; ++j) gg[j] = ((const f32x4*)gf)[F.lane + 64 * j];
        for (int row4 = (F.bid * 8 + F.wave) * 4; row4 < MT; row4 += F.G * 8 * 4) {
            u32x2 xw[4][4]; float rs[4];
#pragma unroll
            for (int q = 0; q < 4; ++q) { const int row = row4 + q; rs[q] = sq[row];
#pragma unroll
                for (int j = 0; j < 4; ++j) xw[q][j] = ((const u32x2*)(XB + (size_t)row * DM))[F.lane + 64 * j]; }
#pragma unroll
            for (int q = 0; q < 4; ++q) { const int row = row4 + q; const float r = rsqrtf(rs[q] * (1.f / 1024.f) + EPS); f32x4* yr = (f32x4*)(XR + (size_t)row * DM);
#pragma unroll
                for (int j = 0; j < 4; ++j) { const f32x4 xv = {bflo(xw[q][j].x), bfhi(xw[q][j].x), bflo(xw[q][j].y), bfhi(xw[q][j].y)}; __builtin_nontemporal_store(xv * r * gg[j], yr + F.lane + 64 * j); } } }
    }
#undef IN
#undef SEAM
}

extern "C" void kernel_launch(void* const* d_in, const int* in_sizes, int n_in, void* d_out, int out_size, void* d_ws, size_t ws_size, hipStream_t stream) {
    static int grid = 0;
    if (grid == 0) {
        if (n_in != 25 || (size_t)out_size != O_END || ws_size < WS_END) { fprintf(stderr, "kernel_launch: unexpected sizes n_in %d out %d ws %zu\n", n_in, out_size, ws_size); grid = -1; return; }
        int dev = 0, cus = 0, per_cu = 0;
        hipGetDevice(&dev); hipDeviceGetAttribute(&cus, hipDeviceAttributeMultiprocessorCount, dev);
        hipFuncSetAttribute((const void*)mk_fwd, hipFuncAttributeMaxDynamicSharedMemorySize, LDS_BYTES);
        hipOccupancyMaxActiveBlocksPerMultiprocessor(&per_cu, (const void*)mk_fwd, 512, LDS_BYTES);
        if (per_cu < 1) { fprintf(stderr, "kernel_launch: occupancy query says %d blocks/CU\n", per_cu); per_cu = 1; }
        (void)hipGetLastError();
        grid = cus;
        fprintf(stderr, "kernel_launch: grid %d (cus %d, per_cu %d)\n", grid, cus, per_cu);
    }
    if (grid < 0) return;
    if (hipMemsetAsync(d_ws, 0, 16384, stream) != hipSuccess) { fprintf(stderr, "kernel_launch: memset failed\n"); return; }
    Args a{};
    for (int i = 0; i < 25; ++i) a.in[i] = (const float*)d_in[i];
    a.out = (float*)d_out; a.ws = (unsigned char*)d_ws;
#if MK_N_LAUNCHES == 1
    a.ph_lo = 0; a.ph_hi = NPH;
    void* kargs[] = {&a};
    hipError_t e = hipLaunchCooperativeKernel((const void*)mk_fwd, dim3(grid), dim3(512), kargs, LDS_BYTES, stream);
    if (e != hipSuccess) fprintf(stderr, "cooperative launch failed: %s (grid %d)\n", hipGetErrorString(e), grid);
#else
    for (int p = 0; p < NPH; ++p) { a.ph_lo = p; a.ph_hi = p + 1; hipLaunchKernelGGL(mk_fwd, dim3(grid), dim3(512), LDS_BYTES, stream, a); }
#endif
}
```
